# Optimizing an MI355X kernel written in HIP

```python
import jax, jax.numpy as jnp
from jax import lax
import numpy as np

D_MODEL = 1024
BATCH = 16
SEQ = 2048
DEPTH = 2

EPS = 1e-6
HEAD_DIM = 64
MIX_WIDTH = D_MODEL
N_GROUPS = 4
GROUP_WIDTH = MIX_WIDTH // N_GROUPS
POOL_WINDOWS = (2, 4, 8, 16)
POOL_GROUP = GROUP_WIDTH // len(POOL_WINDOWS)
SWA_Q_HEADS = GROUP_WIDTH // HEAD_DIM
SWA_KV_HEADS = 2
SWA_GQA = SWA_Q_HEADS // SWA_KV_HEADS
SWA_WINDOW = 128
SWA_BLOCK = SWA_WINDOW
CONV_WIDTH = 3
DIFF_HEADS = GROUP_WIDTH // HEAD_DIM
DIFF_QK_DIM = HEAD_DIM // 2
DIFF_V_DIM = HEAD_DIM
Q_BLOCK = 128
SPLITS = (GROUP_WIDTH,
          SWA_Q_HEADS * HEAD_DIM, SWA_KV_HEADS * HEAD_DIM, SWA_KV_HEADS * HEAD_DIM,
          GROUP_WIDTH, GROUP_WIDTH, GROUP_WIDTH,
          DIFF_HEADS * 2 * DIFF_QK_DIM, DIFF_HEADS * 2 * DIFF_QK_DIM, DIFF_HEADS * DIFF_V_DIM)
IN_PROJ_WIDTH = sum(SPLITS)
PEER_HEADS = 8
PEER_KEYS = 128
PEER_EXPERTS = PEER_KEYS * PEER_KEYS
PEER_QUERY_DIM = 256
PEER_HALF = PEER_QUERY_DIM // 2
PEER_TOPK = 16
PEER_TOKEN_BLOCK = 128

kernel_name = "hymba_pool_swa_conv_diff_peer"


def rms_norm(x, g):
    xf = x.astype(jnp.float32)
    y = xf * lax.rsqrt(jnp.mean(xf * xf, axis=-1, keepdims=True) + EPS)
    return (y * g.astype(jnp.float32)).astype(x.dtype)


def head_norm(y, g):
    b, s, w = y.shape
    nh = w // HEAD_DIM
    return rms_norm(y.reshape(b, s, nh, HEAD_DIM), g.reshape(nh, HEAD_DIM)).reshape(b, s, w)


def split_cols(z, sizes):
    out, off = [], 0
    for n in sizes:
        out.append(z[..., off:off + n])
        off += n
    return out


def alibi_slopes(n):
    return jnp.exp2(-8.0 * jnp.arange(1, n + 1, dtype=jnp.float32) / n)


def pool_mixer(p, w_pool):
    b, s, _ = p.shape
    pf = p.astype(jnp.float32).reshape(b, s, len(POOL_WINDOWS), POOL_GROUP)
    cs = jnp.cumsum(pf, axis=1)
    t = jnp.arange(s)
    pooled = []
    for gi, w in enumerate(POOL_WINDOWS):
        c = cs[:, :, gi]
        lagged = jnp.pad(c, ((0, 0), (w, 0), (0, 0)))[:, :s]
        cnt = jnp.minimum(t + 1, w).astype(jnp.float32)[None, :, None]
        pooled.append((c - lagged) / cnt)
    d = (jnp.stack(pooled, axis=2) - pf).astype(p.dtype)
    return jnp.einsum('bsgc,gcd->bsgd', d, w_pool).reshape(b, s, GROUP_WIDTH)


def swa_sink_attention(q, k, v, qn_g, kn_g, sinks, slopes):
    b, s, _ = q.shape
    nb = s // SWA_BLOCK
    q = rms_norm(q.reshape(b, s, SWA_KV_HEADS, SWA_GQA, HEAD_DIM), qn_g)
    k = rms_norm(k.reshape(b, s, SWA_KV_HEADS, HEAD_DIM), kn_g)
    v = v.reshape(b, s, SWA_KV_HEADS, HEAD_DIM)
    qb = q.reshape(b, nb, SWA_BLOCK, SWA_KV_HEADS, SWA_GQA, HEAD_DIM)

    def banded(a):
        ap = jnp.pad(a, ((0, 0), (SWA_BLOCK, 0), (0, 0), (0, 0)))
        blk = ap.reshape(b, nb + 1, SWA_BLOCK, SWA_KV_HEADS, HEAD_DIM)
        return jnp.concatenate([blk[:, :-1], blk[:, 1:]], axis=2)

    kb, vb = banded(k), banded(v)
    sc = jnp.einsum('bnqhgd,bnkhd->bhgnqk', qb, kb).astype(jnp.float32) * (HEAD_DIM ** -0.5)
    i = jnp.arange(SWA_BLOCK)[:, None]
    j = jnp.arange(2 * SWA_BLOCK)[None, :]
    dist = i + SWA_BLOCK - j
    kpos = jnp.arange(nb)[:, None, None] * SWA_BLOCK - SWA_BLOCK + j
    valid = (dist >= 0) & (dist < SWA_WINDOW) & (kpos >= 0)
    m_h = slopes.reshape(SWA_KV_HEADS, SWA_GQA)[None, :, :, None, None, None]
    sc = sc - m_h * dist.astype(jnp.float32)
    sc = jnp.where(valid[None, None, None], sc, -jnp.inf)
    sink = sinks.astype(jnp.float32).reshape(SWA_KV_HEADS, SWA_GQA)[None, :, :, None, None, None]
    mx = jnp.maximum(jnp.max(sc, axis=-1, keepdims=True), sink)
    e = jnp.exp(sc - mx)
    pr = e / (jnp.sum(e, axis=-1, keepdims=True) + jnp.exp(sink - mx))
    o = jnp.einsum('bhgnqk,bnkhd->bnqhgd', pr.astype(v.dtype), vb)
    return o.reshape(b, s, SWA_Q_HEADS * HEAD_DIM)


def short_conv_mixer(h, gate_b, gate_c, conv_w):
    z = gate_c * h
    y = lax.conv_general_dilated(z, conv_w[:, None, :].astype(z.dtype), window_strides=(1,),
                                 padding=[(CONV_WIDTH - 1, 0)],
                                 dimension_numbers=('NWC', 'WIO', 'NWC'),
                                 feature_group_count=GROUP_WIDTH)
    return gate_b * y


def diff_attention(q, k, v, qn_g, kn_g, lam, slopes):
    b, s, _ = q.shape
    nb = s // Q_BLOCK
    q = rms_norm(q.reshape(b, s, DIFF_HEADS, 2, DIFF_QK_DIM), qn_g)
    k = rms_norm(k.reshape(b, s, DIFF_HEADS, 2, DIFF_QK_DIM), kn_g)
    v = v.reshape(b, s, DIFF_HEADS, DIFF_V_DIM)
    qb = jnp.moveaxis(q.reshape(b, nb, Q_BLOCK, DIFF_HEADS, 2, DIFF_QK_DIM), 1, 0)
    kpos = jnp.arange(s)
    m_h = slopes[None, :, None, None, None]

    def block(args):
        qi, n = args
        qpos = n * Q_BLOCK + jnp.arange(Q_BLOCK)
        sc = jnp.einsum('bqhmd,bkhmd->bhmqk', qi, k).astype(jnp.float32) * (DIFF_QK_DIM ** -0.5)
        dist = qpos[:, None] - kpos[None, :]
        sc = sc - m_h * dist.astype(jnp.float32)
        sc = jnp.where(dist >= 0, sc, -jnp.inf)
        a = jax.nn.softmax(sc, axis=-1)
        w = a[:, :, 0] - lam * a[:, :, 1]
        return jnp.einsum('bhqk,bkhd->bqhd', w.astype(v.dtype), v)

    o = lax.map(block, (qb, jnp.arange(nb)))
    return jnp.moveaxis(o, 0, 1).reshape(b, s, DIFF_HEADS * DIFF_V_DIM)


def peer_ffn(xn, w_query, sub_keys, peer_u, peer_v):
    b, s, d = xn.shape
    t = b * s
    xt = xn.reshape(t, d)
    q = (xt @ w_query).reshape(t, PEER_HEADS, 2, PEER_HALF)
    sk = jnp.einsum('thcd,ckd->thck', q, sub_keys).astype(jnp.float32)
    top_s, top_i = lax.top_k(sk, PEER_TOPK)
    cand_s = top_s[:, :, 0, :, None] + top_s[:, :, 1, None, :]
    cand_i = top_i[:, :, 0, :, None] * PEER_KEYS + top_i[:, :, 1, None, :]
    cand_s = cand_s.reshape(t, PEER_HEADS, PEER_TOPK * PEER_TOPK)
    cand_i = cand_i.reshape(t, PEER_HEADS, PEER_TOPK * PEER_TOPK)
    best_s, best_pos = lax.top_k(cand_s, PEER_TOPK)
    idx = jnp.take_along_axis(cand_i, best_pos, axis=-1)
    gate = jax.nn.softmax(best_s, axis=-1)
    nblk = t // PEER_TOKEN_BLOCK

    def block(args):
        xb, ib, gb = args
        h = jnp.einsum('thkd,td->thk', peer_u[ib], xb).astype(jnp.float32)
        a = (gb * jax.nn.gelu(h, approximate=False)).astype(xb.dtype)
        return jnp.einsum('thk,thkd->td', a, peer_v[ib])

    out = lax.map(block, (xt.reshape(nblk, PEER_TOKEN_BLOCK, d),
                          idx.reshape(nblk, PEER_TOKEN_BLOCK, PEER_HEADS, PEER_TOPK),
                          gate.reshape(nblk, PEER_TOKEN_BLOCK, PEER_HEADS, PEER_TOPK)))
    return out.reshape(b, s, d).astype(xn.dtype)


def hybrid_layer(x, layer_idx, norm1_g, w_in, w_pool, swa_q_norm, swa_k_norm, swa_sinks, conv_w,
                 diff_q_norm, diff_k_norm, lam_q1, lam_k1, lam_q2, lam_k2, out_norm_g, w_out,
                 norm2_g, w_query, sub_keys, peer_u, peer_v):
    slopes = alibi_slopes(SWA_Q_HEADS + DIFF_HEADS)
    lam_init = 0.8 - 0.6 * float(np.exp(-0.3 * layer_idx))
    lam = (jnp.exp(jnp.sum(lam_q1.astype(jnp.float32) * lam_k1.astype(jnp.float32)))
           - jnp.exp(jnp.sum(lam_q2.astype(jnp.float32) * lam_k2.astype(jnp.float32))) + lam_init)

    xn = rms_norm(x, norm1_g)
    z = xn @ w_in
    p_a, q_b, k_b, v_b, h_c, b_c, c_c, q_d, k_d, v_d = split_cols(z, SPLITS)

    y_a = pool_mixer(p_a, w_pool)
    y_b = swa_sink_attention(q_b, k_b, v_b, swa_q_norm, swa_k_norm, swa_sinks, slopes[:SWA_Q_HEADS])
    y_c = short_conv_mixer(h_c, b_c, c_c, conv_w)
    y_d = diff_attention(q_d, k_d, v_d, diff_q_norm, diff_k_norm, lam, slopes[SWA_Q_HEADS:])

    g_a, g_b, g_c, g_d = split_cols(out_norm_g, (GROUP_WIDTH,) * N_GROUPS)
    y = jnp.concatenate([head_norm(y_a, g_a), head_norm(y_b, g_b), head_norm(y_c, g_c),
                         head_norm(y_d, g_d) * (1.0 - lam_init)], axis=-1)
    x = x + y @ w_out
    x = x + peer_ffn(rms_norm(x, norm2_g), w_query, sub_keys, peer_u, peer_v)
    return x


def setup_inputs(seed: int = 0) -> dict:
    key = jax.random.key(seed)
    ks = jax.random.split(key, 24)
    nrm = lambda k, shape, scale: jax.random.normal(k, shape, jnp.float32) * scale
    gain = lambda k, shape: 1.0 + 0.02 * jax.random.normal(k, shape, jnp.float32)
    L = DEPTH
    return {
        "x": nrm(ks[0], (BATCH, SEQ, D_MODEL), 1.0),
        "norm1_g": gain(ks[1], (L, D_MODEL)),
        "w_in": nrm(ks[2], (L, D_MODEL, IN_PROJ_WIDTH), D_MODEL ** -0.5),
        "w_pool": nrm(ks[3], (L, len(POOL_WINDOWS), POOL_GROUP, POOL_GROUP), POOL_GROUP ** -0.5),
        "swa_q_norm": gain(ks[4], (L, HEAD_DIM)),
        "swa_k_norm": gain(ks[5], (L, HEAD_DIM)),
        "swa_sinks": nrm(ks[6], (L, SWA_Q_HEADS), 1.0),
        "conv_w": nrm(ks[7], (L, CONV_WIDTH, GROUP_WIDTH), CONV_WIDTH ** -0.5),
        "diff_q_norm": gain(ks[8], (L, DIFF_QK_DIM)),
        "diff_k_norm": gain(ks[9], (L, DIFF_QK_DIM)),
        "lam_q1": nrm(ks[10], (L, DIFF_QK_DIM), 0.1),
        "lam_k1": nrm(ks[11], (L, DIFF_QK_DIM), 0.1),
        "lam_q2": nrm(ks[12], (L, DIFF_QK_DIM), 0.1),
        "lam_k2": nrm(ks[13], (L, DIFF_QK_DIM), 0.1),
        "out_norm_g": gain(ks[14], (L, MIX_WIDTH)),
        "w_out": nrm(ks[15], (L, MIX_WIDTH, D_MODEL), MIX_WIDTH ** -0.5),
        "norm2_g": gain(ks[16], (L, D_MODEL)),
        "w_query": nrm(ks[17], (L, D_MODEL, PEER_HEADS * PEER_QUERY_DIM), D_MODEL ** -0.5),
        "sub_keys": nrm(ks[18], (L, 2, PEER_KEYS, PEER_HALF), PEER_HALF ** -0.5),
        "peer_u": nrm(ks[19], (L, PEER_EXPERTS, D_MODEL), D_MODEL ** -0.5),
        "peer_v": nrm(ks[20], (L, PEER_EXPERTS, D_MODEL), PEER_HEADS ** -0.5),
    }


def reference(x, norm1_g, w_in, w_pool, swa_q_norm, swa_k_norm, swa_sinks, conv_w, diff_q_norm,
              diff_k_norm, lam_q1, lam_k1, lam_q2, lam_k2, out_norm_g, w_out, norm2_g, w_query,
              sub_keys, peer_u, peer_v):
    for l in range(DEPTH):
        x = hybrid_layer(x, l, norm1_g[l], w_in[l], w_pool[l], swa_q_norm[l], swa_k_norm[l],
                         swa_sinks[l], conv_w[l], diff_q_norm[l], diff_k_norm[l], lam_q1[l],
                         lam_k1[l], lam_q2[l], lam_k2[l], out_norm_g[l], w_out[l], norm2_g[l],
                         w_query[l], sub_keys[l], peer_u[l], peer_v[l])
    return x
```

```cpp
#include <hip/hip_runtime.h>
#include <hip/hip_cooperative_groups.h>
#include <cstdio>
#include <cstdint>
namespace cg = cooperative_groups;

#define LAS __attribute__((address_space(3)))
typedef unsigned short bf16_t;
typedef short bf16x8 __attribute__((ext_vector_type(8)));
typedef float f32x4 __attribute__((ext_vector_type(4)));
typedef float f32x16 __attribute__((ext_vector_type(16)));
typedef unsigned u32x4 __attribute__((ext_vector_type(4)));
typedef unsigned u32x2 __attribute__((ext_vector_type(2)));

constexpr int BATCH = 16, SEQ = 2048, T = BATCH * SEQ, DM = 1024, NZ = 2304, NQ = 2048, DEPTH = 2;
constexpr int NTHREADS = 512, NWAVES = 8;
constexpr int NEXP = 16384;
constexpr float EPS = 1e-6f;
constexpr int ZC_PA = 0, ZC_QB = 256, ZC_KB = 512, ZC_VB = 640, ZC_HC = 768, ZC_BC = 1024, ZC_CC = 1280, ZC_QD = 1536, ZC_KD = 1792, ZC_VD = 2048;

constexpr size_t MiB = 1u << 20;
constexpr size_t WS_CTL = 0;
constexpr size_t WS_WIN = 1 * MiB;
constexpr size_t WS_WOUT = 10 * MiB;
constexpr size_t WS_WQ = 14 * MiB;
constexpr size_t WS_SK = 22 * MiB;
constexpr size_t WS_MISC = 23 * MiB;
constexpr size_t WS_XN = 24 * MiB;
constexpr size_t WS_Y = 88 * MiB;
constexpr size_t WS_XN2 = 152 * MiB;
constexpr size_t WS_Z = 216 * MiB;
constexpr size_t WS_IDX = 360 * MiB;
constexpr size_t WS_GATE = 376 * MiB;
constexpr size_t WS_PU = 392 * MiB;
constexpr size_t WS_PV = 424 * MiB;
constexpr size_t WS_P8 = 392 * MiB;
constexpr size_t WS_SCL = 23 * MiB + 65536;
constexpr size_t WS_RSTD = 23 * MiB + 524288;
constexpr size_t WS_SUQ = 23 * MiB + 655360;
constexpr size_t WS_END = 456 * MiB;

constexpr int LDS_BYTES = 147456;
#ifndef USE_I3U
#define USE_I3U 0
#endif
#ifndef P2_F16
#define P2_F16 1
#endif
#ifndef P1_PRESTAGE
#define P1_PRESTAGE 1
#endif
#ifndef USE_I4U
#define USE_I4U 1
#endif
#ifndef USE_POOLFOLD
#define USE_POOLFOLD 1
#endif
#ifndef USE_FP4
#define USE_FP4 3
#endif
#ifndef USE_PEER
#define USE_PEER 1
#endif
#ifndef USE_XBAR
#define USE_XBAR 1
#endif
#ifndef QUARTILE_BARRIER
#define QUARTILE_BARRIER 1
#endif
#ifndef PROBE_IDXMASK
#define PROBE_IDXMASK 0
#endif
#ifndef PROBE_HALFWAVES
#define PROBE_HALFWAVES 0
#endif
#ifndef PROBE_MASK
#define PROBE_MASK 0
#endif
#ifndef USE_ROUTE
#define USE_ROUTE 1
#endif
#ifndef USE_ATTN
#define USE_ATTN 1
#endif
#ifndef USE_GATHER
#define USE_GATHER 2
#endif
#ifndef USE_PG8
#define USE_PG8 7
#endif

struct Params {
    const float* x; const float* norm1_g; const float* w_in; const float* w_pool; const float* swa_q_norm; const float* swa_k_norm;
    const float* swa_sinks; const float* conv_w; const float* diff_q_norm; const float* diff_k_norm; const float* lam_q1; const float* lam_k1;
    const float* lam_q2; const float* lam_k2; const float* out_norm_g; const float* w_out; const float* norm2_g; const float* w_query;
    const float* sub_keys; const float* peer_u; const float* peer_v;
    float* out; unsigned char* ws;
};

#if defined(__HIP_DEVICE_COMPILE__)
typedef const __attribute__((address_space(4))) Params* KP;
__device__ __forceinline__ KP kargs() { KP k = (KP)__builtin_amdgcn_kernarg_segment_ptr(); asm volatile("" : "+s"(k)); return k; }
#endif
#if defined(__HIP_DEVICE_COMPILE__)
#define FRESH_PARAMS const Params p = *kargs()
#else
#define FRESH_PARAMS const Params p{}
#endif

struct Ids { int tid, lane, wave, bid, nblk, gw, ngw, gtid, gthreads; };
__device__ __forceinline__ int hw_lane() { unsigned z = 0u; asm volatile("" : "+v"(z)); return (int)__builtin_amdgcn_mbcnt_hi(~0u, __builtin_amdgcn_mbcnt_lo(~0u, z)); }
__device__ __forceinline__ Ids fresh_ids(int wv0) {
    Ids I; int bid = blockIdx.x, nblk = gridDim.x, wv = wv0;
    asm volatile("" : "+s"(wv)); asm volatile("" : "+s"(bid)); asm volatile("" : "+s"(nblk));
    int lane = hw_lane(); asm volatile("" : "+v"(lane));
    const int tid = wv * 64 + lane;
    I.tid = tid; I.lane = lane; I.wave = wv; I.bid = bid; I.nblk = nblk;
    I.gw = bid * NWAVES + I.wave; I.ngw = nblk * NWAVES; I.gtid = bid * NTHREADS + tid; I.gthreads = nblk * NTHREADS;
    return I;
}
#define FRESH_IDS const Ids I = fresh_ids(wv0); const int tid = I.tid, lane = I.lane, wave = I.wave, bid = I.bid, nblk = I.nblk, gw = I.gw, ngw = I.ngw, gtid = I.gtid, gthreads = I.gthreads; \
    (void)tid; (void)lane; (void)wave; (void)bid; (void)nblk; (void)gw; (void)ngw; (void)gtid; (void)gthreads

__device__ __forceinline__ float bf2f(unsigned v) { return __uint_as_float(v << 16); }
__device__ __forceinline__ unsigned f2bf(float f) { unsigned u = __float_as_uint(f); return (u + 0x7fffu + ((u >> 16) & 1u)) >> 16; }
typedef __bf16 bf16x2_t __attribute__((ext_vector_type(2)));
typedef float f32x2 __attribute__((ext_vector_type(2)));
typedef unsigned u32x3 __attribute__((ext_vector_type(3)));
__device__ __forceinline__ unsigned pk2(float lo, float hi) { const f32x2 f = {lo, hi}; return __builtin_bit_cast(unsigned, __builtin_convertvector(f, bf16x2_t)); }
__device__ __forceinline__ float dot2bf(unsigned a, unsigned b, float acc) { return __builtin_amdgcn_fdot2_f32_bf16(__builtin_bit_cast(bf16x2_t, a), __builtin_bit_cast(bf16x2_t, b), acc, false); }
__device__ __forceinline__ float wave_sum(float v) {
#pragma unroll
    for (int o = 1; o < 64; o <<= 1) v += __shfl_xor(v, o);
    return v;
}
__device__ __forceinline__ float wave_max(float v) {
#pragma unroll
    for (int o = 1; o < 64; o <<= 1) v = fmaxf(v, __shfl_xor(v, o));
    return v;
}
__device__ __forceinline__ void unpack8(const u32x4 w, float* f) {
    f[0] = __uint_as_float(w.x << 16); f[1] = __uint_as_float(w.x & 0xffff0000u);
    f[2] = __uint_as_float(w.y << 16); f[3] = __uint_as_float(w.y & 0xffff0000u);
    f[4] = __uint_as_float(w.z << 16); f[5] = __uint_as_float(w.z & 0xffff0000u);
    f[6] = __uint_as_float(w.w << 16); f[7] = __uint_as_float(w.w & 0xffff0000u);
}
__device__ __forceinline__ float lam_init_of(int l) { return l == 0 ? 0.2f : 0.35550907f; }

#define MFMA32(a, b, c) __builtin_amdgcn_mfma_f32_32x32x16_bf16((a), (b), (c), 0, 0, 0)
__device__ __forceinline__ int crow(int reg, int h) { return (reg & 3) + 8 * (reg >> 2) + 4 * h; }

#define RLX_AGENT __ATOMIC_RELAXED, __HIP_MEMORY_SCOPE_AGENT
#define XB_TMO      128
#define XB_XCNT(j)  (256  + 64 * (j))
#define XB_XSUB(j)  (1280 + 64 * (j))
#define XB_XGEN(j)  (2304 + 64 * (j))
#define XB_TOP      3328
#define XB_TOPGEN   3392
#define XCD_BAR_WORDS 3456
#define XB_SPIN_CAP (1u << 18)

__device__ __forceinline__ unsigned xb_ld(unsigned* p)              { return __hip_atomic_load(p, __ATOMIC_RELAXED, __HIP_MEMORY_SCOPE_AGENT); }
__device__ __forceinline__ unsigned xb_add(unsigned* p, unsigned v) { return __hip_atomic_fetch_add(p, v, __ATOMIC_RELAXED, __HIP_MEMORY_SCOPE_AGENT); }
__device__ __forceinline__ unsigned xb_xcc_id() { return (unsigned)__builtin_amdgcn_s_getreg((3 << 11) | 20) & 0xFu; }
#define XB_SPIN(cond, bar) do { unsigned _sp = 0; while (cond) { __builtin_amdgcn_s_sleep(1); \
    if ((++_sp & 255u) == 0u) { if (xb_ld(&(bar)[XB_TMO])) break; if (_sp > XB_SPIN_CAP) { atomicAdd(&(bar)[XB_TMO], 1u); break; } } } } while (0)

struct XcdBarrier {
    unsigned* bar; unsigned x;
    volatile LAS unsigned* st;
};

__device__ __forceinline__ XcdBarrier xcd_barrier_post(unsigned* bar, volatile LAS unsigned* st) {
    XcdBarrier b; b.bar = bar; b.x = xb_xcc_id(); b.st = st;
    if (threadIdx.x == 0) (void)xb_add(&bar[XB_XCNT(b.x)], 1u);
    return b;
}
__device__ __forceinline__ void xcd_barrier_complete(unsigned* bar, unsigned x, unsigned& nloc, unsigned& nx) {
    const unsigned G = gridDim.x * gridDim.y * gridDim.z;
    unsigned sum, cnt, mine, sp = 0u;
    for (;;) {
        sum = 0u; cnt = 0u; mine = 0u;
#pragma unroll
        for (unsigned j = 0; j < 16; ++j) { const unsigned c = xb_ld(&bar[XB_XCNT(j)]); sum += c; cnt += (c > 0u) ? 1u : 0u; mine = (j == x) ? c : mine; }
        if (sum == G) break;
        __builtin_amdgcn_s_sleep(1);
        if ((++sp & 255u) == 0u) { if (xb_ld(&bar[XB_TMO])) break; if (sp > XB_SPIN_CAP) { atomicAdd(&bar[XB_TMO], 1u); break; } }
    }
    nloc = mine > 0u ? mine : 1u; nx = cnt > 0u ? cnt : 1u;
}

__device__ __forceinline__ void xcd_barrier(const XcdBarrier& b) {
    asm volatile("s_waitcnt vmcnt(0)" ::: "memory");
    __syncthreads();
    if (threadIdx.x == 0) {
        unsigned* bar = b.bar;
        __builtin_amdgcn_s_waitcnt(0);
        unsigned nloc = b.st[0], nx = b.st[1];
        if (nloc == 0u) { xcd_barrier_complete(bar, b.x, nloc, nx); b.st[0] = nloc; b.st[1] = nx; }
        const unsigned old = xb_add(&bar[XB_XSUB(b.x)], 1u);
        const unsigned gen = old / nloc;
        if (old + 1u == (gen + 1u) * nloc) {
            __builtin_amdgcn_fence(__ATOMIC_RELEASE, "agent");
            asm volatile("s_waitcnt vmcnt(0)" ::: "memory");
            const unsigned og = xb_add(&bar[XB_TOP], 1u);
            const unsigned tg = og / nx;
            if (og + 1u == (tg + 1u) * nx) xb_add(&bar[XB_TOPGEN], 1u);
            else XB_SPIN(xb_ld(&bar[XB_TOPGEN]) == tg, bar);
            __builtin_amdgcn_fence(__ATOMIC_ACQUIRE, "agent");
            xb_add(&bar[XB_XGEN(b.x)], 1u);
            asm volatile("s_waitcnt vmcnt(0)" ::: "memory");
        } else {
            XB_SPIN(xb_ld(&bar[XB_XGEN(b.x)]) == gen, bar);
            __builtin_amdgcn_fence(__ATOMIC_ACQUIRE, "agent");
            asm volatile("s_waitcnt vmcnt(0)" ::: "memory");
        }
    }
    __syncthreads();
}

namespace pg8 {
#define PG8_LAS __attribute__((address_space(3)))
typedef unsigned short bf16_t;
typedef short bf16x8 __attribute__((ext_vector_type(8)));
typedef float f32x4 __attribute__((ext_vector_type(4)));
typedef unsigned u32x4 __attribute__((ext_vector_type(4)));
constexpr int BM = 256, BK = 64, HALF = 128, HTB = HALF * BK * 2  , STAGE_BYTES = 8 * HTB, NXCD = 8, WGM = 8;

__host__ __device__ __forceinline__ int lds_byte(int r, int c) { const int st = (r >> 4) * 2 + (c >> 5), rr = r & 15, cc = c & 31, ob = rr * 64 + cc * 2; return st * 1024 + (ob ^ (((ob >> 9) & 1) << 5)); }
__host__ __device__ __forceinline__ void stage_rc(int b, int& R, int& C) { const int st = b / 1024, sb = b % 1024, swz = sb ^ (((sb >> 9) & 1) << 5); R = (st >> 1) * 16 + swz / 64; C = (st & 1) * 32 + (swz % 64) / 2; }
__host__ __device__ __forceinline__ int perm32(int rho) { const int n = rho >> 4, i = rho & 15; return 8 * (i >> 2) + 4 * n + (i & 3); }

struct Unit { int pm, pn, hm; };
struct Gemm { const bf16_t* A; const bf16_t* Bt; int M, N, K; };

struct StaticOrder {
    static constexpr bool HALF_TAIL = false;
    int nM, nN, nwg, G, c;
    __host__ __device__ void init(int M, int N, int G_, int c_) { nM = M / BM; nN = N / BM; nwg = nM * nN; G = G_; c = c_; }
    __host__ __device__ bool next(int i, Unit& u) const {
        const long L = (long)i * G + c; if (L >= nwg) return false;
        int wgid = (int)L; { const int q = nwg / NXCD, r = nwg % NXCD, xcd = wgid % NXCD, off = wgid / NXCD; wgid = (xcd < r ? xcd * (q + 1) : r * (q + 1) + (xcd - r) * q) + off; }
        const int nig = WGM * nN, gid = wgid / nig, fm = gid * WGM, gsz = (nM - fm) < WGM ? (nM - fm) : WGM;
        u.pm = fm + ((wgid % nig) % gsz); u.pn = (wgid % nig) / gsz; u.hm = -1; return true;
    }
    __device__ __forceinline__ void a_ready(const Unit&) const {}
    __device__ __forceinline__ void done(const Unit&) const {}
};
struct StaticOrderHT : StaticOrder {
    static constexpr bool HALF_TAIL = true;
    __host__ __device__ bool next(int i, Unit& u) const {
        const int full = nwg / G, left = nwg - full * G;
        if (i < full || 2 * left > G) return StaticOrder::next(i, u);
        if (i > full || c >= 2 * left) return false;
        StaticOrder t = *this; t.c = c >> 1;
        if (!t.StaticOrder::next(i, u)) return false;
        u.hm = c & 1; return true;
    }
};

__device__ __forceinline__ unsigned cvt_pk_bf16(float lo, float hi) { unsigned r; asm volatile("v_cvt_pk_bf16_f32 %0, %1, %2" : "=v"(r) : "v"(lo), "v"(hi)); return r; }
typedef float f32x2 __attribute__((ext_vector_type(2)));
__device__ __forceinline__ f32x2 gelu_pk(f32x2 v) {
    const f32x2 av = __builtin_elementwise_abs(v), d = av * 0.2316418882f + 1.0f;
    f32x2 t; t.x = __builtin_amdgcn_rcpf(d.x); t.y = __builtin_amdgcn_rcpf(d.y);
    f32x2 q = t * 0.5307027145f + (-0.7265760135f); q = q * t + 0.7107068705f; q = q * t + (-0.142248368f); q = q * t + 0.127414796f; q = q * t;
    const f32x2 s = (v * v) * (-0.72134752044f);
    f32x2 e; e.x = __builtin_amdgcn_exp2f(s.x); e.y = __builtin_amdgcn_exp2f(s.y);
    const f32x2 m = v * (q * e), r = v - m;
    f32x2 o; o.x = v.x < 0.f ? m.x : r.x; o.y = v.y < 0.f ? m.y : r.y; return o;
}

template <int ACT  > struct EpiBf16 {
    static constexpr bool PERM = true, AFTER_DRAIN = false; static_assert(ACT == 0 || ACT == 1, "EpiBf16: ACT is 0 (none) or 1 (gelu_pk)");
    bf16_t* O; int ldc; const float* bias; int split_cols; size_t split_stride; float scale0;
    __device__ __forceinline__ void operator()(const f32x4 (&acc)[2][2][4][2], const Unit& u, int wr, int wc, int fr, int fq) const {
        const int row0 = u.pm * BM + wr * 64 + fr; int colt = u.pn * BM; bf16_t* base = O;
        float sc = 1.f; if (split_cols) { const int t = colt / split_cols; base += (size_t)t * split_stride; colt -= t * split_cols; if (t == 0) sc = scale0; }
        const int col0 = colt + wc * 32 + 8 * fq, bcol0 = u.pn * BM + wc * 32 + 8 * fq;
        f32x4 bv[2][2];
#pragma unroll
        for (int bj = 0; bj < 2; ++bj)
#pragma unroll
            for (int n = 0; n < 2; ++n) bv[bj][n] = bias ? *(const f32x4*)(bias + bcol0 + bj * HALF + 4 * n) : (f32x4){0.f, 0.f, 0.f, 0.f};
#pragma unroll
        for (int ai = 0; ai < 2; ++ai)
#pragma unroll
            for (int m = 0; m < 4; ++m) { bf16_t* rowp = base + (size_t)(row0 + ai * HALF + m * 16) * ldc + col0;
#pragma unroll
                for (int bj = 0; bj < 2; ++bj) { f32x4 v0 = acc[ai][bj][m][0] + bv[bj][0], v1 = acc[ai][bj][m][1] + bv[bj][1];
                    if (ACT == 1) { f32x2 a = gelu_pk((f32x2){v0[0], v0[1]}), b = gelu_pk((f32x2){v0[2], v0[3]}), c = gelu_pk((f32x2){v1[0], v1[1]}), d = gelu_pk((f32x2){v1[2], v1[3]});
                        v0 = (f32x4){a.x, a.y, b.x, b.y}; v1 = (f32x4){c.x, c.y, d.x, d.y}; }
                    v0 = v0 * sc; v1 = v1 * sc; u32x4 w; w.x = cvt_pk_bf16(v0[0], v0[1]); w.y = cvt_pk_bf16(v0[2], v0[3]); w.z = cvt_pk_bf16(v1[0], v1[1]); w.w = cvt_pk_bf16(v1[2], v1[3]);
                    *(u32x4*)(rowp + bj * HALF) = w; } }
    }
};
struct EpiBf16RS {
    static constexpr bool PERM = true, AFTER_DRAIN = false;
    bf16_t* O; int ldc; const float* rowscale;
    __device__ __forceinline__ void operator()(const f32x4 (&acc)[2][2][4][2], const Unit& u, int wr, int wc, int fr, int fq) const {
        const int row0 = u.pm * BM + wr * 64 + fr + (u.hm > 0 ? HALF : 0), col0 = u.pn * BM + wc * 32 + 8 * fq;
#pragma unroll
        for (int ai = 0; ai < 2; ++ai) if (ai == 0 || u.hm < 0)
#pragma unroll
            for (int m = 0; m < 4; ++m) { const int row = row0 + ai * HALF + m * 16; bf16_t* rowp = O + (size_t)row * ldc + col0; const float sc = rowscale ? rowscale[row] : 1.f;
#pragma unroll
                for (int bj = 0; bj < 2; ++bj) { const f32x4 v0 = acc[ai][bj][m][0] * sc, v1 = acc[ai][bj][m][1] * sc;
                    u32x4 w; w.x = cvt_pk_bf16(v0[0], v0[1]); w.y = cvt_pk_bf16(v0[2], v0[3]); w.z = cvt_pk_bf16(v1[0], v1[1]); w.w = cvt_pk_bf16(v1[2], v1[3]);
                    *(u32x4*)(rowp + bj * HALF) = w; } }
    }
};
struct EpiResB {
    static constexpr bool PERM = true, AFTER_DRAIN = false;
    const float* base32; const bf16_t* base16; bf16_t* xb; int ldc;
    __device__ __forceinline__ void operator()(const f32x4 (&acc)[2][2][4][2], const Unit& u, int wr, int wc, int fr, int fq) const {
        const int row0 = u.pm * BM + wr * 64 + fr, col0 = u.pn * BM + wc * 32 + 8 * fq;
#pragma unroll
        for (int ai = 0; ai < 2; ++ai)
#pragma unroll
            for (int m = 0; m < 4; ++m) { const size_t off = (size_t)(row0 + ai * HALF + m * 16) * ldc + col0;
#pragma unroll
                for (int bj = 0; bj < 2; ++bj) {
                    f32x4 b0, b1;
                    if (base16) { const u32x4 bw = *(const u32x4*)(base16 + off + bj * HALF);
                        b0 = (f32x4){__uint_as_float(bw.x << 16), __uint_as_float(bw.x & 0xffff0000u), __uint_as_float(bw.y << 16), __uint_as_float(bw.y & 0xffff0000u)};
                        b1 = (f32x4){__uint_as_float(bw.z << 16), __uint_as_float(bw.z & 0xffff0000u), __uint_as_float(bw.w << 16), __uint_as_float(bw.w & 0xffff0000u)}; }
                    else { b0 = *(const f32x4*)(base32 + off + bj * HALF); b1 = *(const f32x4*)(base32 + off + bj * HALF + 4); }
                    const f32x4 v0 = b0 + acc[ai][bj][m][0], v1 = b1 + acc[ai][bj][m][1];
                    u32x4 w; w.x = cvt_pk_bf16(v0[0], v0[1]); w.y = cvt_pk_bf16(v0[2], v0[3]); w.z = cvt_pk_bf16(v1[0], v1[1]); w.w = cvt_pk_bf16(v1[2], v1[3]);
                    *(u32x4*)(xb + off + bj * HALF) = w; }
                if (m & 1) asm volatile("" ::: "memory"); }
    }
};
struct EpiRes {
    static constexpr bool PERM = false, AFTER_DRAIN = false;
    const float* base; float* out; int ldc; bf16_t* xb;
    __device__ __forceinline__ void operator()(const f32x4 (&acc)[2][2][4][2], const Unit& u, int wr, int wc, int fr, int fq) const {
        const int col0 = u.pn * BM + wc * 32 + 4 * fq;
#pragma unroll
        for (int ai = 0; ai < 2; ++ai)
#pragma unroll
            for (int m = 0; m < 4; ++m) { const size_t off = (size_t)(u.pm * BM + ai * HALF + wr * 64 + m * 16 + fr) * ldc + col0;
#pragma unroll
                for (int bj = 0; bj < 2; ++bj)
#pragma unroll
                    for (int n = 0; n < 2; ++n) { const f32x4 bs = *(const f32x4*)(base + off + bj * HALF + n * 16); const f32x4 v = bs + acc[ai][bj][m][n]; *(f32x4*)(out + off + bj * HALF + n * 16) = v;
                        if (xb) { unsigned w0 = cvt_pk_bf16(v[0], v[1]), w1 = cvt_pk_bf16(v[2], v[3]); unsigned long long w = (unsigned long long)w0 | ((unsigned long long)w1 << 32); *(unsigned long long*)(xb + off + bj * HALF + n * 16) = w; } }
                if (m & 1) asm volatile("" ::: "memory"); }
    }
};
template <class Epi, class Sched, bool ALIGN_EPI = false, bool SP2 = false>
__device__ __forceinline__ void gemm_phase(PG8_LAS unsigned char* lds, const Gemm g, const Sched& S, const Epi& E, const int tid_in) {
    int tid_ = tid_in; asm volatile("" : "+v"(tid_));
    const int tid = tid_, wid = __builtin_amdgcn_readfirstlane(tid >> 6), lane = tid & 63, wr = wid >> 2, wc = wid & 3, fr = lane & 15, fq = lane >> 4;
    const int K = g.K, nt = K / BK;
    unsigned voffA[2], voffB[2];
#pragma unroll
    for (int i = 0; i < 2; ++i) { int R, C; stage_rc(tid * 16 + i * 8192, R, C); const int Rb = Epi::PERM ? ((R & ~31) + perm32(R & 31)) : R;
        voffA[i] = (unsigned)(R * K + C) * 2u; voffB[i] = (unsigned)(Rb * K + C) * 2u; }
    const size_t kstep = (size_t)(BK * 2);
    const size_t hstep = (size_t)HALF * K * 2;
    const size_t tstep = 2 * hstep;
    const unsigned ldsw = (unsigned)wid * 1024u;
    const int aoff = lds_byte(wr * 64 + fr, fq * 8), boff = lds_byte(wc * 32 + fr, fq * 8);
#define PG8_SA(b, h) (((b) * 2 + (h)) * HTB)
#define PG8_SB(b, h) ((4 + (b) * 2 + (h)) * HTB)
#define PG8_STAGE(bufoff, gbase, voff) do { _Pragma("unroll") for (int _i = 0; _i < 2; ++_i) \
        __builtin_amdgcn_global_load_lds((const unsigned*)((const char*)(gbase) + (voff)[_i]), (PG8_LAS unsigned*)(lds + (bufoff) + ldsw + _i * 8192), 16, 0, 0); } while (0)
#define PG8_LDA(dst, b, h) do { _Pragma("unroll") for (int m = 0; m < 4; ++m) _Pragma("unroll") for (int k = 0; k < 2; ++k) dst[m][k] = *(const PG8_LAS bf16x8*)(lds + PG8_SA(b, h) + aoff + m * 2048 + k * 1024); } while (0)
#define PG8_LDB(dst, b, h) do { _Pragma("unroll") for (int n = 0; n < 2; ++n) _Pragma("unroll") for (int k = 0; k < 2; ++k) dst[n][k] = *(const PG8_LAS bf16x8*)(lds + PG8_SB(b, h) + boff + n * 2048 + k * 1024); } while (0)
#define PG8_MMA(ai, bj, At, Bt) do { __builtin_amdgcn_s_setprio(1); _Pragma("unroll") for (int m = 0; m < 4; ++m) _Pragma("unroll") for (int n = 0; n < 2; ++n) _Pragma("unroll") for (int k = 0; k < 2; ++k) \
        acc[ai][bj][m][n] = __builtin_amdgcn_mfma_f32_16x16x32_bf16(Bt[n][k], At[m][k], acc[ai][bj][m][n], 0, 0, 0); __builtin_amdgcn_s_setprio(0); } while (0)
#define PG8_WAIT_V(n) asm volatile("s_waitcnt vmcnt(" #n ")" ::: "memory")
#define PG8_WAIT_L(n) asm volatile("s_waitcnt lgkmcnt(" #n ")" ::: "memory")
#define PG8_BAR __builtin_amdgcn_s_barrier()
#define PG8_SCHED __builtin_amdgcn_sched_barrier(0)
    Unit cur, nxt; int ui = 0;
    if (!S.next(0, cur)) return;
    f32x4 acc[2][2][4][2];
#pragma unroll
    for (int a = 0; a < 2; ++a)
#pragma unroll
        for (int b = 0; b < 2; ++b)
#pragma unroll
            for (int m = 0; m < 4; ++m)
#pragma unroll
                for (int n = 0; n < 2; ++n) acc[a][b][m][n] = (f32x4){0.f, 0.f, 0.f, 0.f};
    bf16x8 At[4][2], B0[2][2], B1[2][2];
    const char* cA = (const char*)g.A + (size_t)cur.pm * tstep + ((Sched::HALF_TAIL && cur.hm > 0) ? hstep : 0); const char* cB = (const char*)g.Bt + (size_t)cur.pn * tstep;
    size_t cHs = (Sched::HALF_TAIL && cur.hm >= 0) ? 0 : hstep;
    S.a_ready(cur);
    if constexpr (SP2) {
        PG8_STAGE(PG8_SB(0, 0), cB, voffB); PG8_STAGE(PG8_SB(0, 1), cB + hstep, voffB); PG8_STAGE(PG8_SA(0, 0), cA, voffA); PG8_STAGE(PG8_SA(0, 1), cA + cHs, voffA);
        if (wr == 1) PG8_BAR;
        PG8_WAIT_V(2); PG8_BAR;
        PG8_STAGE(PG8_SB(1, 0), cB + kstep, voffB); PG8_STAGE(PG8_SA(1, 0), cA + kstep, voffA); PG8_STAGE(PG8_SB(1, 1), cB + hstep + kstep, voffB);
        PG8_WAIT_V(6); PG8_BAR;
    } else {
        PG8_STAGE(PG8_SB(0, 0), cB, voffB); PG8_STAGE(PG8_SA(0, 0), cA, voffA); PG8_STAGE(PG8_SB(0, 1), cB + hstep, voffB); PG8_STAGE(PG8_SA(0, 1), cA + cHs, voffA);
        if (wr == 1) PG8_BAR;
        PG8_WAIT_V(4); PG8_BAR;
        PG8_STAGE(PG8_SB(1, 0), cB + kstep, voffB); PG8_STAGE(PG8_SA(1, 0), cA + kstep, voffA); PG8_STAGE(PG8_SB(1, 1), cB + hstep + kstep, voffB);
        PG8_WAIT_V(6); PG8_BAR;
    }
    for (;;) {
        const bool has_next = S.next(ui + 1, nxt);
        const char* nA = has_next ? (const char*)g.A + (size_t)nxt.pm * tstep + ((Sched::HALF_TAIL && nxt.hm > 0) ? hstep : 0) : cA; const char* nB = has_next ? (const char*)g.Bt + (size_t)nxt.pn * tstep : cB;
        const size_t nHs = (Sched::HALF_TAIL && has_next && nxt.hm >= 0) ? 0 : (has_next ? hstep : cHs);
        const bool curHalf = Sched::HALF_TAIL && cur.hm >= 0;
        if (!curHalf) {
        for (int t = 0; t < nt; t += 2) {
            const bool last = (t == nt - 2);
            const char* a1 = cA + (size_t)(t + 1) * kstep;
            const char* a2 = last ? nA : cA + (size_t)(t + 2) * kstep; const char* b2 = last ? nB : cB + (size_t)(t + 2) * kstep;
            const char* a3 = a2 + kstep; const char* b3 = b2 + kstep;
            const size_t hs2 = last ? nHs : cHs;
            if (last && has_next) S.a_ready(nxt);
            if constexpr (SP2) {
            PG8_LDB(B0, 0, 0); PG8_LDB(B1, 0, 1); PG8_SCHED; PG8_LDA(At, 0, 0); PG8_STAGE(PG8_SA(1, 1), a1 + cHs, voffA);
            PG8_WAIT_V(8); PG8_WAIT_L(0); PG8_BAR; PG8_MMA(0, 0, At, B0); PG8_MMA(0, 1, At, B1); PG8_BAR; PG8_SCHED;
            PG8_LDA(At, 0, 1);
            PG8_STAGE(PG8_SB(0, 0), b2, voffB); PG8_STAGE(PG8_SB(0, 1), b2 + hstep, voffB); PG8_STAGE(PG8_SA(0, 0), a2, voffA);
            PG8_WAIT_V(8); PG8_WAIT_L(0); PG8_BAR; PG8_MMA(1, 0, At, B0); PG8_MMA(1, 1, At, B1); PG8_BAR; PG8_SCHED;
            PG8_LDB(B0, 1, 0); PG8_LDB(B1, 1, 1); PG8_SCHED; PG8_LDA(At, 1, 0); PG8_STAGE(PG8_SA(0, 1), a2 + hs2, voffA);
            PG8_WAIT_V(8); PG8_WAIT_L(0); PG8_BAR; PG8_MMA(0, 0, At, B0); PG8_MMA(0, 1, At, B1); PG8_BAR; PG8_SCHED;
            PG8_LDA(At, 1, 1);
            PG8_STAGE(PG8_SB(1, 0), b3, voffB); PG8_STAGE(PG8_SB(1, 1), b3 + hstep, voffB); PG8_STAGE(PG8_SA(1, 0), a3, voffA);
            PG8_WAIT_V(8); PG8_WAIT_L(0); PG8_BAR; PG8_MMA(1, 0, At, B0); PG8_MMA(1, 1, At, B1); PG8_BAR; PG8_SCHED;
            } else {
            PG8_LDB(B0, 0, 0); PG8_SCHED; PG8_LDA(At, 0, 0); PG8_STAGE(PG8_SA(1, 1), a1 + hstep, voffA);
            PG8_WAIT_L(8); PG8_BAR; PG8_WAIT_L(0); PG8_MMA(0, 0, At, B0); PG8_BAR; PG8_SCHED;
            PG8_LDB(B1, 0, 1); PG8_STAGE(PG8_SB(0, 0), b2, voffB);
            PG8_BAR; PG8_WAIT_L(0); PG8_MMA(0, 1, At, B1); PG8_BAR;
            PG8_LDA(At, 0, 1); PG8_STAGE(PG8_SA(0, 0), a2, voffA);
            PG8_BAR; PG8_WAIT_L(0); PG8_MMA(1, 0, At, B0); PG8_BAR; PG8_SCHED;
            PG8_STAGE(PG8_SB(0, 1), b2 + hstep, voffB);
            PG8_WAIT_V(6); PG8_BAR; PG8_MMA(1, 1, At, B1); PG8_BAR;
            PG8_LDB(B0, 1, 0); PG8_SCHED; PG8_LDA(At, 1, 0); PG8_STAGE(PG8_SA(0, 1), a2 + hstep, voffA);
            PG8_WAIT_L(8); PG8_BAR; PG8_WAIT_L(0); PG8_MMA(0, 0, At, B0); PG8_BAR; PG8_SCHED;
            PG8_LDB(B1, 1, 1); PG8_STAGE(PG8_SB(1, 0), b3, voffB);
            PG8_BAR; PG8_WAIT_L(0); PG8_MMA(0, 1, At, B1); PG8_BAR;
            PG8_LDA(At, 1, 1); PG8_STAGE(PG8_SA(1, 0), a3, voffA);
            PG8_BAR; PG8_WAIT_L(0); PG8_MMA(1, 0, At, B0); PG8_BAR; PG8_SCHED;
            PG8_STAGE(PG8_SB(1, 1), b3 + hstep, voffB);
            PG8_WAIT_V(6); PG8_BAR; PG8_MMA(1, 1, At, B1); PG8_BAR;
            }
        }
        } else if constexpr (Sched::HALF_TAIL) {
        for (int t = 0; t < nt; t += 2) {
            const bool last = (t == nt - 2);
            const char* a1 = cA + (size_t)(t + 1) * kstep;
            const char* a2 = last ? nA : cA + (size_t)(t + 2) * kstep; const char* b2 = last ? nB : cB + (size_t)(t + 2) * kstep;
            const char* a3 = a2 + kstep; const char* b3 = b2 + kstep;
            const size_t hs2 = last ? nHs : cHs;
            if (last && has_next) S.a_ready(nxt);
            if constexpr (SP2) {
            PG8_LDB(B0, 0, 0); PG8_LDB(B1, 0, 1); PG8_SCHED; PG8_LDA(At, 0, 0); PG8_STAGE(PG8_SA(1, 1), a1 + cHs, voffA);
            PG8_WAIT_V(8); PG8_WAIT_L(0); PG8_BAR; PG8_MMA(0, 0, At, B0); PG8_MMA(0, 1, At, B1); PG8_BAR; PG8_SCHED;
            PG8_STAGE(PG8_SB(0, 0), b2, voffB); PG8_STAGE(PG8_SB(0, 1), b2 + hstep, voffB); PG8_STAGE(PG8_SA(0, 0), a2, voffA);
            PG8_WAIT_V(8); PG8_WAIT_L(0); PG8_BAR; PG8_BAR; PG8_SCHED;
            PG8_LDB(B0, 1, 0); PG8_LDB(B1, 1, 1); PG8_SCHED; PG8_LDA(At, 1, 0); PG8_STAGE(PG8_SA(0, 1), a2 + hs2, voffA);
            PG8_WAIT_V(8); PG8_WAIT_L(0); PG8_BAR; PG8_MMA(0, 0, At, B0); PG8_MMA(0, 1, At, B1); PG8_BAR; PG8_SCHED;
            PG8_STAGE(PG8_SB(1, 0), b3, voffB); PG8_STAGE(PG8_SB(1, 1), b3 + hstep, voffB); PG8_STAGE(PG8_SA(1, 0), a3, voffA);
            PG8_WAIT_V(8); PG8_WAIT_L(0); PG8_BAR; PG8_BAR; PG8_SCHED;
            } else {
            PG8_LDB(B0, 0, 0); PG8_SCHED; PG8_LDA(At, 0, 0); PG8_STAGE(PG8_SA(1, 1), a1 + hstep, voffA);
            PG8_WAIT_L(8); PG8_BAR; PG8_WAIT_L(0); PG8_MMA(0, 0, At, B0); PG8_BAR; PG8_SCHED;
            PG8_LDB(B1, 0, 1); PG8_STAGE(PG8_SB(0, 0), b2, voffB);
            PG8_BAR; PG8_WAIT_L(0); PG8_MMA(0, 1, At, B1); PG8_BAR;
            PG8_LDA(At, 0, 1); PG8_STAGE(PG8_SA(0, 0), a2, voffA);
            PG8_BAR; PG8_WAIT_L(0); PG8_MMA(1, 0, At, B0); PG8_BAR; PG8_SCHED;
            PG8_STAGE(PG8_SB(0, 1), b2 + hstep, voffB);
            PG8_WAIT_V(6); PG8_BAR; PG8_MMA(1, 1, At, B1); PG8_BAR;
            PG8_LDB(B0, 1, 0); PG8_SCHED; PG8_LDA(At, 1, 0); PG8_STAGE(PG8_SA(0, 1), a2 + hstep, voffA);
            PG8_WAIT_L(8); PG8_BAR; PG8_WAIT_L(0); PG8_MMA(0, 0, At, B0); PG8_BAR; PG8_SCHED;
            PG8_LDB(B1, 1, 1); PG8_STAGE(PG8_SB(1, 0), b3, voffB);
            PG8_BAR; PG8_WAIT_L(0); PG8_MMA(0, 1, At, B1); PG8_BAR;
            PG8_LDA(At, 1, 1); PG8_STAGE(PG8_SA(1, 0), a3, voffA);
            PG8_BAR; PG8_WAIT_L(0); PG8_MMA(1, 0, At, B0); PG8_BAR; PG8_SCHED;
            PG8_STAGE(PG8_SB(1, 1), b3 + hstep, voffB);
            PG8_WAIT_V(6); PG8_BAR; PG8_MMA(1, 1, At, B1); PG8_BAR;
            }
        }
        }
        if constexpr (ALIGN_EPI) { if (wr == 0) PG8_BAR; }
        if constexpr (!Epi::AFTER_DRAIN) { E(acc, cur, wr, wc, fr, fq); S.done(cur); }
        if (!has_next) break;
#pragma unroll
        for (int a = 0; a < 2; ++a)
#pragma unroll
            for (int b = 0; b < 2; ++b)
#pragma unroll
                for (int m = 0; m < 4; ++m)
#pragma unroll
                    for (int n = 0; n < 2; ++n) acc[a][b][m][n] = (f32x4){0.f, 0.f, 0.f, 0.f};
        cur = nxt; cA = nA; cB = nB; cHs = nHs; ++ui;
        if constexpr (ALIGN_EPI) { if (wr == 1) PG8_BAR; }
    }
    PG8_WAIT_V(0);
    if constexpr (!ALIGN_EPI) { if (wr == 0) PG8_BAR; }
    PG8_BAR;
    if constexpr (Epi::AFTER_DRAIN) { E.fused(acc, cur, wr, wc, fr, fq, lds, wid, lane); S.done(cur); }
#undef PG8_SA
#undef PG8_SB
#undef PG8_STAGE
#undef PG8_LDA
#undef PG8_LDB
#undef PG8_MMA
#undef PG8_WAIT_V
#undef PG8_WAIT_L
#undef PG8_BAR
#undef PG8_SCHED
}
}

__device__ __forceinline__ void transpose_item(const float* W, int K, int N, bf16_t* WT, const float* scale, float mulhi, int khi,
                                               LAS float* scr, int item, int lane, const float* fold = nullptr) {
    const int nblk = N / 32, kb = item / nblk, nb = item % nblk, k0 = 64 * kb, n0 = 32 * nb;
    if (fold != nullptr && n0 < 256) {
        const int g = n0 >> 6, dd = (n0 & 63) + (lane & 31);
        const float* wp = fold + (size_t)g * 64 * 64 + dd;
        float wpv[64];
#pragma unroll
        for (int c = 0; c < 64; ++c) wpv[c] = wp[c * 64];
#pragma unroll 2
        for (int i = 0; i < 32; ++i) {
            const int kk = 2 * i + (lane >> 5);
            const f32x4* wr = (const f32x4*)(W + (size_t)(k0 + kk) * N + g * 64);
            float a = 0.f;
#pragma unroll
            for (int c = 0; c < 16; ++c) { const f32x4 w4 = wr[c]; a += w4.x * wpv[4 * c] + w4.y * wpv[4 * c + 1] + w4.z * wpv[4 * c + 2] + w4.w * wpv[4 * c + 3]; }
            scr[kk * 33 + (lane & 31)] = a * scale[k0 + kk];
        }
    } else {
#pragma unroll 8
    for (int i = 0; i < 32; ++i) {
        const int kk = 2 * i + (lane >> 5);
        float s = scale[k0 + kk]; if (k0 + kk >= khi) s *= mulhi;
        scr[kk * 33 + (lane & 31)] = __builtin_nontemporal_load(W + (size_t)(k0 + kk) * N + n0 + (lane & 31)) * s;
    }
    }
    asm volatile("s_waitcnt lgkmcnt(0)" ::: "memory");
    const int c = lane & 7;
#pragma unroll
    for (int j = 0; j < 4; ++j) {
        const int n = (lane >> 3) + 8 * j; const LAS float* s = scr + (8 * c) * 33 + n;
        u32x4 o; o.x = pk2(s[0 * 33], s[1 * 33]); o.y = pk2(s[2 * 33], s[3 * 33]); o.z = pk2(s[4 * 33], s[5 * 33]); o.w = pk2(s[6 * 33], s[7 * 33]);
        *(u32x4*)(WT + (size_t)(n0 + n) * K + k0 + 8 * c) = o;
    }
    asm volatile("s_waitcnt lgkmcnt(0)" ::: "memory");
}

__device__ __forceinline__ void rms_row_to_bf16(const float* xrow, bf16_t* orow, int lane) {
    const f32x4* xr = (const f32x4*)xrow + lane;
    f32x4 v[4]; float s = 0.f;
#pragma unroll
    for (int j = 0; j < 4; ++j) { v[j] = xr[64 * j]; s += (v[j].x * v[j].x + v[j].y * v[j].y) + (v[j].z * v[j].z + v[j].w * v[j].w); }
    const float rstd = rsqrtf(wave_sum(s) * (1.f / DM) + EPS);
    u32x2* o8 = (u32x2*)orow + lane;
#pragma unroll
    for (int j = 0; j < 4; ++j) { u32x2 o; o.x = pk2(v[j].x * rstd, v[j].y * rstd); o.y = pk2(v[j].z * rstd, v[j].w * rstd); o8[64 * j] = o; }
}

__device__ __forceinline__ void phase_prep(int wv0, LAS unsigned char* lds) {
    FRESH_PARAMS; FRESH_IDS;
    LAS float* scr = (LAS float*)(lds + wave * 16384);
    bf16_t* WinT = (bf16_t*)(p.ws + WS_WIN); bf16_t* WoutT = (bf16_t*)(p.ws + WS_WOUT); bf16_t* WqT = (bf16_t*)(p.ws + WS_WQ);
    constexpr int I_IN = 16 * 72, I_OUT = 16 * 32, I_Q = 16 * 64, I_L = I_IN + I_OUT + I_Q;
    for (int it = gw; it < DEPTH * I_L; it += ngw) {
        const int l = it / I_L; int r = it % I_L;
        if (r < I_IN) { transpose_item(p.w_in + (size_t)l * DM * NZ, DM, NZ, WinT + (size_t)l * NZ * DM, p.norm1_g + l * DM, 1.f, 1 << 30, scr, r, lane, USE_POOLFOLD ? p.w_pool + (size_t)l * 4 * 64 * 64 : nullptr); continue; }
        r -= I_IN;
        if (r < I_OUT) { transpose_item(p.w_out + (size_t)l * DM * DM, DM, DM, WoutT + (size_t)l * DM * DM, p.out_norm_g + l * DM, 1.f - lam_init_of(l), 768, scr, r, lane); continue; }
        r -= I_OUT;
        transpose_item(p.w_query + (size_t)l * DM * NQ, DM, NQ, WqT + (size_t)l * NQ * DM, p.norm2_g + l * DM, 1.f, 1 << 30, scr, r, lane);
    }
    {
        bf16_t* SK = (bf16_t*)(p.ws + WS_SK);
        for (int i = gw * 64 + lane; i < DEPTH * 2 * 128 * 128; i += ngw * 64) SK[i] = (bf16_t)f2bf(p.sub_keys[i]);
    }
    bf16_t* XN = (bf16_t*)(p.ws + WS_XN);
    {
        float* RS = (float*)(p.ws + WS_RSTD);
#pragma unroll 1
        for (int m0 = 4 * gw; m0 < T; m0 += 4 * ngw) {
            f32x4 vb[4][4];
#pragma unroll
            for (int bi = 0; bi < 4; ++bi) { const f32x4* xr = (const f32x4*)(p.x + (size_t)(m0 + bi) * DM) + lane;
#pragma unroll
                for (int jj = 0; jj < 4; ++jj) vb[bi][jj] = __builtin_nontemporal_load(xr + 64 * jj); }
#pragma unroll
            for (int bi = 0; bi < 4; ++bi) { const int m = m0 + bi;
                float sq = 0.f;
#pragma unroll
                for (int jj = 0; jj < 4; ++jj) { const f32x4 v = vb[bi][jj]; sq += (v.x * v.x + v.y * v.y) + (v.z * v.z + v.w * v.w); }
                const float rstd = rsqrtf(wave_sum(sq) * (1.f / DM) + EPS);
                u32x2* o8 = (u32x2*)(XN + (size_t)m * DM) + lane;
#pragma unroll
                for (int jj = 0; jj < 4; ++jj) { const f32x4 v = vb[bi][jj]; u32x2 o; o.x = pk2(v.x, v.y); o.y = pk2(v.z, v.w); o8[64 * jj] = o; }
                if (lane == 0) RS[m] = rstd;
            }
        }
    }
    if (gw == 0) {
        float* misc = (float*)(p.ws + WS_MISC);
        for (int l = 0; l < DEPTH; ++l) {
            float a = 0.f, b = 0.f, gq = 0.f, gk = 0.f;
            if (lane < 32) { a = p.lam_q1[l * 32 + lane] * p.lam_k1[l * 32 + lane]; b = p.lam_q2[l * 32 + lane] * p.lam_k2[l * 32 + lane];
                             gq = fabsf(p.diff_q_norm[l * 32 + lane]); gk = fabsf(p.diff_k_norm[l * 32 + lane]); }
            a = wave_sum(a); b = wave_sum(b); gq = wave_max(gq); gk = wave_max(gk);
            const float sq = wave_max(fabsf(p.swa_q_norm[l * 64 + lane])), sk = wave_max(fabsf(p.swa_k_norm[l * 64 + lane]));
            if (lane == 0) {
                misc[l * 16 + 0] = __expf(a) - __expf(b) + lam_init_of(l);
                misc[l * 16 + 1] = 32.f * 0.17677669529663687f * gq * gk * 1.02f + 0.05f;
                misc[l * 16 + 2] = 64.f * 0.125f * sq * sk * 1.02f + 0.05f;
            }
        }
    }
}

struct EpiStoreBf16 { bf16_t* O; int ldc; __device__ __forceinline__ void operator()(int row, int col, float v) const { O[(size_t)row * ldc + col] = (bf16_t)f2bf(v); } };
struct EpiResidual { const float* base; float* out; int ldc; __device__ __forceinline__ void operator()(int row, int col, float v) const { const size_t o = (size_t)row * ldc + col; out[o] = base[o] + v; } };

template <class Epi>
__device__ __forceinline__ void gemm_simple(const bf16_t* A, const bf16_t* Bt, int M, int N, int K, const Epi& E, int gw, int ngw, int lane) {
    const int r = lane & 31, h = lane >> 5;
    const int ntn = N / 64, ntiles = (M / 64) * ntn;
    for (int tile = gw; tile < ntiles; tile += ngw) {
        const int m0 = (tile / ntn) * 64, n0 = (tile % ntn) * 64;
        f32x16 acc[2][2];
#pragma unroll
        for (int i = 0; i < 2; ++i)
#pragma unroll
            for (int j = 0; j < 2; ++j)
#pragma unroll
                for (int q = 0; q < 16; ++q) acc[i][j][q] = 0.f;
        const bf16_t* a0 = A + (size_t)(m0 + r) * K + 8 * h; const bf16_t* a1 = a0 + (size_t)32 * K;
        const bf16_t* b0 = Bt + (size_t)(n0 + r) * K + 8 * h; const bf16_t* b1 = b0 + (size_t)32 * K;
#pragma unroll 2
        for (int k = 0; k < K; k += 16) {
            const bf16x8 fa0 = *(const bf16x8*)(a0 + k), fa1 = *(const bf16x8*)(a1 + k), fb0 = *(const bf16x8*)(b0 + k), fb1 = *(const bf16x8*)(b1 + k);
            acc[0][0] = MFMA32(fa0, fb0, acc[0][0]); acc[0][1] = MFMA32(fa0, fb1, acc[0][1]);
            acc[1][0] = MFMA32(fa1, fb0, acc[1][0]); acc[1][1] = MFMA32(fa1, fb1, acc[1][1]);
        }
#pragma unroll
        for (int i = 0; i < 2; ++i)
#pragma unroll
            for (int j = 0; j < 2; ++j)
#pragma unroll
                for (int q = 0; q < 16; ++q) E(m0 + 32 * i + crow(q, h), n0 + 32 * j + r, acc[i][j][q]);
    }
}

__device__ __forceinline__ void phase_qknorm(int wv0, int l) {
    FRESH_PARAMS; FRESH_IDS;
    bf16_t* z = (bf16_t*)(p.ws + WS_Z);
    for (int idx = gtid; idx < T * 22; idx += gthreads) {
        const int t = idx / 22, u = idx % 22;
        int col, W; const float* g; float sc;
        if (u < 4) { col = ZC_QB + 64 * u; W = 64; g = p.swa_q_norm + l * 64; sc = 0.125f; }
        else if (u < 6) { col = ZC_KB + 64 * (u - 4); W = 64; g = p.swa_k_norm + l * 64; sc = 1.f; }
        else if (u < 14) { col = ZC_QD + 32 * (u - 6); W = 32; g = p.diff_q_norm + l * 32; sc = 0.17677669529663687f; }
        else { col = ZC_KD + 32 * (u - 14); W = 32; g = p.diff_k_norm + l * 32; sc = 1.f; }
        u32x4* ptr = (u32x4*)(z + (size_t)t * NZ + col);
        float ss = 0.f;
#pragma unroll 1
        for (int c = 0; c < W / 8; ++c) { float f[8]; unpack8(ptr[c], f);
#pragma unroll
            for (int i = 0; i < 8; ++i) ss += f[i] * f[i]; }
        const float rn = rsqrtf(ss / (float)W + EPS) * sc;
#pragma unroll 1
        for (int c = 0; c < W / 8; ++c) { float f[8]; unpack8(ptr[c], f); u32x4 o;
            const float* gg = g + 8 * c;
            o.x = pk2(f[0] * rn * gg[0], f[1] * rn * gg[1]); o.y = pk2(f[2] * rn * gg[2], f[3] * rn * gg[3]);
            o.z = pk2(f[4] * rn * gg[4], f[5] * rn * gg[5]); o.w = pk2(f[6] * rn * gg[6], f[7] * rn * gg[7]);
            ptr[c] = o; }
    }
}

#define DPP_MOV(v, CTRL) __builtin_bit_cast(float, __builtin_amdgcn_update_dpp(__builtin_bit_cast(int, (v)), __builtin_bit_cast(int, (v)), (CTRL), 0xf, 0xf, false))
#define DPP_ADD8(v) do { (v) += DPP_MOV((v), 0xB1); (v) += DPP_MOV((v), 0x4E); (v) += DPP_MOV((v), 0x141); } while (0)
__device__ __forceinline__ void phase_poolconv3(int wv0, int l) {
    FRESH_PARAMS; FRESH_IDS;
    const bf16_t* z = (const bf16_t*)(p.ws + WS_Z); bf16_t* y = (bf16_t*)(p.ws + WS_Y);
    const int oc = lane & 7, tk = lane >> 3;
#pragma unroll 1
    for (int u = gw; u < (T / 8) * 4; u += ngw) {
        const int g = u & 3, t = (u >> 2) * 8 + tk, pos = t & (SEQ - 1);
        const int win = 2 << g, cnt = (pos + 1 < win) ? pos + 1 : win;
        const bf16_t* zp = z + (size_t)t * NZ + ZC_PA + g * 64 + 8 * oc;
        float cur[8], sm[8];
        unpack8(*(const u32x4*)zp, cur);
#pragma unroll
        for (int q = 0; q < 8; ++q) sm[q] = cur[q];
        u32x4 wrow[15];
#pragma unroll
        for (int jj = 1; jj < 16; ++jj) wrow[jj - 1] = (jj < cnt) ? *(const u32x4*)(zp - (size_t)jj * NZ) : (u32x4){0u, 0u, 0u, 0u};
#pragma unroll
        for (int jj = 1; jj < 16; ++jj) { float f[8]; unpack8(wrow[jj - 1], f);
#pragma unroll
            for (int q = 0; q < 8; ++q) sm[q] += f[q]; }
        const float ic = 1.f / (float)cnt;
        float d[8], ss = 0.f;
#pragma unroll
        for (int q = 0; q < 8; ++q) { d[q] = sm[q] * ic - cur[q]; ss += d[q] * d[q]; }
        DPP_ADD8(ss);
        const float rn = rsqrtf(ss * (1.f / 64.f) + EPS);
        u32x4 o; o.x = pk2(d[0] * rn, d[1] * rn); o.y = pk2(d[2] * rn, d[3] * rn); o.z = pk2(d[4] * rn, d[5] * rn); o.w = pk2(d[6] * rn, d[7] * rn);
        *(u32x4*)(y + (size_t)t * DM + g * 64 + 8 * oc) = o;
    }
    {
        const int oc32 = lane & 31, tp = lane >> 5;
        f32x4 cwa[3], cwb[3];
#pragma unroll
        for (int k = 0; k < 3; ++k) { cwa[k] = *(const f32x4*)(p.conv_w + (l * 3 + k) * 256 + 8 * oc32); cwb[k] = *(const f32x4*)(p.conv_w + (l * 3 + k) * 256 + 8 * oc32 + 4); }
#pragma unroll 1
        for (int u = gw; u < T / 4; u += ngw) {
            const int ta = u * 4 + 2 * tp, pa = ta & (SEQ - 1);
            const bf16_t* zr = z + (size_t)ta * NZ + 8 * oc32;
            float zc[4][8];
#pragma unroll
            for (int k = 0; k < 4; ++k) {
                if (pa + k - 2 >= 0) { float fc[8], fh[8]; unpack8(*(const u32x4*)(zr + (size_t)(k - 2) * NZ + ZC_CC), fc); unpack8(*(const u32x4*)(zr + (size_t)(k - 2) * NZ + ZC_HC), fh);
#pragma unroll
                    for (int q = 0; q < 8; ++q) zc[k][q] = fc[q] * fh[q]; }
                else {
#pragma unroll
                    for (int q = 0; q < 8; ++q) zc[k][q] = 0.f; }
            }
#pragma unroll
            for (int k = 0; k < 2; ++k) {
                float fb[8]; unpack8(*(const u32x4*)(zr + (size_t)k * NZ + ZC_BC), fb);
                float yc[8], ss = 0.f;
#pragma unroll
                for (int q = 0; q < 8; ++q) {
                    const float c0 = q < 4 ? cwa[0][q & 3] : cwb[0][q & 3], c1 = q < 4 ? cwa[1][q & 3] : cwb[1][q & 3], c2 = q < 4 ? cwa[2][q & 3] : cwb[2][q & 3];
                    yc[q] = fb[q] * (c0 * zc[k][q] + c1 * zc[k + 1][q] + c2 * zc[k + 2][q]); ss += yc[q] * yc[q];
                }
                DPP_ADD8(ss);
                const float rn = rsqrtf(ss * (1.f / 64.f) + EPS);
                u32x4 o; o.x = pk2(yc[0] * rn, yc[1] * rn); o.y = pk2(yc[2] * rn, yc[3] * rn); o.z = pk2(yc[4] * rn, yc[5] * rn); o.w = pk2(yc[6] * rn, yc[7] * rn);
                *(u32x4*)(y + (size_t)(ta + k) * DM + 512 + 8 * oc32) = o;
            }
        }
    }
}

template <int G>
__device__ __forceinline__ void pool_unit4(const bf16_t* z, bf16_t* y, int tbase, int lane) {
    constexpr int WIN = 2 << G, NR = WIN + 7;
    const int oc = lane & 7, t0 = tbase + 8 * (lane >> 3), pos0 = t0 & (SEQ - 1);
    const bf16_t* zp = z + (size_t)t0 * NZ + ZC_PA + G * 64 + 8 * oc;
    u32x4 R[NR];
#pragma unroll
    for (int k = 0; k < NR; ++k) R[k] = (pos0 - (WIN - 1) + k >= 0) ? __builtin_nontemporal_load((const u32x4*)(zp + ((ptrdiff_t)k - (WIN - 1)) * NZ)) : (u32x4){0u, 0u, 0u, 0u};
    float sm[8];
#pragma unroll
    for (int q = 0; q < 8; ++q) sm[q] = 0.f;
#pragma unroll
    for (int k = 0; k < WIN - 1; ++k) { float f[8]; unpack8(R[k], f);
#pragma unroll
        for (int q = 0; q < 8; ++q) sm[q] += f[q]; }
#pragma unroll
    for (int i = 0; i < 8; ++i) {
        float cur[8]; unpack8(R[WIN - 1 + i], cur);
#pragma unroll
        for (int q = 0; q < 8; ++q) sm[q] += cur[q];
        const int pos = pos0 + i, cnt = (pos + 1 < WIN) ? pos + 1 : WIN;
        const float ic = 1.f / (float)cnt;
        float d[8], ss = 0.f;
#pragma unroll
        for (int q = 0; q < 8; ++q) { d[q] = sm[q] * ic - cur[q]; ss += d[q] * d[q]; }
        DPP_ADD8(ss);
        const float rn = rsqrtf(ss * (1.f / 64.f) + EPS);
        u32x4 o; o.x = pk2(d[0] * rn, d[1] * rn); o.y = pk2(d[2] * rn, d[3] * rn); o.z = pk2(d[4] * rn, d[5] * rn); o.w = pk2(d[6] * rn, d[7] * rn);
        *(u32x4*)(y + (size_t)(t0 + i) * DM + G * 64 + 8 * oc) = o;
        { float f[8]; unpack8(R[i], f);
#pragma unroll
          for (int q = 0; q < 8; ++q) sm[q] -= f[q]; }
    }
}
__device__ __forceinline__ void phase_poolconv4(int wv0, int l) {
    FRESH_PARAMS; FRESH_IDS;
    const bf16_t* z = (const bf16_t*)(p.ws + WS_Z); bf16_t* y = (bf16_t*)(p.ws + WS_Y);
#pragma unroll 1
    for (int u = gw; u < (T / 64) * 4; u += ngw) {
        const int g = u & 3, tbase = (u >> 2) * 64;
        if (g == 0) pool_unit4<0>(z, y, tbase, lane); else if (g == 1) pool_unit4<1>(z, y, tbase, lane); else if (g == 2) pool_unit4<2>(z, y, tbase, lane); else pool_unit4<3>(z, y, tbase, lane);
    }
    {
        int ln = lane; asm volatile("" : "+v"(ln));
        const int oc32 = ln & 31, tr = ln >> 5;
        f32x4 cwa[3], cwb[3];
#pragma unroll
        for (int k = 0; k < 3; ++k) { cwa[k] = *(const f32x4*)(p.conv_w + (l * 3 + k) * 256 + 8 * oc32); cwb[k] = *(const f32x4*)(p.conv_w + (l * 3 + k) * 256 + 8 * oc32 + 4); }
#pragma unroll 1
        for (int u = gw; u < T / 16; u += ngw) {
            const int t0 = u * 16 + 8 * tr, pos0 = t0 & (SEQ - 1);
            const bf16_t* zr = z + (size_t)t0 * NZ + 8 * oc32;
            u32x4 rc[10], rh[10], rb[8];
#pragma unroll
            for (int k = 0; k < 10; ++k) {
                const bool ok = pos0 + k - 2 >= 0;
                rc[k] = ok ? __builtin_nontemporal_load((const u32x4*)(zr + ((ptrdiff_t)k - 2) * NZ + ZC_CC)) : (u32x4){0u, 0u, 0u, 0u};
                rh[k] = ok ? __builtin_nontemporal_load((const u32x4*)(zr + ((ptrdiff_t)k - 2) * NZ + ZC_HC)) : (u32x4){0u, 0u, 0u, 0u};
            }
#pragma unroll
            for (int k = 0; k < 8; ++k) rb[k] = __builtin_nontemporal_load((const u32x4*)(zr + (size_t)k * NZ + ZC_BC));
            float z0[8], z1[8];
            { float fc[8], fh[8]; unpack8(rc[0], fc); unpack8(rh[0], fh);
#pragma unroll
              for (int q = 0; q < 8; ++q) z0[q] = fc[q] * fh[q];
              unpack8(rc[1], fc); unpack8(rh[1], fh);
#pragma unroll
              for (int q = 0; q < 8; ++q) z1[q] = fc[q] * fh[q]; }
#pragma unroll
            for (int k = 0; k < 8; ++k) {
                float z2[8], fb[8];
                { float fc[8], fh[8]; unpack8(rc[k + 2], fc); unpack8(rh[k + 2], fh);
#pragma unroll
                  for (int q = 0; q < 8; ++q) z2[q] = fc[q] * fh[q]; }
                unpack8(rb[k], fb);
                float yc[8], ss = 0.f;
#pragma unroll
                for (int q = 0; q < 8; ++q) {
                    const float c0 = q < 4 ? cwa[0][q & 3] : cwb[0][q & 3], c1 = q < 4 ? cwa[1][q & 3] : cwb[1][q & 3], c2 = q < 4 ? cwa[2][q & 3] : cwb[2][q & 3];
                    yc[q] = fb[q] * (c0 * z0[q] + c1 * z1[q] + c2 * z2[q]); ss += yc[q] * yc[q];
                }
                DPP_ADD8(ss);
                const float rn = rsqrtf(ss * (1.f / 64.f) + EPS);
                u32x4 o; o.x = pk2(yc[0] * rn, yc[1] * rn); o.y = pk2(yc[2] * rn, yc[3] * rn); o.z = pk2(yc[4] * rn, yc[5] * rn); o.w = pk2(yc[6] * rn, yc[7] * rn);
                *(u32x4*)(y + (size_t)(t0 + k) * DM + 512 + 8 * oc32) = o;
#pragma unroll
                for (int q = 0; q < 8; ++q) { z0[q] = z1[q]; z1[q] = z2[q]; }
            }
        }
    }
}

constexpr int PC_P_OFF = 0, PC_D_OFF = 48 * 256 * 4;
__device__ __forceinline__ void phase_poolconv(int wv0, int l, LAS unsigned char* lds) {
    FRESH_PARAMS; FRESH_IDS;
    const bf16_t* z = (const bf16_t*)(p.ws + WS_Z); bf16_t* y = (bf16_t*)(p.ws + WS_Y);
    LAS float* P = (LAS float*)(lds + PC_P_OFF); LAS float* dl = (LAS float*)(lds + PC_D_OFF);
    const int ch = tid & 255, half = tid >> 8, g = ch >> 6, dd = ch & 63;
    const int win = 2 << g;
    float w[64];
#pragma unroll
    for (int c = 0; c < 64; ++c) w[c] = p.w_pool[((size_t)(l * 4 + g) * 64 + c) * 64 + dd];
    const int oc = tid & 31, tp = tid >> 5;
    f32x4 cwa[3], cwb[3];
#pragma unroll
    for (int k = 0; k < 3; ++k) { cwa[k] = *(const f32x4*)(p.conv_w + (l * 3 + k) * 256 + 8 * oc); cwb[k] = *(const f32x4*)(p.conv_w + (l * 3 + k) * 256 + 8 * oc + 4); }
#pragma unroll 1
    for (int tile = bid; tile < T / 32; tile += nblk) {
        const int t0 = tile * 32, pos0 = t0 & (SEQ - 1);
#pragma unroll
        for (int k = 0; k < 3; ++k) {
            const int idx = tid + 512 * k;
            if (idx < 47 * 32) {
                const int row = idx >> 5, c8 = idx & 31;
                float f[8];
                if (pos0 + row - 15 >= 0) unpack8(*(const u32x4*)(z + (size_t)(t0 + row - 15) * NZ + ZC_PA + 8 * c8), f);
                else {
#pragma unroll
                    for (int q = 0; q < 8; ++q) f[q] = 0.f; }
                *(LAS f32x4*)(P + row * 256 + 8 * c8) = (f32x4){f[0], f[1], f[2], f[3]};
                *(LAS f32x4*)(P + row * 256 + 8 * c8 + 4) = (f32x4){f[4], f[5], f[6], f[7]};
            }
        }
        {
            const int ta = t0 + 2 * tp, pa = pos0 + 2 * tp;
            const bf16_t* zr = z + (size_t)ta * NZ + 8 * oc;
            float zc[4][8];
#pragma unroll
            for (int k = 0; k < 4; ++k) {
                if (pa + k - 2 >= 0) { float fc[8], fh[8]; unpack8(*(const u32x4*)(zr + (size_t)(k - 2) * NZ + ZC_CC), fc); unpack8(*(const u32x4*)(zr + (size_t)(k - 2) * NZ + ZC_HC), fh);
#pragma unroll
                    for (int q = 0; q < 8; ++q) zc[k][q] = fc[q] * fh[q]; }
                else {
#pragma unroll
                    for (int q = 0; q < 8; ++q) zc[k][q] = 0.f; }
            }
#pragma unroll
            for (int k = 0; k < 2; ++k) {
                float fb[8]; unpack8(*(const u32x4*)(zr + (size_t)k * NZ + ZC_BC), fb);
                float yc[8], ss = 0.f;
#pragma unroll
                for (int q = 0; q < 8; ++q) {
                    const float c0 = q < 4 ? cwa[0][q & 3] : cwb[0][q & 3], c1 = q < 4 ? cwa[1][q & 3] : cwb[1][q & 3], c2 = q < 4 ? cwa[2][q & 3] : cwb[2][q & 3];
                    yc[q] = fb[q] * (c0 * zc[k][q] + c1 * zc[k + 1][q] + c2 * zc[k + 2][q]); ss += yc[q] * yc[q];
                }
                ss += __shfl_xor(ss, 1); ss += __shfl_xor(ss, 2); ss += __shfl_xor(ss, 4);
                const float rn = rsqrtf(ss * (1.f / 64.f) + EPS);
                u32x4 o; o.x = pk2(yc[0] * rn, yc[1] * rn); o.y = pk2(yc[2] * rn, yc[3] * rn); o.z = pk2(yc[4] * rn, yc[5] * rn); o.w = pk2(yc[6] * rn, yc[7] * rn);
                *(u32x4*)(y + (size_t)(ta + k) * DM + 512 + 8 * oc) = o;
            }
        }
        __syncthreads();
        {
            const int tl0 = half * 16;
            float sum = 0.f;
#pragma unroll 1
            for (int jj = 0; jj < win; ++jj) sum += P[(15 + tl0 - jj) * 256 + ch];
#pragma unroll 1
            for (int i = 0; i < 16; ++i) {
                const int tl = tl0 + i, pos = pos0 + tl;
                const int cnt = (pos + 1 < win) ? pos + 1 : win;
                const float cur = P[(15 + tl) * 256 + ch];
                dl[tl * 256 + ch] = sum / (float)cnt - cur;
                if (i < 15) sum += P[(16 + tl) * 256 + ch] - P[(16 + tl - win) * 256 + ch];
            }
        }
        __syncthreads();
#pragma unroll 1
        for (int i = 0; i < 16; ++i) {
            const int tl = half * 16 + i;
            float acc = 0.f;
#pragma unroll
            for (int c = 0; c < 64; c += 4) { const f32x4 dv = *(const LAS f32x4*)(dl + tl * 256 + g * 64 + c);
                acc += dv.x * w[c] + dv.y * w[c + 1] + dv.z * w[c + 2] + dv.w * w[c + 3]; }
            const float ss = wave_sum(acc * acc);
            const float rn = rsqrtf(ss * (1.f / 64.f) + EPS);
            y[(size_t)(t0 + tl) * DM + ch] = (bf16_t)f2bf(acc * rn);
        }
        __syncthreads();
    }
}

__device__ __forceinline__ void phase_swa_naive(int wv0, int l) {
    FRESH_PARAMS; FRESH_IDS;
    const bf16_t* z = (const bf16_t*)(p.ws + WS_Z); bf16_t* y = (bf16_t*)(p.ws + WS_Y);
    const float* misc = (const float*)(p.ws + WS_MISC);
    const float bound = misc[l * 16 + 2];
    for (int idx = gtid; idx < BATCH * 4 * SEQ * 4; idx += gthreads) {
        const int dg = idx & 3, q = (idx >> 2) & (SEQ - 1), hq = (idx >> 13) & 3, b = idx >> 15;
        const int hkv = hq >> 1;
        const float slope = exp2f(-(float)(hq + 1));
        const float sink = p.swa_sinks[l * 4 + hq];
        const float mx = fmaxf(bound, sink);
        float qf[64];
        { const u32x4* qp = (const u32x4*)(z + (size_t)(b * SEQ + q) * NZ + ZC_QB + hq * 64);
#pragma unroll
          for (int c = 0; c < 8; ++c) unpack8(qp[c], qf + 8 * c); }
        float lsum = 0.f, o[16];
#pragma unroll
        for (int i = 0; i < 16; ++i) o[i] = 0.f;
        const bf16_t* kbase = z + (size_t)(b * SEQ) * NZ + ZC_KB + hkv * 64;
        const bf16_t* vbase = z + (size_t)(b * SEQ) * NZ + ZC_VB + hkv * 64 + dg * 16;
        const int s0 = (q - 127 > 0) ? q - 127 : 0;
#pragma unroll 1
        for (int s = s0; s <= q; ++s) {
            const u32x4* kp = (const u32x4*)(kbase + (size_t)s * NZ);
            float sc = 0.f;
#pragma unroll
            for (int c = 0; c < 8; ++c) { float f[8]; unpack8(kp[c], f);
#pragma unroll
                for (int i = 0; i < 8; ++i) sc += f[i] * qf[8 * c + i]; }
            const float pr = __expf(sc - slope * (float)(q - s) - mx);
            lsum += pr;
            const u32x4* vp = (const u32x4*)(vbase + (size_t)s * NZ);
            float vf[16]; unpack8(vp[0], vf); unpack8(vp[1], vf + 8);
#pragma unroll
            for (int i = 0; i < 16; ++i) o[i] += pr * vf[i];
        }
        lsum += __expf(sink - mx);
        const float inv = 1.f / lsum;
        float ss = 0.f;
#pragma unroll
        for (int i = 0; i < 16; ++i) { o[i] *= inv; ss += o[i] * o[i]; }
        ss += __shfl_xor(ss, 1); ss += __shfl_xor(ss, 2);
        const float rn = rsqrtf(ss * (1.f / 64.f) + EPS);
        u32x4 w0, w1;
        w0.x = pk2(o[0] * rn, o[1] * rn); w0.y = pk2(o[2] * rn, o[3] * rn); w0.z = pk2(o[4] * rn, o[5] * rn); w0.w = pk2(o[6] * rn, o[7] * rn);
        w1.x = pk2(o[8] * rn, o[9] * rn); w1.y = pk2(o[10] * rn, o[11] * rn); w1.z = pk2(o[12] * rn, o[13] * rn); w1.w = pk2(o[14] * rn, o[15] * rn);
        u32x4* yo = (u32x4*)(y + (size_t)(b * SEQ + q) * DM + 256 + hq * 64 + dg * 16);
        yo[0] = w0; yo[1] = w1;
    }
}

__device__ __forceinline__ void phase_diff_naive(int wv0, int l) {
    FRESH_PARAMS; FRESH_IDS;
    const bf16_t* z = (const bf16_t*)(p.ws + WS_Z); bf16_t* y = (bf16_t*)(p.ws + WS_Y);
    const float* misc = (const float*)(p.ws + WS_MISC);
    const float lam = misc[l * 16 + 0], bound = misc[l * 16 + 1];
    for (int idx = gtid; idx < BATCH * 4 * SEQ * 4; idx += gthreads) {
        const int dg = idx & 3, q = (idx >> 2) & (SEQ - 1), h = (idx >> 13) & 3, b = idx >> 15;
        const float slope = exp2f(-(float)(h + 5));
        float qf[64];
        { const u32x4* qp = (const u32x4*)(z + (size_t)(b * SEQ + q) * NZ + ZC_QD + h * 64);
#pragma unroll
          for (int c = 0; c < 8; ++c) unpack8(qp[c], qf + 8 * c); }
        float l1 = 0.f, l2 = 0.f, o1[16], o2[16];
#pragma unroll
        for (int i = 0; i < 16; ++i) { o1[i] = 0.f; o2[i] = 0.f; }
        const bf16_t* kbase = z + (size_t)(b * SEQ) * NZ + ZC_KD + h * 64;
        const bf16_t* vbase = z + (size_t)(b * SEQ) * NZ + ZC_VD + h * 64 + dg * 16;
#pragma unroll 1
        for (int s = 0; s <= q; ++s) {
            const u32x4* kp = (const u32x4*)(kbase + (size_t)s * NZ);
            float s1 = 0.f, s2 = 0.f;
#pragma unroll
            for (int c = 0; c < 4; ++c) { float f[8]; unpack8(kp[c], f);
#pragma unroll
                for (int i = 0; i < 8; ++i) s1 += f[i] * qf[8 * c + i]; }
#pragma unroll
            for (int c = 4; c < 8; ++c) { float f[8]; unpack8(kp[c], f);
#pragma unroll
                for (int i = 0; i < 8; ++i) s2 += f[i] * qf[8 * c + i]; }
            const float ab = slope * (float)(q - s) + bound;
            const float p1 = __expf(s1 - ab), p2 = __expf(s2 - ab);
            l1 += p1; l2 += p2;
            const u32x4* vp = (const u32x4*)(vbase + (size_t)s * NZ);
            float vf[16]; unpack8(vp[0], vf); unpack8(vp[1], vf + 8);
#pragma unroll
            for (int i = 0; i < 16; ++i) { o1[i] += p1 * vf[i]; o2[i] += p2 * vf[i]; }
        }
        const float i1 = 1.f / l1, i2 = lam / l2;
        float o[16], ss = 0.f;
#pragma unroll
        for (int i = 0; i < 16; ++i) { o[i] = o1[i] * i1 - o2[i] * i2; ss += o[i] * o[i]; }
        ss += __shfl_xor(ss, 1); ss += __shfl_xor(ss, 2);
        const float rn = rsqrtf(ss * (1.f / 64.f) + EPS);
        u32x4 w0, w1;
        w0.x = pk2(o[0] * rn, o[1] * rn); w0.y = pk2(o[2] * rn, o[3] * rn); w0.z = pk2(o[4] * rn, o[5] * rn); w0.w = pk2(o[6] * rn, o[7] * rn);
        w1.x = pk2(o[8] * rn, o[9] * rn); w1.y = pk2(o[10] * rn, o[11] * rn); w1.z = pk2(o[12] * rn, o[13] * rn); w1.w = pk2(o[14] * rn, o[15] * rn);
        u32x4* yo = (u32x4*)(y + (size_t)(b * SEQ + q) * DM + 768 + h * 64 + dg * 16);
        yo[0] = w0; yo[1] = w1;
    }
}

constexpr int ATT_KBYTES = 8192, ATT_VBYTES = 8192, ATT_BUF = ATT_KBYTES + ATT_VBYTES;
typedef short s16x4 __attribute__((ext_vector_type(4)));
template <bool DIFF>
__device__ __forceinline__ void attn_unit(LAS unsigned char* lds, const bf16_t* z, bf16_t* y, int b, int head, int qblk, float lam, float bound, const float* sinks_l,
                                          const float* gq, const float* gk, int tid, int lane, int wave) {
    asm volatile("" : "+v"(tid), "+v"(lane));
    const int r = lane & 31, h = lane >> 5, tq_ = (lane & 15) >> 2, tp_ = lane & 3;
    const float LOG2E = 1.4426950408889634f;
    int q0, qhead, qcol, kcol, vcol, ycol, kt_lo, kt_hi;
    float slope, mx;
    if (DIFF) { q0 = qblk * 256 + 32 * wave; qhead = head; qcol = ZC_QD + head * 64; kcol = ZC_KD + head * 64; vcol = ZC_VD + head * 64; ycol = 768 + head * 64;
                slope = exp2f(-(float)(head + 5)); mx = bound; kt_lo = 0; kt_hi = 4 * qblk + 3; }
    else { const int gq = wave >> 2; q0 = qblk * 128 + 32 * (wave & 3); qhead = head * 2 + gq; qcol = ZC_QB + qhead * 64; kcol = ZC_KB + head * 64; vcol = ZC_VB + head * 64; ycol = 256 + qhead * 64;
           slope = exp2f(-(float)(qhead + 1)); mx = fmaxf(bound, sinks_l[qhead]); kt_lo = (qblk > 0) ? 2 * qblk - 2 : 0; kt_hi = 2 * qblk + 1; }
    const float slope2 = slope * LOG2E, bound2 = mx * LOG2E;
    const int wkt_hi = (q0 + 31) >> 6;
    int wkt_lo = 0; if (!DIFF) { const int k0 = q0 - 127; wkt_lo = (k0 > 0) ? (k0 >> 6) : 0; }
    const int skey = tid >> 3, sch = tid & 7;
    const bf16_t* srow = z + (size_t)(b * SEQ + skey) * NZ + sch * 8;
    const int kw_off = skey * 128 + ((sch ^ ((skey >> 1) & 7)) << 4);
    const int vw_off = skey * 128 + (((2 * sch) ^ (((skey >> 1) & 1) << 3)) << 3);
    u32x4 kreg, vreg;
    u32x4 kr4[4], vr4[4];
    const float* gkp = gk + (DIFF ? ((8 * sch) & 31) : (8 * sch));
#define ATT_LOAD(kt, KR, VR) do { const bf16_t* _p = srow + (size_t)(kt) * 64 * NZ; KR = *(const u32x4*)(_p + kcol); VR = *(const u32x4*)(_p + vcol); } while (0)
#define ATT_KNORM() do { float _f[8]; unpack8(kreg, _f); const f32x4 _ga = *(const f32x4*)gkp, _gb = *(const f32x4*)(gkp + 4); const float gkv[8] = {_ga.x, _ga.y, _ga.z, _ga.w, _gb.x, _gb.y, _gb.z, _gb.w}; float _ss = 0.f; _Pragma("unroll") for (int _e = 0; _e < 8; ++_e) _ss += _f[_e] * _f[_e]; \
        _ss += __shfl_xor(_ss, 1); _ss += __shfl_xor(_ss, 2); if (!DIFF) _ss += __shfl_xor(_ss, 4); \
        const float _rn = rsqrtf(_ss * (DIFF ? 1.f / 32.f : 1.f / 64.f) + EPS); \
        kreg.x = pk2(_f[0] * _rn * gkv[0], _f[1] * _rn * gkv[1]); kreg.y = pk2(_f[2] * _rn * gkv[2], _f[3] * _rn * gkv[3]); \
        kreg.z = pk2(_f[4] * _rn * gkv[4], _f[5] * _rn * gkv[5]); kreg.w = pk2(_f[6] * _rn * gkv[6], _f[7] * _rn * gkv[7]); } while (0)
#define ATT_WRITE(bufi) do { LAS unsigned char* _kb = lds + (bufi) * ATT_BUF; *(LAS u32x4*)(_kb + kw_off) = kreg; *(LAS u32x4*)(_kb + ATT_KBYTES + vw_off) = vreg; } while (0)
    if (!DIFF) {
#pragma unroll
        for (int ti = 0; ti < 4; ++ti) if (kt_lo + ti <= kt_hi) ATT_LOAD(kt_lo + ti, kr4[ti], vr4[ti]);
    }
    bf16x8 qf[4];
    { const bf16_t* qp = z + (size_t)(b * SEQ + q0 + r) * NZ + qcol + 8 * h;
      float qv[4][8], ssq[2] = {0.f, 0.f};
#pragma unroll
      for (int ks = 0; ks < 4; ++ks) { unpack8(__builtin_nontemporal_load((const u32x4*)(qp + 16 * ks)), qv[ks]);
#pragma unroll
          for (int e = 0; e < 8; ++e) ssq[DIFF ? (ks >> 1) : 0] += qv[ks][e] * qv[ks][e]; }
      ssq[0] += __shfl_xor(ssq[0], 32); ssq[1] += __shfl_xor(ssq[1], 32);
      const float rq0 = rsqrtf(ssq[0] * (DIFF ? 1.f / 32.f : 1.f / 64.f) + EPS) * (DIFF ? 0.17677669529663687f : 0.125f) * LOG2E;
      const float rq1 = DIFF ? rsqrtf(ssq[1] * (1.f / 32.f) + EPS) * 0.17677669529663687f * LOG2E : rq0;
#pragma unroll
      for (int ks = 0; ks < 4; ++ks) { const float rq = (DIFF && ks >= 2) ? rq1 : rq0; const float* gp = gq + (DIFF ? ((16 * ks + 8 * h) & 31) : (16 * ks + 8 * h));
          u32x4 w; w.x = pk2(qv[ks][0] * rq * gp[0], qv[ks][1] * rq * gp[1]); w.y = pk2(qv[ks][2] * rq * gp[2], qv[ks][3] * rq * gp[3]);
          w.z = pk2(qv[ks][4] * rq * gp[4], qv[ks][5] * rq * gp[5]); w.w = pk2(qv[ks][6] * rq * gp[6], qv[ks][7] * rq * gp[7]);
          qf[ks] = __builtin_bit_cast(bf16x8, w); }
    }
    f32x16 O1[2], O2[2];
#pragma unroll
    for (int dt = 0; dt < 2; ++dt)
#pragma unroll
        for (int q = 0; q < 16; ++q) { O1[dt][q] = 0.f; O2[dt][q] = 0.f; }
    float l1 = 0.f, l2 = 0.f;
    if (DIFF) { ATT_LOAD(kt_lo, kreg, vreg); ATT_KNORM(); ATT_WRITE(0); }
    else {
        __syncthreads();
#pragma unroll
        for (int ti = 0; ti < 4; ++ti) if (kt_lo + ti <= kt_hi) { kreg = kr4[ti]; vreg = vr4[ti]; ATT_KNORM(); ATT_WRITE(ti); }
    }
    __syncthreads();
#pragma unroll 1
    for (int kt = (DIFF ? kt_lo : wkt_lo); kt <= (DIFF ? kt_hi : wkt_hi); ++kt) {
        const int bufi = DIFF ? ((kt - kt_lo) & 1) : (kt - kt_lo);
        if (DIFF && kt < kt_hi) ATT_LOAD(kt + 1, kreg, vreg);
        if (!DIFF || (kt >= wkt_lo && kt <= wkt_hi)) {
            const LAS unsigned char* kbuf = lds + bufi * ATT_BUF; const LAS unsigned char* vbuf = kbuf + ATT_KBYTES;
            const bool need_mask = (kt * 64 + 63 > q0) || (!DIFF && (q0 + 31 - kt * 64 >= 128));
#pragma unroll
            for (int kb = 0; kb < 2; ++kb) {
                const int key = kb * 32 + r;
                bf16x8 kf[4];
#pragma unroll
                for (int ks = 0; ks < 4; ++ks) kf[ks] = *(const LAS bf16x8*)(kbuf + key * 128 + (((2 * ks + h) ^ ((key >> 1) & 7)) << 4));
                const int base_d = (q0 + r) - (kt * 64 + kb * 32) - 4 * h;
                const float t0 = -(slope2 * (float)base_d + bound2);
                f32x16 S1, S2;
#pragma unroll
                for (int q = 0; q < 16; ++q) { S1[q] = t0 + slope2 * (float)((q & 3) + 8 * (q >> 2)); S2[q] = S1[q]; }
                if (DIFF) { S1 = MFMA32(kf[0], qf[0], S1); S1 = MFMA32(kf[1], qf[1], S1); S2 = MFMA32(kf[2], qf[2], S2); S2 = MFMA32(kf[3], qf[3], S2); }
                else { S1 = MFMA32(kf[0], qf[0], S1); S1 = MFMA32(kf[1], qf[1], S1); S1 = MFMA32(kf[2], qf[2], S1); S1 = MFMA32(kf[3], qf[3], S1); }
                if (need_mask) {
                    asm volatile("" ::: "memory");
#pragma unroll
                    for (int q = 0; q < 16; ++q) {
                        const int dist = base_d - ((q & 3) + 8 * (q >> 2)); const bool ok = (dist >= 0) && (DIFF || dist < 128);
                        S1[q] = ok ? __builtin_amdgcn_exp2f(S1[q]) : 0.f; if (DIFF) S2[q] = ok ? __builtin_amdgcn_exp2f(S2[q]) : 0.f;
                    }
                } else {
#pragma unroll
                    for (int q = 0; q < 16; ++q) { S1[q] = __builtin_amdgcn_exp2f(S1[q]); if (DIFF) S2[q] = __builtin_amdgcn_exp2f(S2[q]); }
                }
                bf16x8 pb1[2], pb2[2];
#pragma unroll
                for (int s2 = 0; s2 < 2; ++s2) {
                    u32x4 w; w.x = pk2(S1[8 * s2 + 0], S1[8 * s2 + 1]); w.y = pk2(S1[8 * s2 + 2], S1[8 * s2 + 3]); w.z = pk2(S1[8 * s2 + 4], S1[8 * s2 + 5]); w.w = pk2(S1[8 * s2 + 6], S1[8 * s2 + 7]);
                    pb1[s2] = __builtin_bit_cast(bf16x8, w);
                    l1 = dot2bf(w.x, 0x3F803F80u, l1); l1 = dot2bf(w.y, 0x3F803F80u, l1); l1 = dot2bf(w.z, 0x3F803F80u, l1); l1 = dot2bf(w.w, 0x3F803F80u, l1);
                    if (DIFF) { u32x4 w2; w2.x = pk2(S2[8 * s2 + 0], S2[8 * s2 + 1]); w2.y = pk2(S2[8 * s2 + 2], S2[8 * s2 + 3]); w2.z = pk2(S2[8 * s2 + 4], S2[8 * s2 + 5]); w2.w = pk2(S2[8 * s2 + 6], S2[8 * s2 + 7]);
                                pb2[s2] = __builtin_bit_cast(bf16x8, w2);
                                l2 = dot2bf(w2.x, 0x3F803F80u, l2); l2 = dot2bf(w2.y, 0x3F803F80u, l2); l2 = dot2bf(w2.z, 0x3F803F80u, l2); l2 = dot2bf(w2.w, 0x3F803F80u, l2); }
                }
#pragma unroll
                for (int dt = 0; dt < 2; ++dt)
#pragma unroll
                    for (int s2 = 0; s2 < 2; ++s2) {
                        const int key0 = kb * 32 + 16 * s2 + 4 * h + tq_, unit = dt * 8 + 4 * ((lane >> 4) & 1) + tp_;
                        LAS unsigned char* va = (LAS unsigned char*)vbuf + key0 * 128 + ((unit ^ (((key0 >> 1) & 1) << 3)) << 3);
                        const s16x4 lo = __builtin_amdgcn_ds_read_tr16_b64_v4i16((LAS s16x4*)va), hi = __builtin_amdgcn_ds_read_tr16_b64_v4i16((LAS s16x4*)(va + 8 * 128));
                        const bf16x8 vf = __builtin_shufflevector(lo, hi, 0, 1, 2, 3, 4, 5, 6, 7);
                        O1[dt] = MFMA32(vf, pb1[s2], O1[dt]);
                        if (DIFF) O2[dt] = MFMA32(vf, pb2[s2], O2[dt]);
                    }
            }
        }
        if (DIFF) { if (kt < kt_hi) { ATT_KNORM(); ATT_WRITE(bufi ^ 1); } __syncthreads(); }
    }
#undef ATT_LOAD
#undef ATT_KNORM
#undef ATT_WRITE
    l1 += __shfl_xor(l1, 32);
    float i1, i2 = 0.f;
    if (DIFF) { l2 += __shfl_xor(l2, 32); i1 = 1.f / l1; i2 = lam / l2; }
    else { l1 += __builtin_amdgcn_exp2f((sinks_l[qhead] - mx) * LOG2E); i1 = 1.f / l1; }
    float ss = 0.f;
#pragma unroll
    for (int dt = 0; dt < 2; ++dt)
#pragma unroll
        for (int q = 0; q < 16; ++q) { const float o = DIFF ? (O1[dt][q] * i1 - O2[dt][q] * i2) : O1[dt][q] * i1; O1[dt][q] = o; ss += o * o; }
    ss += __shfl_xor(ss, 32);
    const float rn = rsqrtf(ss * (1.f / 64.f) + EPS);
    bf16_t* yrow = y + (size_t)(b * SEQ + q0 + r) * DM + ycol + 4 * h;
#pragma unroll
    for (int dt = 0; dt < 2; ++dt)
#pragma unroll
        for (int g4 = 0; g4 < 4; ++g4) { u32x2 o; o.x = pk2(O1[dt][4 * g4 + 0] * rn, O1[dt][4 * g4 + 1] * rn); o.y = pk2(O1[dt][4 * g4 + 2] * rn, O1[dt][4 * g4 + 3] * rn);
            *(u32x2*)(yrow + dt * 32 + 8 * g4) = o; }
}

__device__ __forceinline__ void phase_attn(int wv0, int l, LAS unsigned char* lds) {
    FRESH_PARAMS; FRESH_IDS;
    const bf16_t* z = (const bf16_t*)(p.ws + WS_Z); bf16_t* y = (bf16_t*)(p.ws + WS_Y);
    const float* misc = (const float*)(p.ws + WS_MISC);
    const float lam = misc[l * 16 + 0], bound_d = misc[l * 16 + 1], bound_s = misc[l * 16 + 2];
    const float* sinks_l = p.swa_sinks + l * 4;
    const float* gqd = p.diff_q_norm + l * 32; const float* gkd = p.diff_k_norm + l * 32; const float* gqs = p.swa_q_norm + l * 64; const float* gks = p.swa_k_norm + l * 64;
#pragma unroll 1
    for (int u = bid; u < 256; u += nblk) {
        const int bh = u >> 2, pp = u & 3;
        attn_unit<true>(lds, z, y, bh >> 2, bh & 3, 7 - pp, lam, bound_d, sinks_l, gqd, gkd, tid, lane, wave);
        attn_unit<true>(lds, z, y, bh >> 2, bh & 3, pp, lam, bound_d, sinks_l, gqd, gkd, tid, lane, wave);
    }
#pragma unroll 1
    for (int u = bid; u < 512; u += nblk)
        attn_unit<false>(lds, z, y, u >> 5, (u >> 4) & 1, u & 15, lam, bound_s, sinks_l, gqs, gks, tid, lane, wave);
}

#define INS_PACKED(L, xv) do { float _x = (xv); _Pragma("unroll") for (int _m = 0; _m < 16; ++_m) { const float _hi = fmaxf(L[_m], _x); _x = fminf(L[_m], _x); L[_m] = _hi; } } while (0)

__device__ __forceinline__ void phase_route_a_naive(int wv0, int l) {
    FRESH_PARAMS; FRESH_IDS;
    const bf16_t* qp = (const bf16_t*)(p.ws + WS_Z);
    const bf16_t* SK = (const bf16_t*)(p.ws + WS_SK) + (size_t)l * 2 * 128 * 128;
    float* tops = (float*)(p.ws + WS_Y);
    for (int idx = gtid; idx < T * 16; idx += gthreads) {
        const int t = idx % T, hc = idx / T, h = hc >> 1, c = hc & 1;
        float qf[128];
        { const u32x4* q4 = (const u32x4*)(qp + (size_t)t * NQ + h * 256 + c * 128);
#pragma unroll
          for (int i = 0; i < 16; ++i) unpack8(q4[i], qf + 8 * i); }
        float L[16];
#pragma unroll
        for (int m = 0; m < 16; ++m) L[m] = -3.0e38f;
#pragma unroll 1
        for (int k = 0; k < 128; ++k) {
            const u32x4* s4 = (const u32x4*)(SK + (size_t)(c * 128 + k) * 128);
            float sc = 0.f;
#pragma unroll
            for (int i = 0; i < 16; ++i) { float f[8]; unpack8(s4[i], f);
#pragma unroll
                for (int j = 0; j < 8; ++j) sc += f[j] * qf[8 * i + j]; }
            const float pkd = __uint_as_float((__float_as_uint(sc) & ~127u) | (unsigned)k);
            INS_PACKED(L, pkd);
        }
        float* o = tops + ((size_t)(t * 8 + h) * 2 + c) * 16;
#pragma unroll
        for (int m = 0; m < 16; ++m) o[m] = L[m];
    }
}

__device__ __forceinline__ void phase_route_b_naive(int wv0, int l) {
    FRESH_PARAMS; FRESH_IDS;
    const float* tops = (const float*)(p.ws + WS_Y);
    int* idxo = (int*)(p.ws + WS_IDX); float* gate = (float*)(p.ws + WS_GATE);
    for (int th = gtid; th < T * 8; th += gthreads) {
        const float* a = tops + (size_t)th * 32; const float* bq = a + 16;
        float L[16];
#pragma unroll
        for (int m = 0; m < 16; ++m) L[m] = -3.0e38f;
#pragma unroll 1
        for (int i = 0; i < 16; ++i) {
            const float sa = __uint_as_float(__float_as_uint(a[i]) & ~127u);
#pragma unroll 1
            for (int j = 0; j < 16; ++j) {
                const float sb = __uint_as_float(__float_as_uint(bq[j]) & ~127u);
                const float pkd = __uint_as_float((__float_as_uint(sa + sb) & ~255u) | (unsigned)(i * 16 + j));
                INS_PACKED(L, pkd);
            }
        }
        const float top0 = __uint_as_float(__float_as_uint(L[0]) & ~255u);
        float e[16], sum = 0.f;
#pragma unroll
        for (int m = 0; m < 16; ++m) { e[m] = __expf(__uint_as_float(__float_as_uint(L[m]) & ~255u) - top0); sum += e[m]; }
        const float inv = 1.f / sum;
#pragma unroll
        for (int m = 0; m < 16; ++m) {
            const unsigned pos = __float_as_uint(L[m]) & 255u;
            const int ia = (int)(__float_as_uint(a[pos >> 4]) & 127u), ib = (int)(__float_as_uint(bq[pos & 15u]) & 127u);
            idxo[(size_t)th * 16 + m] = ia * 128 + ib; gate[(size_t)th * 16 + m] = e[m] * inv;
        }
    }
}

#define CE_DESC(a, b) do { const float _hi = fmaxf((a), (b)); const float _lo = fminf((a), (b)); (a) = _hi; (b) = _lo; } while (0)
__device__ __forceinline__ void merge_halves_sorted(float (&L)[16]) {
    float M[16];
#pragma unroll
    for (int i = 0; i < 16; ++i) M[i] = __shfl_xor(L[15 - i], 32);
#pragma unroll
    for (int i = 0; i < 16; ++i) M[i] = fmaxf(L[i], M[i]);
#define BITONIC_STAGE(ST) _Pragma("unroll") for (int i = 0; i < 16; ++i) if ((i & (ST)) == 0) CE_DESC(M[i], M[i + (ST)]);
    BITONIC_STAGE(8) BITONIC_STAGE(4) BITONIC_STAGE(2) BITONIC_STAGE(1)
#undef BITONIC_STAGE
#pragma unroll
    for (int i = 0; i < 16; ++i) L[i] = M[i];
}

#define CE_ASC(a, b) do { const float _hi = fmaxf((a), (b)); const float _lo = fminf((a), (b)); (a) = _lo; (b) = _hi; } while (0)
__device__ __forceinline__ void sort16_desc(float (&a)[16]) {
    CE_DESC(a[0], a[13]); CE_DESC(a[1], a[12]); CE_DESC(a[2], a[15]); CE_DESC(a[3], a[14]); CE_DESC(a[4], a[8]); CE_DESC(a[5], a[6]); CE_DESC(a[7], a[11]); CE_DESC(a[9], a[10]);
    CE_DESC(a[0], a[5]); CE_DESC(a[1], a[7]); CE_DESC(a[2], a[9]); CE_DESC(a[3], a[4]); CE_DESC(a[6], a[13]); CE_DESC(a[8], a[14]); CE_DESC(a[10], a[15]); CE_DESC(a[11], a[12]);
    CE_DESC(a[0], a[1]); CE_DESC(a[2], a[3]); CE_DESC(a[4], a[5]); CE_DESC(a[6], a[8]); CE_DESC(a[7], a[9]); CE_DESC(a[10], a[11]); CE_DESC(a[12], a[13]); CE_DESC(a[14], a[15]);
    CE_DESC(a[0], a[2]); CE_DESC(a[1], a[3]); CE_DESC(a[4], a[10]); CE_DESC(a[5], a[11]); CE_DESC(a[6], a[7]); CE_DESC(a[8], a[9]); CE_DESC(a[12], a[14]); CE_DESC(a[13], a[15]);
    CE_DESC(a[1], a[2]); CE_DESC(a[3], a[12]); CE_DESC(a[4], a[6]); CE_DESC(a[5], a[7]); CE_DESC(a[8], a[10]); CE_DESC(a[9], a[11]); CE_DESC(a[13], a[14]); CE_DESC(a[1], a[4]);
    CE_DESC(a[2], a[6]); CE_DESC(a[5], a[8]); CE_DESC(a[7], a[10]); CE_DESC(a[9], a[13]); CE_DESC(a[11], a[14]); CE_DESC(a[2], a[4]); CE_DESC(a[3], a[6]); CE_DESC(a[9], a[12]);
    CE_DESC(a[11], a[13]); CE_DESC(a[3], a[5]); CE_DESC(a[6], a[8]); CE_DESC(a[7], a[9]); CE_DESC(a[10], a[12]); CE_DESC(a[3], a[4]); CE_DESC(a[5], a[6]); CE_DESC(a[7], a[8]);
    CE_DESC(a[9], a[10]); CE_DESC(a[11], a[12]); CE_DESC(a[6], a[7]); CE_DESC(a[8], a[9]);
}
__device__ __forceinline__ void merge16_desc(float (&L)[16], const float (&T)[16]) {
#pragma unroll
    for (int i = 0; i < 16; ++i) L[i] = fmaxf(L[i], T[15 - i]);
#define BM_STAGE(ST) _Pragma("unroll") for (int i = 0; i < 16; ++i) if ((i & (ST)) == 0) CE_DESC(L[i], L[i + (ST)]);
    BM_STAGE(8) BM_STAGE(4) BM_STAGE(2) BM_STAGE(1)
#undef BM_STAGE
}

__device__ __forceinline__ void route_load_q(const bf16_t* qp, int t0, int r, int hh, int hd, int c, bf16x8 (&qf)[8]) {
    const bf16_t* q8 = qp + (size_t)(t0 + r) * NQ + hd * 256 + c * 128 + 8 * hh;
#pragma unroll
    for (int ks = 0; ks < 8; ++ks) qf[ks] = __builtin_nontemporal_load((const bf16x8*)(q8 + 16 * ks));
}
__device__ __forceinline__ void route_half(const LAS unsigned char* lds, const bf16x8 (&qf)[8], int r, int hh, int c, float (&L)[16]) {
#pragma unroll
    for (int m = 0; m < 16; ++m) L[m] = -3.0e38f;
#pragma unroll 1
    for (int kt = 0; kt < 4; ++kt) {
        const int key = kt * 32 + r;
        const LAS unsigned char* krow = lds + (c * 128 + key) * 256;
        f32x16 S;
#pragma unroll
        for (int q = 0; q < 16; ++q) S[q] = 0.f;
#pragma unroll
        for (int ks = 0; ks < 8; ++ks) { const bf16x8 kf = *(const LAS bf16x8*)(krow + (((2 * ks + hh) ^ (key & 15)) << 4)); S = MFMA32(kf, qf[ks], S); }
        float Tt[16];
#pragma unroll
        for (int q = 0; q < 16; ++q) {
            const unsigned kidx = (unsigned)(kt * 32 + (q & 3) + 8 * (q >> 2) + 4 * hh);
            Tt[q] = __uint_as_float((__float_as_uint(S[q]) & ~127u) | kidx);
        }
        sort16_desc(Tt);
        if (kt == 0) {
#pragma unroll
            for (int m = 0; m < 16; ++m) L[m] = Tt[m];
        } else merge16_desc(L, Tt);
    }
    merge_halves_sorted(L);
}

constexpr int RT_SK_BYTES = 65536, RT_LANE_STRIDE = 33 * 4, RT_WAVE_BYTES = 64 * RT_LANE_STRIDE;
__device__ __forceinline__ void phase_route(int wv0, int l, LAS unsigned char* lds) {
    FRESH_PARAMS; FRESH_IDS;
    const bf16_t* qp = (const bf16_t*)(p.ws + WS_Z);
    const bf16_t* SK = (const bf16_t*)(p.ws + WS_SK) + (size_t)l * 2 * 128 * 128;
    int* idxo = (int*)(p.ws + WS_IDX); float* gate = (float*)(p.ws + WS_GATE);
    const int r = lane & 31, hh = lane >> 5;
    for (int i = tid; i < 4096; i += NTHREADS) {
        const int row = i >> 4, ch = i & 15;
        *(LAS u32x4*)(lds + row * 256 + ((ch ^ (row & 15)) << 4)) = *(const u32x4*)(SK + (size_t)i * 8);
    }
    __syncthreads();
    LAS float* mine = (LAS float*)(lds + RT_SK_BYTES + wave * RT_WAVE_BYTES + lane * RT_LANE_STRIDE);
#pragma unroll 1
    for (int u = gw; u < (T / 32) * 8; u += ngw) {
        const int t0 = (u >> 3) * 32, hd = u & 7;
        float LA[16], LB[16];
        { bf16x8 qa[8], qb[8];
          route_load_q(qp, t0, r, hh, hd, 0, qa); route_load_q(qp, t0, r, hh, hd, 1, qb);
          route_half(lds, qa, r, hh, 0, LA);
          route_half(lds, qb, r, hh, 1, LB); }
#pragma unroll
        for (int m = 0; m < 16; ++m) { mine[m] = LA[m]; mine[16 + m] = LB[m]; }
        float F[16];
#pragma unroll
        for (int m = 0; m < 16; ++m) F[m] = -3.0e38f;
#pragma unroll
        for (int i = 0; i < 16; ++i)
#pragma unroll
            for (int j = 0; j < 16; ++j)
                if ((i + 1) * (j + 1) <= 16) {
                    const float sm = LA[i] + LB[j];
                    const float pkd = __uint_as_float((__float_as_uint(sm) & ~255u) | (unsigned)(i * 16 + j));
                    INS_PACKED(F, pkd);
                }
        float e[16], sum = 0.f;
#pragma unroll
        for (int m = 0; m < 16; ++m) { e[m] = __expf(F[m] - F[0]); sum += e[m]; }
        const float inv = 1.f / sum;
        int io[8]; float go[8];
#pragma unroll
        for (int k = 0; k < 8; ++k) {
            float f_lo = F[k], f_hi = F[8 + k], e_lo = e[k], e_hi = e[8 + k];
            asm volatile("" : "+v"(f_lo), "+v"(f_hi), "+v"(e_lo), "+v"(e_hi));
            const float fv = hh ? f_hi : f_lo; const float ev = hh ? e_hi : e_lo;
            const unsigned pos = __float_as_uint(fv) & 255u;
            const unsigned ia = __float_as_uint(mine[pos >> 4]) & 127u, ib = __float_as_uint(mine[16 + (pos & 15u)]) & 127u;
            io[k] = (int)(ia * 128u + ib); go[k] = ev * inv;
        }
        const size_t ob = ((size_t)(t0 + r) * 8 + hd) * 16 + 8 * hh;
        *(u32x4*)(idxo + ob) = (u32x4){(unsigned)io[0], (unsigned)io[1], (unsigned)io[2], (unsigned)io[3]};
        *(u32x4*)(idxo + ob + 4) = (u32x4){(unsigned)io[4], (unsigned)io[5], (unsigned)io[6], (unsigned)io[7]};
        *(f32x4*)(gate + ob) = (f32x4){go[0], go[1], go[2], go[3]};
        *(f32x4*)(gate + ob + 4) = (f32x4){go[4], go[5], go[6], go[7]};
    }
}

__device__ __forceinline__ void phase_gather_naive(int wv0, int l) {
    FRESH_PARAMS; FRESH_IDS;
    const float* U = p.peer_u + (size_t)l * NEXP * DM; const float* V = p.peer_v + (size_t)l * NEXP * DM;
    const float* g2 = p.norm2_g + l * DM;
    const int* idxs = (const int*)(p.ws + WS_IDX); const float* gate = (const float*)(p.ws + WS_GATE);
    bf16_t* XN = (bf16_t*)(p.ws + WS_XN);
    for (int t = gw; t < T; t += ngw) {
        float* xrow = p.out + (size_t)t * DM;
        f32x4 xr[4], xn[4], acc[4]; float ss = 0.f;
#pragma unroll
        for (int j = 0; j < 4; ++j) { xr[j] = *(const f32x4*)(xrow + j * 256 + lane * 4); ss += (xr[j].x * xr[j].x + xr[j].y * xr[j].y) + (xr[j].z * xr[j].z + xr[j].w * xr[j].w); }
        const float rstd = rsqrtf(wave_sum(ss) * (1.f / DM) + EPS);
#pragma unroll
        for (int j = 0; j < 4; ++j) { const f32x4 g = *(const f32x4*)(g2 + j * 256 + lane * 4); xn[j] = xr[j] * rstd * g; acc[j] = (f32x4){0.f, 0.f, 0.f, 0.f}; }
#pragma unroll 1
        for (int r = 0; r < 128; ++r) {
            const int e = idxs[(size_t)t * 128 + r]; const float gt = gate[(size_t)t * 128 + r];
            const float* ur = U + (size_t)e * DM + lane * 4;
            float d = 0.f;
#pragma unroll
            for (int j = 0; j < 4; ++j) { const f32x4 uv = *(const f32x4*)(ur + j * 256); d += (uv.x * xn[j].x + uv.y * xn[j].y) + (uv.z * xn[j].z + uv.w * xn[j].w); }
            d = wave_sum(d);
            const float a = gt * 0.5f * d * (1.f + erff(d * 0.70710678118654752f));
            const float* vr = V + (size_t)e * DM + lane * 4;
#pragma unroll
            for (int j = 0; j < 4; ++j) { const f32x4 vv = *(const f32x4*)(vr + j * 256); acc[j] += vv * a; }
        }
        float s2 = 0.f;
#pragma unroll
        for (int j = 0; j < 4; ++j) { xr[j] += acc[j]; *(f32x4*)(xrow + j * 256 + lane * 4) = xr[j]; s2 += (xr[j].x * xr[j].x + xr[j].y * xr[j].y) + (xr[j].z * xr[j].z + xr[j].w * xr[j].w); }
        if (l + 1 < DEPTH) {
            const float r1 = rsqrtf(wave_sum(s2) * (1.f / DM) + EPS);
#pragma unroll
            for (int j = 0; j < 4; ++j) { u32x2 o; o.x = pk2(xr[j].x * r1, xr[j].y * r1); o.y = pk2(xr[j].z * r1, xr[j].w * r1); *(u32x2*)(XN + (size_t)t * DM + j * 256 + lane * 4) = o; }
        }
    }
}


__device__ __forceinline__ void phase_table_convert(int wv0, int l) {
    FRESH_PARAMS; FRESH_IDS;
    const f32x4* U = (const f32x4*)(p.peer_u + (size_t)l * NEXP * DM); const f32x4* V = (const f32x4*)(p.peer_v + (size_t)l * NEXP * DM);
    u32x4* PU = (u32x4*)(p.ws + WS_PU); u32x4* PV = (u32x4*)(p.ws + WS_PV);
#pragma unroll 2
    for (int i = gtid; i < NEXP * DM / 8; i += gthreads) {
        const f32x4 a0 = U[2 * i], a1 = U[2 * i + 1], b0 = V[2 * i], b1 = V[2 * i + 1];
        u32x4 o; o.x = pk2(a0.x, a0.y); o.y = pk2(a0.z, a0.w); o.z = pk2(a1.x, a1.y); o.w = pk2(a1.z, a1.w); PU[i] = o;
        u32x4 q; q.x = pk2(b0.x, b0.y); q.y = pk2(b0.z, b0.w); q.z = pk2(b1.x, b1.y); q.w = pk2(b1.z, b1.w); PV[i] = q;
    }
}

__device__ __forceinline__ void phase_gather(int wv0, int l) {
    FRESH_PARAMS; FRESH_IDS;
    const unsigned char* PU = p.ws + WS_PU; const unsigned char* PV = p.ws + WS_PV;
    const float* g2 = p.norm2_g + l * DM;
    const int* idxs = (const int*)(p.ws + WS_IDX); const float* gates = (const float*)(p.ws + WS_GATE);
    bf16_t* XN = (bf16_t*)(p.ws + WS_XN);
    const int g = lane >> 4, j = lane & 15;
#pragma unroll 1
    for (int t = gw; t < T; t += ngw) {
        float* xrow = p.out + (size_t)t * DM;
        unsigned xpk[8][4];
        {
            f32x4 xa[8][2]; float ss = 0.f;
#pragma unroll
            for (int c = 0; c < 8; ++c) {
                xa[c][0] = *(const f32x4*)(xrow + (j + 16 * c) * 8); xa[c][1] = *(const f32x4*)(xrow + (j + 16 * c) * 8 + 4);
                ss += (xa[c][0].x * xa[c][0].x + xa[c][0].y * xa[c][0].y) + (xa[c][0].z * xa[c][0].z + xa[c][0].w * xa[c][0].w);
                ss += (xa[c][1].x * xa[c][1].x + xa[c][1].y * xa[c][1].y) + (xa[c][1].z * xa[c][1].z + xa[c][1].w * xa[c][1].w);
            }
            ss += __shfl_xor(ss, 1); ss += __shfl_xor(ss, 2); ss += __shfl_xor(ss, 4); ss += __shfl_xor(ss, 8);
            const float rstd = rsqrtf(ss * (1.f / DM) + EPS);
#pragma unroll
            for (int c = 0; c < 8; ++c) {
                const f32x4 ga = *(const f32x4*)(g2 + (j + 16 * c) * 8), gb = *(const f32x4*)(g2 + (j + 16 * c) * 8 + 4);
                xpk[c][0] = pk2(xa[c][0].x * rstd * ga.x, xa[c][0].y * rstd * ga.y); xpk[c][1] = pk2(xa[c][0].z * rstd * ga.z, xa[c][0].w * rstd * ga.w);
                xpk[c][2] = pk2(xa[c][1].x * rstd * gb.x, xa[c][1].y * rstd * gb.y); xpk[c][3] = pk2(xa[c][1].z * rstd * gb.z, xa[c][1].w * rstd * gb.w);
            }
        }
        const int my_i0 = idxs[(size_t)t * 128 + 4 * j + g], my_i1 = idxs[(size_t)t * 128 + 4 * (j + 16) + g];
        const float my_g0 = gates[(size_t)t * 128 + 4 * j + g], my_g1 = gates[(size_t)t * 128 + 4 * (j + 16) + g];
        float acc[64];
#pragma unroll
        for (int q = 0; q < 64; ++q) acc[q] = 0.f;
#pragma unroll 1
        for (int i = 0; i < 32; ++i) {
            const int sel = (lane & 48) | (i & 15);
            const int e = __shfl(i < 16 ? my_i0 : my_i1, sel);
            const float gt = __shfl(i < 16 ? my_g0 : my_g1, sel);
            const unsigned char* ur = PU + (size_t)e * 2048 + j * 16; const unsigned char* vr = PV + (size_t)e * 2048 + j * 16;
            u32x4 ub[8], vb[8];
#pragma unroll
            for (int c = 0; c < 8; ++c) ub[c] = *(const u32x4*)(ur + c * 256);
#pragma unroll
            for (int c = 0; c < 8; ++c) vb[c] = *(const u32x4*)(vr + c * 256);
            float d = 0.f;
#pragma unroll
            for (int c = 0; c < 8; ++c) { d = dot2bf(ub[c].x, xpk[c][0], d); d = dot2bf(ub[c].y, xpk[c][1], d); d = dot2bf(ub[c].z, xpk[c][2], d); d = dot2bf(ub[c].w, xpk[c][3], d); }
            d += __shfl_xor(d, 1); d += __shfl_xor(d, 2); d += __shfl_xor(d, 4); d += __shfl_xor(d, 8);
            const float a = gt * 0.5f * d * (1.f + erff(d * 0.70710678118654752f));
#pragma unroll
            for (int c = 0; c < 8; ++c) { float f[8]; unpack8(vb[c], f);
#pragma unroll
                for (int q = 0; q < 8; ++q) acc[c * 8 + q] += a * f[q]; }
        }
        float s1[32];
#pragma unroll
        for (int q = 0; q < 32; ++q) { const float mine = (g & 2) ? acc[32 + q] : acc[q], send = (g & 2) ? acc[q] : acc[32 + q]; s1[q] = mine + __shfl_xor(send, 32); }
        float s2[16];
#pragma unroll
        for (int q = 0; q < 16; ++q) { const float mine = (g & 1) ? s1[16 + q] : s1[q], send = (g & 1) ? s1[q] : s1[16 + q]; s2[q] = mine + __shfl_xor(send, 16); }
        const int cc0 = 4 * (g >> 1) + 2 * (g & 1);
        f32x4 xo[2][2]; float sq = 0.f;
#pragma unroll
        for (int c = 0; c < 2; ++c) {
            float* px = xrow + (j + 16 * (cc0 + c)) * 8;
            xo[c][0] = *(const f32x4*)px; xo[c][1] = *(const f32x4*)(px + 4);
            xo[c][0] += (f32x4){s2[c * 8 + 0], s2[c * 8 + 1], s2[c * 8 + 2], s2[c * 8 + 3]}; xo[c][1] += (f32x4){s2[c * 8 + 4], s2[c * 8 + 5], s2[c * 8 + 6], s2[c * 8 + 7]};
            *(f32x4*)px = xo[c][0]; *(f32x4*)(px + 4) = xo[c][1];
            sq += (xo[c][0].x * xo[c][0].x + xo[c][0].y * xo[c][0].y) + (xo[c][0].z * xo[c][0].z + xo[c][0].w * xo[c][0].w);
            sq += (xo[c][1].x * xo[c][1].x + xo[c][1].y * xo[c][1].y) + (xo[c][1].z * xo[c][1].z + xo[c][1].w * xo[c][1].w);
        }
        if (l + 1 < DEPTH) {
            const float r1 = rsqrtf(wave_sum(sq) * (1.f / DM) + EPS);
#pragma unroll
            for (int c = 0; c < 2; ++c) { u32x4 o; o.x = pk2(xo[c][0].x * r1, xo[c][0].y * r1); o.y = pk2(xo[c][0].z * r1, xo[c][0].w * r1); o.z = pk2(xo[c][1].x * r1, xo[c][1].y * r1); o.w = pk2(xo[c][1].z * r1, xo[c][1].w * r1);
                *(u32x4*)(XN + (size_t)t * DM + (j + 16 * (cc0 + c)) * 8) = o; }
        }
    }
}

__device__ __forceinline__ void phase_table_fp8(int wv0) {
    FRESH_PARAMS; FRESH_IDS;
    unsigned char* P8 = p.ws + WS_P8; float* SCL = (float*)(p.ws + WS_SCL);
#pragma unroll 1
    for (int row = gw; row < DEPTH * 2 * NEXP; row += ngw) {
        const int ti = row / NEXP, e = row % NEXP, l = ti >> 1;
        const float* src = ((ti & 1) ? p.peer_v : p.peer_u) + ((size_t)l * NEXP + e) * DM + lane * 16;
        f32x4 v[4]; float am = 0.f;
#pragma unroll
        for (int q = 0; q < 4; ++q) { v[q] = *(const f32x4*)(src + 4 * q); am = fmaxf(am, fmaxf(fmaxf(fabsf(v[q].x), fabsf(v[q].y)), fmaxf(fabsf(v[q].z), fabsf(v[q].w)))); }
        am = fmaxf(wave_max(am), 1e-30f);
        const float sc = 440.f / am;
        u32x4 o;
        { int w = 0; w = __builtin_amdgcn_cvt_pk_fp8_f32(v[0].x * sc, v[0].y * sc, w, false); w = __builtin_amdgcn_cvt_pk_fp8_f32(v[0].z * sc, v[0].w * sc, w, true); o.x = (unsigned)w; }
        { int w = 0; w = __builtin_amdgcn_cvt_pk_fp8_f32(v[1].x * sc, v[1].y * sc, w, false); w = __builtin_amdgcn_cvt_pk_fp8_f32(v[1].z * sc, v[1].w * sc, w, true); o.y = (unsigned)w; }
        { int w = 0; w = __builtin_amdgcn_cvt_pk_fp8_f32(v[2].x * sc, v[2].y * sc, w, false); w = __builtin_amdgcn_cvt_pk_fp8_f32(v[2].z * sc, v[2].w * sc, w, true); o.z = (unsigned)w; }
        { int w = 0; w = __builtin_amdgcn_cvt_pk_fp8_f32(v[3].x * sc, v[3].y * sc, w, false); w = __builtin_amdgcn_cvt_pk_fp8_f32(v[3].z * sc, v[3].w * sc, w, true); o.w = (unsigned)w; }
        *(u32x4*)(P8 + (size_t)row * 1024 + lane * 16) = o;
        if (lane == 0) SCL[row] = am * (1.f / 440.f);
    }
}

__device__ __forceinline__ void phase_gather8(int wv0, int l) {
    FRESH_PARAMS; FRESH_IDS;
    const unsigned char* PU = p.ws + WS_P8 + (size_t)(2 * l) * NEXP * 1024; const unsigned char* PV = PU + (size_t)NEXP * 1024;
    const float* SU = (const float*)(p.ws + WS_SCL) + (size_t)(2 * l) * NEXP; const float* SV = SU + NEXP;
    const float* g2 = p.norm2_g + l * DM;
    const int* idxs = (const int*)(p.ws + WS_IDX); const float* gates = (const float*)(p.ws + WS_GATE);
    bf16_t* XN = (bf16_t*)(p.ws + WS_XN);
    const int g = lane >> 4, j = lane & 15;
#pragma unroll 1
    for (int t = gw; t < T; t += ngw) {
        float* xrow = p.out + (size_t)t * DM;
        unsigned xp[4][8];
        {
            f32x4 xa[4][4]; float ss = 0.f;
#pragma unroll
            for (int c = 0; c < 4; ++c)
#pragma unroll
                for (int q = 0; q < 4; ++q) { const f32x4 a = *(const f32x4*)(xrow + 16 * (j + 16 * c) + 4 * q); xa[c][q] = a; ss += (a.x * a.x + a.y * a.y) + (a.z * a.z + a.w * a.w); }
            ss += __shfl_xor(ss, 1); ss += __shfl_xor(ss, 2); ss += __shfl_xor(ss, 4); ss += __shfl_xor(ss, 8);
            const float rstd = rsqrtf(ss * (1.f / DM) + EPS);
#pragma unroll
            for (int c = 0; c < 4; ++c)
#pragma unroll
                for (int q = 0; q < 4; ++q) { const f32x4 ga = *(const f32x4*)(g2 + 16 * (j + 16 * c) + 4 * q); const f32x4 a = xa[c][q];
                    xp[c][2 * q] = pk2(a.x * ga.x * rstd, a.y * ga.y * rstd); xp[c][2 * q + 1] = pk2(a.z * ga.z * rstd, a.w * ga.w * rstd); }
        }
        const int my_i0 = idxs[(size_t)t * 128 + 4 * j + g], my_i1 = idxs[(size_t)t * 128 + 4 * (j + 16) + g];
        const float my_g0 = gates[(size_t)t * 128 + 4 * j + g], my_g1 = gates[(size_t)t * 128 + 4 * (j + 16) + g];
        f32x2 acc[4][8];
#pragma unroll
        for (int c = 0; c < 4; ++c)
#pragma unroll
            for (int q = 0; q < 8; ++q) acc[c][q] = (f32x2){0.f, 0.f};
        u32x4 ubA[4], vbA[4], ubB[4], vbB[4]; float usA, vsA, gtA, usB, vsB, gtB;
#define G8_LOAD(UB, VB, US, VS, GT, i) do { const int _sel = (lane & 48) | ((i) & 15); const int _e = __shfl((i) < 16 ? my_i0 : my_i1, _sel); GT = __shfl((i) < 16 ? my_g0 : my_g1, _sel); \
        US = SU[_e]; VS = SV[_e]; const unsigned char* _ur = PU + (size_t)_e * 1024 + j * 16; const unsigned char* _vr = PV + (size_t)_e * 1024 + j * 16; \
        _Pragma("unroll") for (int _c = 0; _c < 4; ++_c) UB[_c] = *(const u32x4*)(_ur + _c * 256); \
        _Pragma("unroll") for (int _c = 0; _c < 4; ++_c) VB[_c] = *(const u32x4*)(_vr + _c * 256); } while (0)
#define G8_XF(P) ((f32x2){__uint_as_float((P) << 16), __uint_as_float((P) & 0xffff0000u)})
#define G8_DOT1(W, X0, X1) do { d2 = __builtin_amdgcn_cvt_pk_f32_fp8((int)(W), false) * G8_XF(X0) + d2; d2 = __builtin_amdgcn_cvt_pk_f32_fp8((int)(W), true) * G8_XF(X1) + d2; } while (0)
#define G8_AXPY1(W, A0, A1) do { A0 = __builtin_amdgcn_cvt_pk_f32_fp8((int)(W), false) * a2 + A0; A1 = __builtin_amdgcn_cvt_pk_f32_fp8((int)(W), true) * a2 + A1; } while (0)
#define G8_COMPUTE(UB, VB, US, VS, GT) do { f32x2 d2 = (f32x2){0.f, 0.f}; \
        _Pragma("unroll") for (int _c = 0; _c < 4; ++_c) { G8_DOT1(UB[_c].x, xp[_c][0], xp[_c][1]); G8_DOT1(UB[_c].y, xp[_c][2], xp[_c][3]); G8_DOT1(UB[_c].z, xp[_c][4], xp[_c][5]); G8_DOT1(UB[_c].w, xp[_c][6], xp[_c][7]); } \
        float _d = d2.x + d2.y; _d += __shfl_xor(_d, 1); _d += __shfl_xor(_d, 2); _d += __shfl_xor(_d, 4); _d += __shfl_xor(_d, 8); _d *= US; \
        const float _a = GT * 0.5f * _d * (1.f + erff(_d * 0.70710678118654752f)) * VS; const f32x2 a2 = (f32x2){_a, _a}; \
        _Pragma("unroll") for (int _c = 0; _c < 4; ++_c) { G8_AXPY1(VB[_c].x, acc[_c][0], acc[_c][1]); G8_AXPY1(VB[_c].y, acc[_c][2], acc[_c][3]); G8_AXPY1(VB[_c].z, acc[_c][4], acc[_c][5]); G8_AXPY1(VB[_c].w, acc[_c][6], acc[_c][7]); } } while (0)
        G8_LOAD(ubA, vbA, usA, vsA, gtA, 0);
#pragma unroll 1
        for (int i = 0; i < 32; i += 2) {
            G8_LOAD(ubB, vbB, usB, vsB, gtB, i + 1);
            G8_COMPUTE(ubA, vbA, usA, vsA, gtA);
            if (i + 2 < 32) G8_LOAD(ubA, vbA, usA, vsA, gtA, i + 2);
            G8_COMPUTE(ubB, vbB, usB, vsB, gtB);
        }
#undef G8_LOAD
#undef G8_XF
#undef G8_DOT1
#undef G8_AXPY1
#undef G8_COMPUTE
        float s1[32];
#pragma unroll
        for (int q = 0; q < 16; ++q) {
            const f32x2 lo = acc[q >> 3][q & 7], hi = acc[2 + (q >> 3)][q & 7];
            const f32x2 mine = (g & 2) ? hi : lo, send = (g & 2) ? lo : hi;
            s1[2 * q] = mine.x + __shfl_xor(send.x, 32); s1[2 * q + 1] = mine.y + __shfl_xor(send.y, 32);
        }
        float s2[16];
#pragma unroll
        for (int q = 0; q < 16; ++q) { const float mine = (g & 1) ? s1[16 + q] : s1[q], send = (g & 1) ? s1[q] : s1[16 + q]; s2[q] = mine + __shfl_xor(send, 16); }
        float* px = xrow + 16 * (j + 16 * g);
        f32x4 xo[4]; float sq = 0.f;
#pragma unroll
        for (int q = 0; q < 4; ++q) { xo[q] = *(const f32x4*)(px + 4 * q); xo[q] += (f32x4){s2[4 * q], s2[4 * q + 1], s2[4 * q + 2], s2[4 * q + 3]}; *(f32x4*)(px + 4 * q) = xo[q];
            sq += (xo[q].x * xo[q].x + xo[q].y * xo[q].y) + (xo[q].z * xo[q].z + xo[q].w * xo[q].w); }
        if (l + 1 < DEPTH) {
            const float r1 = rsqrtf(wave_sum(sq) * (1.f / DM) + EPS);
            u32x4 o0, o1;
            o0.x = pk2(xo[0].x * r1, xo[0].y * r1); o0.y = pk2(xo[0].z * r1, xo[0].w * r1); o0.z = pk2(xo[1].x * r1, xo[1].y * r1); o0.w = pk2(xo[1].z * r1, xo[1].w * r1);
            o1.x = pk2(xo[2].x * r1, xo[2].y * r1); o1.y = pk2(xo[2].z * r1, xo[2].w * r1); o1.z = pk2(xo[3].x * r1, xo[3].y * r1); o1.w = pk2(xo[3].z * r1, xo[3].w * r1);
            u32x4* po = (u32x4*)(XN + (size_t)t * DM + 16 * (j + 16 * g));
            po[0] = o0; po[1] = o1;
        }
    }
}

__host__ __device__ constexpr int cand_i_of(int c) { int n = 0; for (int i = 0; i < 16; ++i) for (int j = 0; j < 16; ++j) if ((i + 1) * (j + 1) <= 16) { if (n == c) return i; ++n; } return 0; }
__host__ __device__ constexpr int cand_j_of(int c) { int n = 0; for (int i = 0; i < 16; ++i) for (int j = 0; j < 16; ++j) if ((i + 1) * (j + 1) <= 16) { if (n == c) return j; ++n; } return 0; }
__device__ __forceinline__ void route_unit(const LAS unsigned char* lds, LAS float* mine, const bf16_t* qp, int* idxo, float* sco, int t0, int hd, int r, int hh) {
    float LA[16], LB[16];
    { bf16x8 qa[8], qb[8];
      route_load_q(qp, t0, r, hh, hd, 0, qa); route_load_q(qp, t0, r, hh, hd, 1, qb);
      route_half(lds, qa, r, hh, 0, LA);
      route_half(lds, qb, r, hh, 1, LB); }
#pragma unroll
    for (int m = 0; m < 16; ++m) { mine[m] = LA[m]; mine[16 + m] = LB[m]; }
    float F[16];
#pragma unroll
    for (int m = 0; m < 16; ++m) F[m] = -3.0e38f;
    {
        constexpr int NC = 50;
#define CAND_I(c) cand_i_of(c)
#pragma unroll
        for (int c = 0; c < NC; c += 2) {
            const int i0 = cand_i_of(c), j0 = cand_j_of(c), i1 = cand_i_of(c + 1), j1 = cand_j_of(c + 1);
            float a_lo = LA[i0], a_hi = LA[i1], b_lo = LB[j0], b_hi = LB[j1];
            const float sm = (hh ? a_hi : a_lo) + (hh ? b_hi : b_lo);
            const unsigned pos = hh ? (unsigned)(i1 * 16 + j1) : (unsigned)(i0 * 16 + j0);
            const float pkd = __uint_as_float((__float_as_uint(sm) & ~255u) | pos);
            INS_PACKED(F, pkd);
        }
#undef CAND_I
    }
    merge_halves_sorted(F);
    int io[8]; float so[8];
#pragma unroll
    for (int k = 0; k < 8; ++k) {
        float f_lo = F[k], f_hi = F[8 + k];
        asm volatile("" : "+v"(f_lo), "+v"(f_hi));
        const float fv = hh ? f_hi : f_lo;
        const unsigned pos = __float_as_uint(fv) & 255u;
        const unsigned ia = __float_as_uint(mine[pos >> 4]) & 127u, ib = __float_as_uint(mine[16 + (pos & 15u)]) & 127u;
        io[k] = (int)(ia * 128u + ib); so[k] = __uint_as_float(__float_as_uint(fv) & ~255u);
    }
    const size_t ob = ((size_t)(t0 + r) * 8 + hd) * 16 + 8 * hh;
    *(u32x4*)(idxo + ob) = (u32x4){(unsigned)io[0], (unsigned)io[1], (unsigned)io[2], (unsigned)io[3]};
    *(u32x4*)(idxo + ob + 4) = (u32x4){(unsigned)io[4], (unsigned)io[5], (unsigned)io[6], (unsigned)io[7]};
    *(f32x4*)(sco + ob) = (f32x4){so[0], so[1], so[2], so[3]};
    *(f32x4*)(sco + ob + 4) = (f32x4){so[4], so[5], so[6], so[7]};
}

template <bool DRY>
__device__ __forceinline__ void gather_token8(int l, int t, float* out, const float* g2w, const unsigned char* PU, const unsigned char* PV, const float* SU, const float* SV,
                                              const int* idxs, const float* scos, bf16_t* XN, int lane) {
    const int gg = lane >> 5, j = lane & 31;
    float* xrow = out + (size_t)t * DM;
    unsigned xp[2][8];
    float rstd;
    {
        f32x4 xa[2][4]; float ss = 0.f;
#pragma unroll
        for (int c = 0; c < 2; ++c)
#pragma unroll
            for (int q = 0; q < 4; ++q) { const f32x4 a = *(const f32x4*)(xrow + 16 * (j + 32 * c) + 4 * q); xa[c][q] = a; ss += (a.x * a.x + a.y * a.y) + (a.z * a.z + a.w * a.w); }
        ss += __shfl_xor(ss, 1); ss += __shfl_xor(ss, 2); ss += __shfl_xor(ss, 4); ss += __shfl_xor(ss, 8); ss += __shfl_xor(ss, 16);
        rstd = rsqrtf(ss * (1.f / DM) + EPS);
#pragma unroll
        for (int c = 0; c < 2; ++c)
#pragma unroll
            for (int q = 0; q < 4; ++q) { const f32x4 ga = *(const f32x4*)(g2w + 16 * (j + 32 * c) + 4 * q); const f32x4 a = xa[c][q];
                xp[c][2 * q] = pk2(a.x * ga.x * rstd, a.y * ga.y * rstd); xp[c][2 * q + 1] = pk2(a.z * ga.z * rstd, a.w * ga.w * rstd); }
    }
    const int my_i0 = idxs[(size_t)t * 128 + 2 * j + gg], my_i1 = idxs[(size_t)t * 128 + 2 * (j + 32) + gg];
    float my_g0, my_g1;
    {
        const float s0 = scos[(size_t)t * 128 + 2 * j + gg], s1 = scos[(size_t)t * 128 + 2 * (j + 32) + gg];
        const int src = lane & 24;
        const float m0 = __shfl(s0, src), m1 = __shfl(s1, src);
        const float e0 = __expf((s0 - m0) * rstd), e1 = __expf((s1 - m1) * rstd);
        float z0 = e0, z1 = e1;
        z0 += __shfl_xor(z0, 1); z0 += __shfl_xor(z0, 2); z0 += __shfl_xor(z0, 4); z0 += __shfl_xor(z0, 32);
        z1 += __shfl_xor(z1, 1); z1 += __shfl_xor(z1, 2); z1 += __shfl_xor(z1, 4); z1 += __shfl_xor(z1, 32);
        my_g0 = e0 / z0; my_g1 = e1 / z1;
    }
    f32x2 acc[2][8];
#pragma unroll
    for (int c = 0; c < 2; ++c)
#pragma unroll
        for (int q = 0; q < 8; ++q) acc[c][q] = (f32x2){0.f, 0.f};
    struct Stage { u32x4 u0, u1, v0, v1; float us, vs, gt; };
    Stage S0, S1, S2, S3;
#define G8_LOAD(S, i) do { const int _sel = (lane & 32) | ((i) & 31); const int _e = __shfl((i) < 32 ? my_i0 : my_i1, _sel); S.gt = __shfl((i) < 32 ? my_g0 : my_g1, _sel); \
        S.us = SU[_e]; S.vs = SV[_e]; const unsigned char* _ur = PU + (size_t)_e * 1024 + j * 16; const unsigned char* _vr = PV + (size_t)_e * 1024 + j * 16; \
        S.u0 = *(const u32x4*)_ur; S.u1 = *(const u32x4*)(_ur + 512); S.v0 = *(const u32x4*)_vr; S.v1 = *(const u32x4*)(_vr + 512); } while (0)
#define G8_XF(P) ((f32x2){__uint_as_float((P) << 16), __uint_as_float((P) & 0xffff0000u)})
#define G8_DOT1(W, X0, X1) do { d2 = __builtin_amdgcn_cvt_pk_f32_fp8((int)(W), false) * G8_XF(X0) + d2; d2 = __builtin_amdgcn_cvt_pk_f32_fp8((int)(W), true) * G8_XF(X1) + d2; } while (0)
#define G8_AXPY1(W, A0, A1) do { A0 = __builtin_amdgcn_cvt_pk_f32_fp8((int)(W), false) * a2 + A0; A1 = __builtin_amdgcn_cvt_pk_f32_fp8((int)(W), true) * a2 + A1; } while (0)
#define G8_COMPUTE(S) do { f32x2 d2 = (f32x2){0.f, 0.f}; \
        G8_DOT1(S.u0.x, xp[0][0], xp[0][1]); G8_DOT1(S.u0.y, xp[0][2], xp[0][3]); G8_DOT1(S.u0.z, xp[0][4], xp[0][5]); G8_DOT1(S.u0.w, xp[0][6], xp[0][7]); \
        G8_DOT1(S.u1.x, xp[1][0], xp[1][1]); G8_DOT1(S.u1.y, xp[1][2], xp[1][3]); G8_DOT1(S.u1.z, xp[1][4], xp[1][5]); G8_DOT1(S.u1.w, xp[1][6], xp[1][7]); \
        float _d = d2.x + d2.y; _d += __shfl_xor(_d, 1); _d += __shfl_xor(_d, 2); _d += __shfl_xor(_d, 4); _d += __shfl_xor(_d, 8); _d += __shfl_xor(_d, 16); _d *= S.us; \
        const float _a = S.gt * 0.5f * _d * (1.f + erff(_d * 0.70710678118654752f)) * S.vs; const f32x2 a2 = (f32x2){_a, _a}; \
        G8_AXPY1(S.v0.x, acc[0][0], acc[0][1]); G8_AXPY1(S.v0.y, acc[0][2], acc[0][3]); G8_AXPY1(S.v0.z, acc[0][4], acc[0][5]); G8_AXPY1(S.v0.w, acc[0][6], acc[0][7]); \
        G8_AXPY1(S.v1.x, acc[1][0], acc[1][1]); G8_AXPY1(S.v1.y, acc[1][2], acc[1][3]); G8_AXPY1(S.v1.z, acc[1][4], acc[1][5]); G8_AXPY1(S.v1.w, acc[1][6], acc[1][7]); } while (0)
    G8_LOAD(S0, 0); G8_LOAD(S1, 1); G8_LOAD(S2, 2);
#pragma unroll 1
    for (int i = 0; i < 64; i += 4) {
        G8_LOAD(S3, i + 3); G8_COMPUTE(S0);
        if (i + 4 < 64) G8_LOAD(S0, i + 4);
        G8_COMPUTE(S1);
        if (i + 4 < 64) G8_LOAD(S1, i + 5);
        G8_COMPUTE(S2);
        if (i + 4 < 64) G8_LOAD(S2, i + 6);
        G8_COMPUTE(S3);
    }
#undef G8_LOAD
#undef G8_XF
#undef G8_DOT1
#undef G8_AXPY1
#undef G8_COMPUTE
    float s2[16];
#pragma unroll
    for (int q = 0; q < 8; ++q) {
        const f32x2 mine2 = gg ? acc[1][q] : acc[0][q], send = gg ? acc[0][q] : acc[1][q];
        s2[2 * q] = mine2.x + __shfl_xor(send.x, 32); s2[2 * q + 1] = mine2.y + __shfl_xor(send.y, 32);
    }
    float* px = xrow + 16 * (j + 32 * gg);
    f32x4 xo[4]; float sq = 0.f;
#pragma unroll
    for (int q = 0; q < 4; ++q) { xo[q] = *(const f32x4*)(px + 4 * q); xo[q] += (f32x4){s2[4 * q], s2[4 * q + 1], s2[4 * q + 2], s2[4 * q + 3]}; if (!DRY || xo[q].x == 1.2345e-30f) *(f32x4*)(px + 4 * q) = xo[q];
        sq += (xo[q].x * xo[q].x + xo[q].y * xo[q].y) + (xo[q].z * xo[q].z + xo[q].w * xo[q].w); }
    if (!DRY && l + 1 < DEPTH) {
        const float r1 = rsqrtf(wave_sum(sq) * (1.f / DM) + EPS);
        u32x4 o0, o1;
        o0.x = pk2(xo[0].x * r1, xo[0].y * r1); o0.y = pk2(xo[0].z * r1, xo[0].w * r1); o0.z = pk2(xo[1].x * r1, xo[1].y * r1); o0.w = pk2(xo[1].z * r1, xo[1].w * r1);
        o1.x = pk2(xo[2].x * r1, xo[2].y * r1); o1.y = pk2(xo[2].z * r1, xo[2].w * r1); o1.z = pk2(xo[3].x * r1, xo[3].y * r1); o1.w = pk2(xo[3].z * r1, xo[3].w * r1);
        u32x4* po = (u32x4*)(XN + (size_t)t * DM + 16 * (j + 32 * gg));
        po[0] = o0; po[1] = o1;
    }
}

#define DPP_ROR_ADD(v, N) do { const int _iv = __builtin_bit_cast(int, (v)); const int _r = __builtin_amdgcn_update_dpp(_iv, _iv, 0x120 + (N), 0xf, 0xf, false); (v) += __builtin_bit_cast(float, _r); } while (0)
__device__ __forceinline__ float sum32(float v) {
    DPP_ROR_ADD(v, 8); DPP_ROR_ADD(v, 4); DPP_ROR_ADD(v, 2); DPP_ROR_ADD(v, 1);
    const int sw = __builtin_amdgcn_ds_swizzle(__builtin_bit_cast(int, v), 0x401F);
    return v + __builtin_bit_cast(float, sw);
}
__device__ __forceinline__ float gelu_fast(float v) {
    const float av = fabsf(v), t = __builtin_amdgcn_rcpf(av * 0.2316418882f + 1.0f);
    float q = t * 0.5307027145f + (-0.7265760135f); q = q * t + 0.7107068705f; q = q * t + (-0.142248368f); q = q * t + 0.127414796f; q = q * t;
    const float e = __builtin_amdgcn_exp2f((v * v) * (-0.72134752044f));
    const float m = v * (q * e);
    return v < 0.f ? m : v - m;
}

#ifndef F4_ROWSCALE
#define F4_ROWSCALE 1
#endif
constexpr int F4_ROW = F4_ROWSCALE ? 512 : 576;
#ifndef F4_STAGES
#define F4_STAGES 4
#endif
__device__ __forceinline__ void phase_table_fp4(int wv0) {
    FRESH_PARAMS; FRESH_IDS;
    unsigned char* P4 = p.ws + WS_P8;
    constexpr int NTR = DEPTH * 2 * NEXP, TB = 4;
#pragma unroll 1
    for (int row0 = TB * gw; row0 < NTR; row0 += TB * ngw) {
      f32x4 vb[TB][4];
      {
          const int tib = row0 / NEXP, eb = row0 % NEXP, lb = tib >> 1;
          const float* srcb = ((tib & 1) ? p.peer_v : p.peer_u) + ((size_t)lb * NEXP + eb) * DM + lane * 16;
#pragma unroll
          for (int bi = 0; bi < TB; ++bi)
#pragma unroll
              for (int q = 0; q < 4; ++q) vb[bi][q] = __builtin_nontemporal_load((const f32x4*)(srcb + (size_t)bi * DM + 4 * q));
      }
#pragma unroll
      for (int bi = 0; bi < TB; ++bi) {
        const int row = row0 + bi;
        const int ti = row / NEXP, e = row % NEXP, l = ti >> 1;
        f32x4 v[4]; float am = 0.f;
#pragma unroll
        for (int q = 0; q < 4; ++q) { v[q] = vb[bi][q]; am = fmaxf(am, fmaxf(fmaxf(fabsf(v[q].x), fabsf(v[q].y)), fmaxf(fabsf(v[q].z), fabsf(v[q].w)))); }
#if USE_I3U
        if ((ti & 1) == 0) {
            float sq = 0.f;
#pragma unroll
            for (int q = 0; q < 4; ++q) sq += (v[q].x * v[q].x + v[q].y * v[q].y) + (v[q].z * v[q].z + v[q].w * v[q].w);
            const float rms = sqrtf(wave_sum(sq) * (1.f / DM));
            const float su = fmaxf(rms * (2.0f / 3.5f), 1e-30f), iq = 1.f / su;
            unsigned lo8 = 0u, hi8 = 0u; int qs = 0;
#pragma unroll
            for (int q = 0; q < 4; ++q)
#pragma unroll
                for (int c4 = 0; c4 < 4; ++c4) { const int qv = (int)fminf(fmaxf(floorf(v[q][c4] * iq) + 4.f, 0.f), 7.f); qs += qv;
                    if (q < 2) lo8 |= (unsigned)qv << (4 * (4 * q + c4)); else hi8 |= (unsigned)qv << (4 * (4 * (q - 2) + c4)); }
            const float qsum = wave_sum((float)qs);
            const unsigned s0 = (hi8 & 0x11111111u) << 3, s1 = (hi8 & 0x22222222u) << 2, s2 = (hi8 & 0x44444444u) << 1;
            const unsigned r0 = (unsigned)__shfl_xor((int)s0, 1), r1 = (unsigned)__shfl_xor((int)s1, 1);
            unsigned char* dst = P4 + (size_t)ti * NEXP * F4_ROW + (size_t)e * 384 + (lane >> 1) * 12;
            if ((lane & 1) == 0) { *(unsigned*)dst = lo8 | r0; *(unsigned*)(dst + 4) = hi8 | r1; }
            else *(unsigned*)(dst + 8) = lo8 | s2;
            if (lane == 0) ((f32x2*)(p.ws + WS_SUQ))[(size_t)l * NEXP + e] = (f32x2){su, su * qsum * 0.25f};
            continue;
        }
#elif USE_I4U
        if ((ti & 1) == 0) {
            float sq = 0.f;
#pragma unroll
            for (int q = 0; q < 4; ++q) sq += (v[q].x * v[q].x + v[q].y * v[q].y) + (v[q].z * v[q].z + v[q].w * v[q].w);
            const float rms = sqrtf(wave_sum(sq) * (1.f / DM));
            const float su = fmaxf(rms * (2.4f / 7.f), 1e-30f), iq = 1.f / su;
            unsigned wq0 = 0u, wq1 = 0u; int qs = 0;
#pragma unroll
            for (int q = 0; q < 4; ++q)
#pragma unroll
                for (int c4 = 0; c4 < 4; ++c4) { const int qv = (int)__builtin_rintf(fminf(fmaxf(v[q][c4] * iq, -7.f), 7.f)); qs += qv;
                    if (q < 2) wq0 |= ((unsigned)qv & 0xfu) << (4 * (4 * q + c4)); else wq1 |= ((unsigned)qv & 0xfu) << (4 * (4 * (q - 2) + c4)); }
            const float qsum = wave_sum((float)qs);
            *(u32x2*)(P4 + (size_t)row * F4_ROW + lane * 8) = (u32x2){wq0, wq1};
            if (lane == 0) ((f32x2*)(p.ws + WS_SUQ))[(size_t)l * NEXP + e] = (f32x2){su, su * qsum * 0.25f};
            continue;
        }
#endif
#if F4_ROWSCALE
        am = wave_max(am);
        const float rsc = fmaxf(am * (1.f / 6.f), 1e-30f);
        const unsigned sb = 0u; const float inv = 1.f / rsc;
        if (lane == 0) ((float*)(p.ws + WS_SCL))[row] = rsc;
#else
        am = fmaxf(am, __shfl_xor(am, 1));
        const unsigned sb = f2bf(fmaxf(am * (1.f / 6.f), 1e-30f));
        const float inv = 1.f / bf2f(sb);
#endif
        unsigned w0 = 0u, w1 = 0u;
        w0 = __builtin_amdgcn_cvt_scalef32_pk_fp4_f32(w0, v[0].x * inv, v[0].y * inv, 1.0f, 0); w0 = __builtin_amdgcn_cvt_scalef32_pk_fp4_f32(w0, v[0].z * inv, v[0].w * inv, 1.0f, 1);
        w0 = __builtin_amdgcn_cvt_scalef32_pk_fp4_f32(w0, v[1].x * inv, v[1].y * inv, 1.0f, 2); w0 = __builtin_amdgcn_cvt_scalef32_pk_fp4_f32(w0, v[1].z * inv, v[1].w * inv, 1.0f, 3);
        w1 = __builtin_amdgcn_cvt_scalef32_pk_fp4_f32(w1, v[2].x * inv, v[2].y * inv, 1.0f, 0); w1 = __builtin_amdgcn_cvt_scalef32_pk_fp4_f32(w1, v[2].z * inv, v[2].w * inv, 1.0f, 1);
        w1 = __builtin_amdgcn_cvt_scalef32_pk_fp4_f32(w1, v[3].x * inv, v[3].y * inv, 1.0f, 2); w1 = __builtin_amdgcn_cvt_scalef32_pk_fp4_f32(w1, v[3].z * inv, v[3].w * inv, 1.0f, 3);
        unsigned char* dst = P4 + (size_t)row * F4_ROW;
        *(u32x2*)(dst + lane * 8) = (u32x2){w0, w1};
        if (!F4_ROWSCALE && (lane & 1) == 0) *(bf16_t*)(dst + 512 + lane) = (bf16_t)sb;
      }
    }
}

template <bool DRY>
__device__ __forceinline__ void gather_token4(int l, int t, float* out, const float* g2w, const unsigned char* PU, const unsigned char* PV,
                                              const int* idxs, const float* scos, bf16_t* XN, int lane) {
    const int gg = lane >> 5, j = lane & 31;
    float* xrow = out + (size_t)t * DM;
    f32x2 xv[16];
    float rstd;
    {
        f32x4 xa[8]; float ss = 0.f;
#pragma unroll
        for (int q = 0; q < 8; ++q) { const f32x4 a = *(const f32x4*)(xrow + 32 * j + 4 * q); xa[q] = a; ss += (a.x * a.x + a.y * a.y) + (a.z * a.z + a.w * a.w); }
        ss += __shfl_xor(ss, 1); ss += __shfl_xor(ss, 2); ss += __shfl_xor(ss, 4); ss += __shfl_xor(ss, 8); ss += __shfl_xor(ss, 16);
        rstd = rsqrtf(ss * (1.f / DM) + EPS);
#pragma unroll
        for (int q = 0; q < 8; ++q) { const f32x4 ga = *(const f32x4*)(g2w + 32 * j + 4 * q); const f32x4 a = xa[q];
            xv[2 * q] = (f32x2){bf2f(f2bf(a.x * ga.x * rstd)), bf2f(f2bf(a.y * ga.y * rstd))}; xv[2 * q + 1] = (f32x2){bf2f(f2bf(a.z * ga.z * rstd)), bf2f(f2bf(a.w * ga.w * rstd))}; }
    }
    const int my_i0 = idxs[(size_t)t * 128 + 2 * j + gg], my_i1 = idxs[(size_t)t * 128 + 2 * (j + 32) + gg];
    float my_g0, my_g1;
    {
        const float s0 = scos[(size_t)t * 128 + 2 * j + gg], s1 = scos[(size_t)t * 128 + 2 * (j + 32) + gg];
        const int src = lane & 24;
        const float m0 = __shfl(s0, src), m1 = __shfl(s1, src);
        const float e0 = __expf((s0 - m0) * rstd), e1 = __expf((s1 - m1) * rstd);
        float z0 = e0, z1 = e1;
        z0 += __shfl_xor(z0, 1); z0 += __shfl_xor(z0, 2); z0 += __shfl_xor(z0, 4); z0 += __shfl_xor(z0, 32);
        z1 += __shfl_xor(z1, 1); z1 += __shfl_xor(z1, 2); z1 += __shfl_xor(z1, 4); z1 += __shfl_xor(z1, 32);
        my_g0 = e0 / z0; my_g1 = e1 / z1;
    }
    f32x2 acc[16];
#pragma unroll
    for (int q = 0; q < 16; ++q) acc[q] = (f32x2){0.f, 0.f};
    struct Stage { u32x4 u, v; unsigned short su, sv; float gt; };
#if F4_STAGES == 8
    Stage S0, S1, S2, S3, S4, S5, S6, S7;
#else
    Stage S0, S1, S2, S3;
#endif
#define G4_LOAD(S, i) do { const int _sel = (lane & 32) | ((i) & 31); const int _e = __shfl((i) < 32 ? my_i0 : my_i1, _sel); S.gt = __shfl((i) < 32 ? my_g0 : my_g1, _sel); \
        const unsigned char* _ur = PU + (size_t)_e * F4_ROW; const unsigned char* _vr = PV + (size_t)_e * F4_ROW; \
        S.u = *(const u32x4*)(_ur + j * 16); S.v = *(const u32x4*)(_vr + j * 16); S.su = *(const unsigned short*)(_ur + 512 + 2 * j); S.sv = *(const unsigned short*)(_vr + 512 + 2 * j); } while (0)
#define G4_DOT1(W, Q) do { d2 = __builtin_amdgcn_cvt_scalef32_pk_f32_fp4((W), 1.0f, 0) * xv[(Q)] + d2; d2 = __builtin_amdgcn_cvt_scalef32_pk_f32_fp4((W), 1.0f, 1) * xv[(Q) + 1] + d2; \
        e2 = __builtin_amdgcn_cvt_scalef32_pk_f32_fp4((W), 1.0f, 2) * xv[(Q) + 2] + e2; e2 = __builtin_amdgcn_cvt_scalef32_pk_f32_fp4((W), 1.0f, 3) * xv[(Q) + 3] + e2; } while (0)
#define G4_AXPY1(W, Q) do { acc[(Q)] = __builtin_amdgcn_cvt_scalef32_pk_f32_fp4((W), 1.0f, 0) * a2 + acc[(Q)]; acc[(Q) + 1] = __builtin_amdgcn_cvt_scalef32_pk_f32_fp4((W), 1.0f, 1) * a2 + acc[(Q) + 1]; \
        acc[(Q) + 2] = __builtin_amdgcn_cvt_scalef32_pk_f32_fp4((W), 1.0f, 2) * a2 + acc[(Q) + 2]; acc[(Q) + 3] = __builtin_amdgcn_cvt_scalef32_pk_f32_fp4((W), 1.0f, 3) * a2 + acc[(Q) + 3]; } while (0)
#define G4_COMPUTE(S) do { f32x2 d2 = (f32x2){0.f, 0.f}, e2 = (f32x2){0.f, 0.f}; \
        G4_DOT1(S.u.x, 0); G4_DOT1(S.u.y, 4); G4_DOT1(S.u.z, 8); G4_DOT1(S.u.w, 12); \
        const float _d = sum32(((d2.x + d2.y) + (e2.x + e2.y)) * bf2f(S.su)); \
        const float _a = S.gt * gelu_fast(_d) * bf2f(S.sv); const f32x2 a2 = (f32x2){_a, _a}; \
        G4_AXPY1(S.v.x, 0); G4_AXPY1(S.v.y, 4); G4_AXPY1(S.v.z, 8); G4_AXPY1(S.v.w, 12); } while (0)
#if F4_STAGES == 8
    G4_LOAD(S0, 0); G4_LOAD(S1, 1); G4_LOAD(S2, 2); G4_LOAD(S3, 3); G4_LOAD(S4, 4); G4_LOAD(S5, 5); G4_LOAD(S6, 6);
#pragma unroll 1
    for (int i = 0; i < 64; i += 8) {
        const bool more = i + 8 < 64;
        G4_LOAD(S7, i + 7); G4_COMPUTE(S0);
        if (more) G4_LOAD(S0, i + 8);
        G4_COMPUTE(S1);
        if (more) G4_LOAD(S1, i + 9);
        G4_COMPUTE(S2);
        if (more) G4_LOAD(S2, i + 10);
        G4_COMPUTE(S3);
        if (more) G4_LOAD(S3, i + 11);
        G4_COMPUTE(S4);
        if (more) G4_LOAD(S4, i + 12);
        G4_COMPUTE(S5);
        if (more) G4_LOAD(S5, i + 13);
        G4_COMPUTE(S6);
        if (more) G4_LOAD(S6, i + 14);
        G4_COMPUTE(S7);
    }
#else
    G4_LOAD(S0, 0); G4_LOAD(S1, 1); G4_LOAD(S2, 2);
#pragma unroll 1
    for (int i = 0; i < 64; i += 4) {
        const bool more = i + 4 < 64;
        G4_LOAD(S3, i + 3); G4_COMPUTE(S0);
        if (more) G4_LOAD(S0, i + 4);
        G4_COMPUTE(S1);
        if (more) G4_LOAD(S1, i + 5);
        G4_COMPUTE(S2);
        if (more) G4_LOAD(S2, i + 6);
        G4_COMPUTE(S3);
    }
#endif
#undef G4_LOAD
#undef G4_DOT1
#undef G4_AXPY1
#undef G4_COMPUTE
    float s2[16];
#pragma unroll
    for (int q = 0; q < 8; ++q) {
        const f32x2 mine2 = gg ? acc[8 + q] : acc[q], send = gg ? acc[q] : acc[8 + q];
        s2[2 * q] = mine2.x + __shfl_xor(send.x, 32); s2[2 * q + 1] = mine2.y + __shfl_xor(send.y, 32);
    }
    float* px = xrow + 32 * j + 16 * gg;
    f32x4 xo[4]; float sq = 0.f;
#pragma unroll
    for (int q = 0; q < 4; ++q) { xo[q] = *(const f32x4*)(px + 4 * q); xo[q] += (f32x4){s2[4 * q], s2[4 * q + 1], s2[4 * q + 2], s2[4 * q + 3]}; if (!DRY || xo[q].x == 1.2345e-30f) *(f32x4*)(px + 4 * q) = xo[q];
        sq += (xo[q].x * xo[q].x + xo[q].y * xo[q].y) + (xo[q].z * xo[q].z + xo[q].w * xo[q].w); }
    if (!DRY && l + 1 < DEPTH) {
        const float r1 = rsqrtf(wave_sum(sq) * (1.f / DM) + EPS);
        u32x4 o0, o1;
        o0.x = pk2(xo[0].x * r1, xo[0].y * r1); o0.y = pk2(xo[0].z * r1, xo[0].w * r1); o0.z = pk2(xo[1].x * r1, xo[1].y * r1); o0.w = pk2(xo[1].z * r1, xo[1].w * r1);
        o1.x = pk2(xo[2].x * r1, xo[2].y * r1); o1.y = pk2(xo[2].z * r1, xo[2].w * r1); o1.z = pk2(xo[3].x * r1, xo[3].y * r1); o1.w = pk2(xo[3].z * r1, xo[3].w * r1);
        u32x4* po = (u32x4*)(XN + (size_t)t * DM + 32 * j + 16 * gg);
        po[0] = o0; po[1] = o1;
    }
}

template <bool DRY>
__device__ __forceinline__ void gather_token4b(int l, int t, float* out, const bf16_t* XB, float* rstd_out, const float* g2w, const unsigned char* PU, const unsigned char* PV,
                                               const int* idxs, const float* scos, bf16_t* XN, LAS unsigned* wl  , int lane) {
    const int gg = lane >> 5, j = lane & 31;
    float* xrow = out + (size_t)t * DM; const bf16_t* xbrow = XB + (size_t)t * DM;
    { const u32x2 iv = *(const u32x2*)(idxs + (size_t)t * 128 + 2 * lane); wl[2 * lane] = iv.x; wl[2 * lane + 1] = iv.y; }
    f32x2 xv[16];
    float rstd;
    {
        f32x4 xa[8]; float ss = 0.f;
#pragma unroll
        for (int q = 0; q < 4; ++q) { float f[8]; unpack8(*(const u32x4*)(xbrow + 32 * j + 8 * q), f); xa[2 * q] = (f32x4){f[0], f[1], f[2], f[3]}; xa[2 * q + 1] = (f32x4){f[4], f[5], f[6], f[7]};
#pragma unroll
            for (int e = 0; e < 8; ++e) ss += f[e] * f[e]; }
        ss = sum32(ss);
        rstd = rsqrtf(ss * (1.f / DM) + EPS);
#pragma unroll
        for (int q = 0; q < 8; ++q) { const f32x4 ga = *(const f32x4*)(g2w + 32 * j + 4 * q); const f32x4 a = xa[q];
            xv[2 * q] = (f32x2){a.x * ga.x * rstd, a.y * ga.y * rstd}; xv[2 * q + 1] = (f32x2){a.z * ga.z * rstd, a.w * ga.w * rstd}; }
    }
    struct StU { u32x4 u; unsigned short su; };
    StU A0, A1, A2, A3, A4, A5, A6, A7;
#define P1_LOAD(S, i) do { const int _e = (int)wl[2 * (i) + gg]; const unsigned char* _ur = PU + (size_t)_e * F4_ROW; S.u = *(const u32x4*)(_ur + j * 16); S.su = *(const unsigned short*)(_ur + 512 + 2 * j); } while (0)
#define P1_DOT1(W, Q) do { d2 = __builtin_amdgcn_cvt_scalef32_pk_f32_fp4((W), 1.0f, 0) * xv[(Q)] + d2; e2 = __builtin_amdgcn_cvt_scalef32_pk_f32_fp4((W), 1.0f, 1) * xv[(Q) + 1] + e2; \
        d2 = __builtin_amdgcn_cvt_scalef32_pk_f32_fp4((W), 1.0f, 2) * xv[(Q) + 2] + d2; e2 = __builtin_amdgcn_cvt_scalef32_pk_f32_fp4((W), 1.0f, 3) * xv[(Q) + 3] + e2; } while (0)
#define P1_COMPUTE(S, PD) do { f32x2 d2 = (f32x2){0.f, 0.f}, e2 = (f32x2){0.f, 0.f}; P1_DOT1(S.u.x, 0); P1_DOT1(S.u.y, 4); P1_DOT1(S.u.z, 8); P1_DOT1(S.u.w, 12); \
        PD = ((d2.x + d2.y) + (e2.x + e2.y)) * bf2f(S.su); } while (0)
#define P1_STEP(S, k) do { P1_COMPUTE(S, P[(k)]); if (i0 + (k) + 8 < 64) P1_LOAD(S, i0 + (k) + 8); } while (0)
    P1_LOAD(A0, 0); P1_LOAD(A1, 1); P1_LOAD(A2, 2); P1_LOAD(A3, 3); P1_LOAD(A4, 4); P1_LOAD(A5, 5); P1_LOAD(A6, 6); P1_LOAD(A7, 7);
    const bool b4 = (lane & 16) != 0, b3 = (lane & 8) != 0, b2 = (lane & 4) != 0, b1 = (lane & 2) != 0;
    const int rho = (lane >> 1) & 15;
#pragma unroll 1
    for (int b = 0; b < 4; ++b) {
        const int i0 = 16 * b;
        float P[16];
        P1_STEP(A0, 0); P1_STEP(A1, 1); P1_STEP(A2, 2); P1_STEP(A3, 3); P1_STEP(A4, 4); P1_STEP(A5, 5); P1_STEP(A6, 6); P1_STEP(A7, 7);
        P1_STEP(A0, 8); P1_STEP(A1, 9); P1_STEP(A2, 10); P1_STEP(A3, 11); P1_STEP(A4, 12); P1_STEP(A5, 13); P1_STEP(A6, 14); P1_STEP(A7, 15);
        float Q8[8], R4[4], S2[2], h;
#pragma unroll
        for (int k = 0; k < 8; ++k) { const float mine = b4 ? P[8 + k] : P[k], send = b4 ? P[k] : P[8 + k]; Q8[k] = mine + __builtin_bit_cast(float, __builtin_amdgcn_ds_swizzle(__builtin_bit_cast(int, send), 0x401F)); }
#pragma unroll
        for (int k = 0; k < 4; ++k) { const float mine = b3 ? Q8[4 + k] : Q8[k], send = b3 ? Q8[k] : Q8[4 + k]; R4[k] = mine + DPP_MOV(send, 0x128); }
#pragma unroll
        for (int k = 0; k < 2; ++k) { const float mine = b2 ? R4[2 + k] : R4[k], send = b2 ? R4[k] : R4[2 + k]; S2[k] = mine + DPP_MOV(send, 0x141); }
        { const float mine = b1 ? S2[1] : S2[0], send = b1 ? S2[0] : S2[1]; h = mine + DPP_MOV(send, 0x4E); }
        h += DPP_MOV(h, 0xB1);
        const int r = 2 * (i0 + rho) + gg;
        const float sc = scos[(size_t)t * 128 + r];
        const float m0 = __shfl(sc, lane & 16);
        const float ex = __expf((sc - m0) * rstd);
        float z = ex;
        z += DPP_MOV(z, 0x4E); z += DPP_MOV(z, 0x141) ; z += DPP_MOV(z, 0x128);
        z += __shfl_xor(z, 32);
        const float a = (ex / z) * gelu_fast(h);
        if ((lane & 1) == 0) wl[128 + r] = __float_as_uint(a);
    }
#undef P1_LOAD
#undef P1_DOT1
#undef P1_COMPUTE
#undef P1_STEP
    f32x2 acc[16];
#pragma unroll
    for (int q = 0; q < 16; ++q) acc[q] = (f32x2){0.f, 0.f};
    struct StV { u32x4 v; unsigned short sv; float a; };
    StV B0, B1, B2, B3, B4, B5, B6, B7;
#define P2_LOAD(S, i) do { const int _e = (int)wl[2 * (i) + gg]; S.a = __uint_as_float(wl[128 + 2 * (i) + gg]); const unsigned char* _vr = PV + (size_t)_e * F4_ROW; S.v = *(const u32x4*)(_vr + j * 16); S.sv = *(const unsigned short*)(_vr + 512 + 2 * j); } while (0)
#define P2_AXPY1(W, Q) do { acc[(Q)] = __builtin_amdgcn_cvt_scalef32_pk_f32_fp4((W), 1.0f, 0) * a2 + acc[(Q)]; acc[(Q) + 1] = __builtin_amdgcn_cvt_scalef32_pk_f32_fp4((W), 1.0f, 1) * a2 + acc[(Q) + 1]; \
        acc[(Q) + 2] = __builtin_amdgcn_cvt_scalef32_pk_f32_fp4((W), 1.0f, 2) * a2 + acc[(Q) + 2]; acc[(Q) + 3] = __builtin_amdgcn_cvt_scalef32_pk_f32_fp4((W), 1.0f, 3) * a2 + acc[(Q) + 3]; } while (0)
#define P2_STEP(S, k) do { { const float _a = S.a * bf2f(S.sv); const f32x2 a2 = (f32x2){_a, _a}; P2_AXPY1(S.v.x, 0); P2_AXPY1(S.v.y, 4); P2_AXPY1(S.v.z, 8); P2_AXPY1(S.v.w, 12); } \
        if (i0 + (k) + 8 < 64) P2_LOAD(S, i0 + (k) + 8); } while (0)
    P2_LOAD(B0, 0); P2_LOAD(B1, 1); P2_LOAD(B2, 2); P2_LOAD(B3, 3); P2_LOAD(B4, 4); P2_LOAD(B5, 5); P2_LOAD(B6, 6); P2_LOAD(B7, 7);
#pragma unroll 1
    for (int i0 = 0; i0 < 64; i0 += 8) {
        P2_STEP(B0, 0); P2_STEP(B1, 1); P2_STEP(B2, 2); P2_STEP(B3, 3); P2_STEP(B4, 4); P2_STEP(B5, 5); P2_STEP(B6, 6); P2_STEP(B7, 7);
    }
#undef P2_LOAD
#undef P2_AXPY1
#undef P2_STEP
    float s2[16];
#pragma unroll
    for (int q = 0; q < 8; ++q) {
        const f32x2 mine2 = gg ? acc[8 + q] : acc[q], send = gg ? acc[q] : acc[8 + q];
        s2[2 * q] = mine2.x + __shfl_xor(send.x, 32); s2[2 * q + 1] = mine2.y + __shfl_xor(send.y, 32);
    }
    const int e0 = 32 * j + 16 * gg;
    f32x4 xo[4]; float sq = 0.f;
    { float f0[8], f1[8]; unpack8(*(const u32x4*)(xbrow + e0), f0); unpack8(*(const u32x4*)(xbrow + e0 + 8), f1);
      xo[0] = (f32x4){f0[0], f0[1], f0[2], f0[3]}; xo[1] = (f32x4){f0[4], f0[5], f0[6], f0[7]}; xo[2] = (f32x4){f1[0], f1[1], f1[2], f1[3]}; xo[3] = (f32x4){f1[4], f1[5], f1[6], f1[7]}; }
#pragma unroll
    for (int q = 0; q < 4; ++q) { xo[q] += (f32x4){s2[4 * q], s2[4 * q + 1], s2[4 * q + 2], s2[4 * q + 3]};
        sq += (xo[q].x * xo[q].x + xo[q].y * xo[q].y) + (xo[q].z * xo[q].z + xo[q].w * xo[q].w); }
    if (l + 1 < DEPTH) {
        const float r1 = rsqrtf(wave_sum(sq) * (1.f / DM) + EPS);
        if (!DRY) {
            u32x4 o0, o1;
            o0.x = pk2(xo[0].x, xo[0].y); o0.y = pk2(xo[0].z, xo[0].w); o0.z = pk2(xo[1].x, xo[1].y); o0.w = pk2(xo[1].z, xo[1].w);
            o1.x = pk2(xo[2].x, xo[2].y); o1.y = pk2(xo[2].z, xo[2].w); o1.z = pk2(xo[3].x, xo[3].y); o1.w = pk2(xo[3].z, xo[3].w);
            u32x4* po = (u32x4*)(XN + (size_t)t * DM + e0);
            po[0] = o0; po[1] = o1;
            if (lane == 0) rstd_out[t] = r1;
        }
    } else {
#pragma unroll
        for (int q = 0; q < 4; ++q) if (!DRY || xo[q].x == 1.2345e-30f) *(f32x4*)(xrow + e0 + 4 * q) = xo[q];
    }
}

template <unsigned IDXMASK>
__device__ __forceinline__ void gather_pass1(int t, const bf16_t* XB, const float* g2w, const unsigned char* PU, const float* SU, const int* idxs, const float* scos, LAS unsigned* wl, int lane) {
    const int gg = lane >> 5, j = lane & 31;
    const bf16_t* xbrow = XB + (size_t)t * DM;
#if !P1_PRESTAGE
    { const u32x2 iv = *(const u32x2*)(idxs + (size_t)t * 128 + 2 * lane); wl[2 * lane] = iv.x & IDXMASK; wl[2 * lane + 1] = iv.y & IDXMASK; }
#endif
    float sc4[4];
#pragma unroll
    for (int bb = 0; bb < 4; ++bb) sc4[bb] = scos[(size_t)t * 128 + 2 * (16 * bb + ((lane >> 1) & 15)) + gg];
#if USE_I4U
    unsigned xh[4], xl[4];
    float xscale, rstd;
    {
        float f[32]; float ss = 0.f;
#pragma unroll
        for (int q = 0; q < 4; ++q) { unpack8(*(const u32x4*)(xbrow + 32 * j + 8 * q), f + 8 * q);
#pragma unroll
            for (int e = 0; e < 8; ++e) ss += f[8 * q + e] * f[8 * q + e]; }
        ss = sum32(ss);
        rstd = rsqrtf(ss * (1.f / DM) + EPS);
        float am = 0.f;
#pragma unroll
        for (int q = 0; q < 8; ++q) { const f32x4 ga = *(const f32x4*)(g2w + 32 * j + 4 * q);
            f[4 * q] *= ga.x * rstd; f[4 * q + 1] *= ga.y * rstd; f[4 * q + 2] *= ga.z * rstd; f[4 * q + 3] *= ga.w * rstd;
            am = fmaxf(am, fmaxf(fmaxf(fabsf(f[4 * q]), fabsf(f[4 * q + 1])), fmaxf(fabsf(f[4 * q + 2]), fabsf(f[4 * q + 3])))); }
        am = fmaxf(am, DPP_MOV(am, 0xB1)); am = fmaxf(am, DPP_MOV(am, 0x4E)); am = fmaxf(am, DPP_MOV(am, 0x141)); am = fmaxf(am, DPP_MOV(am, 0x128));
        am = fmaxf(am, __builtin_bit_cast(float, __builtin_amdgcn_ds_swizzle(__builtin_bit_cast(int, am), 0x401F)));
        am = fmaxf(am, 1e-30f);
        xscale = am * (1.f / 127.f);
        const float iq = 127.f / am;
#pragma unroll
        for (int w = 0; w < 4; ++w) { unsigned h4 = 0u, l4 = 0u;
#pragma unroll
            for (int pp = 0; pp < 8; ++pp) { const int bq = (int)__builtin_rintf(f[8 * w + pp] * iq) + 128;
                h4 |= (unsigned)(((bq >> 4) - 8) & 0xf) << (4 * pp); l4 |= (unsigned)(((bq & 15) - 8) & 0xf) << (4 * pp); }
            xh[w] = h4; xl[w] = l4; }
    }
#else
    f32x2 xv[16];
    float rstd;
    {
        f32x4 xa[8]; float ss = 0.f;
#pragma unroll
        for (int q = 0; q < 4; ++q) { float f[8]; unpack8(*(const u32x4*)(xbrow + 32 * j + 8 * q), f); xa[2 * q] = (f32x4){f[0], f[1], f[2], f[3]}; xa[2 * q + 1] = (f32x4){f[4], f[5], f[6], f[7]};
#pragma unroll
            for (int e = 0; e < 8; ++e) ss += f[e] * f[e]; }
        ss = sum32(ss);
        rstd = rsqrtf(ss * (1.f / DM) + EPS);
#pragma unroll
        for (int q = 0; q < 8; ++q) { const f32x4 ga = *(const f32x4*)(g2w + 32 * j + 4 * q); const f32x4 a = xa[q];
            xv[2 * q] = (f32x2){a.x * ga.x * rstd, a.y * ga.y * rstd}; xv[2 * q + 1] = (f32x2){a.z * ga.z * rstd, a.w * ga.w * rstd}; }
    }
#endif
#if USE_I4U
    struct StU { u32x4 u; f32x2 sq; };
#elif F4_ROWSCALE
    struct StU { u32x4 u; float su; };
#else
    struct StU { u32x4 u; unsigned short su; };
#endif
    StU A0, A1, A2, A3, A4, A5, A6, A7, A8, A9, A10, A11, A12, A13, A14, A15;
#if USE_I4U
#define P1_LOAD(S, i) do { const int _e = (int)wl[2 * (i) + gg]; S.u = *(const u32x4*)(PU + (size_t)_e * F4_ROW + j * 16); S.sq = ((const f32x2*)SU)[_e]; } while (0)
#define P1_COMPUTE(S, PD) do { int _ah = 0, _al = 0; \
        _ah = __builtin_amdgcn_sdot8((int)S.u.x, (int)xh[0], _ah, false); _al = __builtin_amdgcn_sdot8((int)S.u.x, (int)xl[0], _al, false); \
        _ah = __builtin_amdgcn_sdot8((int)S.u.y, (int)xh[1], _ah, false); _al = __builtin_amdgcn_sdot8((int)S.u.y, (int)xl[1], _al, false); \
        _ah = __builtin_amdgcn_sdot8((int)S.u.z, (int)xh[2], _ah, false); _al = __builtin_amdgcn_sdot8((int)S.u.z, (int)xl[2], _al, false); \
        _ah = __builtin_amdgcn_sdot8((int)S.u.w, (int)xh[3], _ah, false); _al = __builtin_amdgcn_sdot8((int)S.u.w, (int)xl[3], _al, false); \
        PD = (float)(16 * _ah + _al) * S.sq.x + S.sq.y; } while (0)
#else
#define P1_LOAD(S, i) do { const int _e = (int)wl[2 * (i) + gg]; const unsigned char* _ur = PU + (size_t)_e * F4_ROW; S.u = *(const u32x4*)(_ur + j * 16); if (F4_ROWSCALE) S.su = SU[_e]; else S.su = *(const unsigned short*)(_ur + 512 + 2 * j); } while (0)
#define P1_DOT1(W, Q) do { d2 = __builtin_amdgcn_cvt_scalef32_pk_f32_fp4((W), 1.0f, 0) * xv[(Q)] + d2; e2 = __builtin_amdgcn_cvt_scalef32_pk_f32_fp4((W), 1.0f, 1) * xv[(Q) + 1] + e2; \
        d2 = __builtin_amdgcn_cvt_scalef32_pk_f32_fp4((W), 1.0f, 2) * xv[(Q) + 2] + d2; e2 = __builtin_amdgcn_cvt_scalef32_pk_f32_fp4((W), 1.0f, 3) * xv[(Q) + 3] + e2; } while (0)
#define P1_COMPUTE(S, PD) do { f32x2 d2 = (f32x2){0.f, 0.f}, e2 = (f32x2){0.f, 0.f}; P1_DOT1(S.u.x, 0); P1_DOT1(S.u.y, 4); P1_DOT1(S.u.z, 8); P1_DOT1(S.u.w, 12); \
        PD = ((d2.x + d2.y) + (e2.x + e2.y)) * (F4_ROWSCALE ? (float)S.su : bf2f((unsigned)S.su)); } while (0)
#endif
#define P1_STEP(S, k) do { P1_COMPUTE(S, P[(k)]); if (i0 + 16 < 64) P1_LOAD(S, i0 + (k) + 16); } while (0)
    P1_LOAD(A0, 0); P1_LOAD(A1, 1); P1_LOAD(A2, 2); P1_LOAD(A3, 3); P1_LOAD(A4, 4); P1_LOAD(A5, 5); P1_LOAD(A6, 6); P1_LOAD(A7, 7);
    P1_LOAD(A8, 8); P1_LOAD(A9, 9); P1_LOAD(A10, 10); P1_LOAD(A11, 11); P1_LOAD(A12, 12); P1_LOAD(A13, 13); P1_LOAD(A14, 14); P1_LOAD(A15, 15);
    const bool b4 = (lane & 16) != 0, b3 = (lane & 8) != 0, b2 = (lane & 4) != 0, b1 = (lane & 2) != 0;
    const int rho = (lane >> 1) & 15;
#pragma unroll
    for (int b = 0; b < 4; ++b) {
        const int i0 = 16 * b;
        float P[16];
        P1_STEP(A0, 0); P1_STEP(A1, 1); P1_STEP(A2, 2); P1_STEP(A3, 3); P1_STEP(A4, 4); P1_STEP(A5, 5); P1_STEP(A6, 6); P1_STEP(A7, 7);
        P1_STEP(A8, 8); P1_STEP(A9, 9); P1_STEP(A10, 10); P1_STEP(A11, 11); P1_STEP(A12, 12); P1_STEP(A13, 13); P1_STEP(A14, 14); P1_STEP(A15, 15);
        float Q8[8], R4[4], S2[2], h;
#pragma unroll
        for (int k = 0; k < 8; ++k) { const float mine = b4 ? P[8 + k] : P[k], send = b4 ? P[k] : P[8 + k]; Q8[k] = mine + __builtin_bit_cast(float, __builtin_amdgcn_ds_swizzle(__builtin_bit_cast(int, send), 0x401F)); }
#pragma unroll
        for (int k = 0; k < 4; ++k) { const float mine = b3 ? Q8[4 + k] : Q8[k], send = b3 ? Q8[k] : Q8[4 + k]; R4[k] = mine + DPP_MOV(send, 0x128); }
#pragma unroll
        for (int k = 0; k < 2; ++k) { const float mine = b2 ? R4[2 + k] : R4[k], send = b2 ? R4[k] : R4[2 + k]; S2[k] = mine + DPP_MOV(send, 0x141); }
        { const float mine = b1 ? S2[1] : S2[0], send = b1 ? S2[0] : S2[1]; h = mine + DPP_MOV(send, 0x4E); }
        h += DPP_MOV(h, 0xB1);
        const int r = 2 * (i0 + rho) + gg;
        const float sc = sc4[b];
        const float m0 = __shfl(sc, lane & 16);
        const float ex = __expf((sc - m0) * rstd);
        float z = ex;
        z += DPP_MOV(z, 0x4E); z += DPP_MOV(z, 0x141) ; z += DPP_MOV(z, 0x128);
        z += __shfl_xor(z, 32);
        const float a = (ex / z) * gelu_fast(USE_I4U ? h * xscale : h);
        if ((lane & 1) == 0) wl[128 + r] = __float_as_uint(a);
    }
#undef P1_LOAD
#undef P1_DOT1
#undef P1_COMPUTE
#undef P1_STEP
}

template <bool DRY>
__device__ __forceinline__ void gather_pass2(int l, int t, float* out, const bf16_t* XB, float* rstd_out, const unsigned char* PV, const float* SV, bf16_t* XN, LAS unsigned* wl, int lane) {
    const int gg = lane >> 5, j = lane & 31;
    float* xrow = out + (size_t)t * DM; const bf16_t* xbrow = XB + (size_t)t * DM;
    f32x2 acc[16];
#pragma unroll
    for (int q = 0; q < 16; ++q) acc[q] = (f32x2){0.f, 0.f};
#if F4_ROWSCALE
    struct StV { u32x4 v; float sv; float a; };
#else
    struct StV { u32x4 v; unsigned short sv; float a; };
#endif
    StV B0, B1, B2, B3, B4, B5, B6, B7, B8, B9, B10, B11, B12, B13, B14, B15;
#define P2_LOAD(S, i) do { const int _e = (int)wl[2 * (i) + gg]; S.a = __uint_as_float(wl[128 + 2 * (i) + gg]); const unsigned char* _vr = PV + (size_t)_e * F4_ROW; S.v = *(const u32x4*)(_vr + j * 16); if (F4_ROWSCALE) S.sv = SV[_e]; else S.sv = *(const unsigned short*)(_vr + 512 + 2 * j); } while (0)
#define P2_AXPY1(W, Q) do { acc[(Q)] = __builtin_amdgcn_cvt_scalef32_pk_f32_fp4((W), 1.0f, 0) * a2 + acc[(Q)]; acc[(Q) + 1] = __builtin_amdgcn_cvt_scalef32_pk_f32_fp4((W), 1.0f, 1) * a2 + acc[(Q) + 1]; \
        acc[(Q) + 2] = __builtin_amdgcn_cvt_scalef32_pk_f32_fp4((W), 1.0f, 2) * a2 + acc[(Q) + 2]; acc[(Q) + 3] = __builtin_amdgcn_cvt_scalef32_pk_f32_fp4((W), 1.0f, 3) * a2 + acc[(Q) + 3]; } while (0)
#define P2_STEP(S, k) do { { const float _a = S.a * (F4_ROWSCALE ? (float)S.sv : bf2f((unsigned)S.sv)); const f32x2 a2 = (f32x2){_a, _a}; P2_AXPY1(S.v.x, 0); P2_AXPY1(S.v.y, 4); P2_AXPY1(S.v.z, 8); P2_AXPY1(S.v.w, 12); } \
        if (i0 + 16 < 64) P2_LOAD(S, i0 + (k) + 16); } while (0)
    P2_LOAD(B0, 0); P2_LOAD(B1, 1); P2_LOAD(B2, 2); P2_LOAD(B3, 3); P2_LOAD(B4, 4); P2_LOAD(B5, 5); P2_LOAD(B6, 6); P2_LOAD(B7, 7);
    P2_LOAD(B8, 8); P2_LOAD(B9, 9); P2_LOAD(B10, 10); P2_LOAD(B11, 11); P2_LOAD(B12, 12); P2_LOAD(B13, 13); P2_LOAD(B14, 14); P2_LOAD(B15, 15);
#pragma unroll
    for (int i0 = 0; i0 < 64; i0 += 16) {
        P2_STEP(B0, 0); P2_STEP(B1, 1); P2_STEP(B2, 2); P2_STEP(B3, 3); P2_STEP(B4, 4); P2_STEP(B5, 5); P2_STEP(B6, 6); P2_STEP(B7, 7);
        P2_STEP(B8, 8); P2_STEP(B9, 9); P2_STEP(B10, 10); P2_STEP(B11, 11); P2_STEP(B12, 12); P2_STEP(B13, 13); P2_STEP(B14, 14); P2_STEP(B15, 15);
    }
#undef P2_LOAD
#undef P2_AXPY1
#undef P2_STEP
    float s2[16];
#pragma unroll
    for (int q = 0; q < 8; ++q) {
        const f32x2 mine2 = gg ? acc[8 + q] : acc[q], send = gg ? acc[q] : acc[8 + q];
        s2[2 * q] = mine2.x + __shfl_xor(send.x, 32); s2[2 * q + 1] = mine2.y + __shfl_xor(send.y, 32);
    }
    const int e0 = 32 * j + 16 * gg;
    f32x4 xo[4]; float sq = 0.f;
    { float f0[8], f1[8]; unpack8(*(const u32x4*)(xbrow + e0), f0); unpack8(*(const u32x4*)(xbrow + e0 + 8), f1);
      xo[0] = (f32x4){f0[0], f0[1], f0[2], f0[3]}; xo[1] = (f32x4){f0[4], f0[5], f0[6], f0[7]}; xo[2] = (f32x4){f1[0], f1[1], f1[2], f1[3]}; xo[3] = (f32x4){f1[4], f1[5], f1[6], f1[7]}; }
#pragma unroll
    for (int q = 0; q < 4; ++q) { xo[q] += (f32x4){s2[4 * q], s2[4 * q + 1], s2[4 * q + 2], s2[4 * q + 3]};
        sq += (xo[q].x * xo[q].x + xo[q].y * xo[q].y) + (xo[q].z * xo[q].z + xo[q].w * xo[q].w); }
    if (l + 1 < DEPTH) {
        const float r1 = rsqrtf(wave_sum(sq) * (1.f / DM) + EPS);
        if (!DRY) {
            u32x4 o0, o1;
            o0.x = pk2(xo[0].x, xo[0].y); o0.y = pk2(xo[0].z, xo[0].w); o0.z = pk2(xo[1].x, xo[1].y); o0.w = pk2(xo[1].z, xo[1].w);
            o1.x = pk2(xo[2].x, xo[2].y); o1.y = pk2(xo[2].z, xo[2].w); o1.z = pk2(xo[3].x, xo[3].y); o1.w = pk2(xo[3].z, xo[3].w);
            u32x4* po = (u32x4*)(XN + (size_t)t * DM + e0);
            po[0] = o0; po[1] = o1;
            if (lane == 0) rstd_out[t] = r1;
        }
    } else {
#pragma unroll
        for (int q = 0; q < 4; ++q) if (!DRY || xo[q].x == 1.2345e-30f) *(f32x4*)(xrow + e0 + 4 * q) = xo[q];
    }
}

#define DPP_MOVI(v, CTRL) __builtin_amdgcn_update_dpp((v), (v), (CTRL), 0xf, 0xf, false)
__device__ __forceinline__ void gather_pass1_lean(int t, const bf16_t* XB, const float* g2w, const unsigned char* PU, const f32x2* SUQ, const float* SV, const float* scos, LAS unsigned* wl, int lane) {
    const int gg = lane >> 5, j = lane & 31;
    const int rho = (lane >> 1) & 15;
    const unsigned jofs = (unsigned)j * 16u, jofs3 = (unsigned)j * 12u; (void)jofs; (void)jofs3;
    const bf16_t* xbrow = XB + (size_t)t * DM;
    float sc4[4], sv4[4]; f32x2 sq4[4];
#pragma unroll
    for (int bb = 0; bb < 4; ++bb) { const int rb = 2 * (16 * bb + rho) + gg; const unsigned e = wl[rb]; sc4[bb] = scos[(size_t)t * 128 + rb]; sq4[bb] = SUQ[e]; sv4[bb] = SV[e]; }
    unsigned xh[4], xl[4];
    float xscale, rstd, c35;
    {
        float f[32]; float ss = 0.f;
#pragma unroll
        for (int q = 0; q < 4; ++q) { unpack8(*(const u32x4*)(xbrow + 32 * j + 8 * q), f + 8 * q);
#pragma unroll
            for (int e = 0; e < 8; ++e) ss += f[8 * q + e] * f[8 * q + e]; }
        ss = sum32(ss);
        rstd = rsqrtf(ss * (1.f / DM) + EPS);
        float am = 0.f;
#pragma unroll
        for (int q = 0; q < 8; ++q) { const f32x4 ga = *(const f32x4*)(g2w + 32 * j + 4 * q);
            f[4 * q] *= ga.x * rstd; f[4 * q + 1] *= ga.y * rstd; f[4 * q + 2] *= ga.z * rstd; f[4 * q + 3] *= ga.w * rstd;
            am = fmaxf(am, fmaxf(fmaxf(fabsf(f[4 * q]), fabsf(f[4 * q + 1])), fmaxf(fabsf(f[4 * q + 2]), fabsf(f[4 * q + 3])))); }
        am = fmaxf(am, DPP_MOV(am, 0xB1)); am = fmaxf(am, DPP_MOV(am, 0x4E)); am = fmaxf(am, DPP_MOV(am, 0x141)); am = fmaxf(am, DPP_MOV(am, 0x128));
        am = fmaxf(am, __builtin_bit_cast(float, __builtin_amdgcn_ds_swizzle(__builtin_bit_cast(int, am), 0x401F)));
        am = fmaxf(am, 1e-30f);
        xscale = am * (1.f / 127.f);
        const float iq = 127.f / am;
        int xsum = 0;
#pragma unroll
        for (int w = 0; w < 4; ++w) { unsigned h4 = 0u, l4 = 0u;
#pragma unroll
            for (int pp = 0; pp < 8; ++pp) { const int bq = (int)__builtin_rintf(f[8 * w + pp] * iq) + 128;
                xsum += bq - 128;
                h4 |= (unsigned)(((bq >> 4) - 8) & 0xf) << (4 * pp); l4 |= (unsigned)(((bq & 15) - 8) & 0xf) << (4 * pp); }
            xh[w] = h4; xl[w] = l4; }
        c35 = 3.5f * sum32((float)xsum);
    }
#if USE_I3U
    struct StU { u32x3 u; };
#else
    struct StU { u32x4 u; };
#endif
    StU A0, A1, A2, A3, A4, A5, A6, A7, A8, A9, A10, A11, A12, A13, A14, A15;
#if USE_I3U
#define P1_LOAD(S, i) do { const unsigned _e = wl[2 * (i) + gg]; S.u = *(const u32x3*)(PU + (size_t)(_e * 384u + jofs3)); } while (0)
#else
#define P1_LOAD(S, i) do { const unsigned _e = wl[2 * (i) + gg]; S.u = *(const u32x4*)(PU + (size_t)(_e * 512u + jofs)); } while (0)
#endif
#if USE_I3U
#define P1_COMPUTE(S, PD) do { int _ah = 0, _al = 0; \
        const unsigned _n0 = S.u.x & 0x77777777u, _n1 = S.u.y & 0x77777777u, _n2 = S.u.z & 0x77777777u; \
        unsigned _n3 = (S.u.x >> 3) & 0x11111111u; _n3 = ((S.u.y >> 2) & 0x22222222u) | _n3; _n3 = ((S.u.z >> 1) & 0x44444444u) | _n3; \
        _ah = __builtin_amdgcn_sdot8((int)_n0, (int)xh[0], _ah, false); _al = __builtin_amdgcn_sdot8((int)_n0, (int)xl[0], _al, false); \
        _ah = __builtin_amdgcn_sdot8((int)_n1, (int)xh[1], _ah, false); _al = __builtin_amdgcn_sdot8((int)_n1, (int)xl[1], _al, false); \
        _ah = __builtin_amdgcn_sdot8((int)_n2, (int)xh[2], _ah, false); _al = __builtin_amdgcn_sdot8((int)_n2, (int)xl[2], _al, false); \
        _ah = __builtin_amdgcn_sdot8((int)_n3, (int)xh[3], _ah, false); _al = __builtin_amdgcn_sdot8((int)_n3, (int)xl[3], _al, false); \
        PD = 16 * _ah + _al; } while (0)
#else
#define P1_COMPUTE(S, PD) do { int _ah = 0, _al = 0; \
        _ah = __builtin_amdgcn_sdot8((int)S.u.x, (int)xh[0], _ah, false); _al = __builtin_amdgcn_sdot8((int)S.u.x, (int)xl[0], _al, false); \
        _ah = __builtin_amdgcn_sdot8((int)S.u.y, (int)xh[1], _ah, false); _al = __builtin_amdgcn_sdot8((int)S.u.y, (int)xl[1], _al, false); \
        _ah = __builtin_amdgcn_sdot8((int)S.u.z, (int)xh[2], _ah, false); _al = __builtin_amdgcn_sdot8((int)S.u.z, (int)xl[2], _al, false); \
        _ah = __builtin_amdgcn_sdot8((int)S.u.w, (int)xh[3], _ah, false); _al = __builtin_amdgcn_sdot8((int)S.u.w, (int)xl[3], _al, false); \
        PD = 16 * _ah + _al; } while (0)
#endif
#define P1_STEP(S, k) do { P1_COMPUTE(S, P[(k)]); if (i0 + 16 < 64) P1_LOAD(S, i0 + (k) + 16); } while (0)
    P1_LOAD(A0, 0); P1_LOAD(A1, 1); P1_LOAD(A2, 2); P1_LOAD(A3, 3); P1_LOAD(A4, 4); P1_LOAD(A5, 5); P1_LOAD(A6, 6); P1_LOAD(A7, 7);
    P1_LOAD(A8, 8); P1_LOAD(A9, 9); P1_LOAD(A10, 10); P1_LOAD(A11, 11); P1_LOAD(A12, 12); P1_LOAD(A13, 13); P1_LOAD(A14, 14); P1_LOAD(A15, 15);
    const bool b4 = (lane & 16) != 0, b3 = (lane & 8) != 0, b2 = (lane & 4) != 0, b1 = (lane & 2) != 0;
#pragma unroll
    for (int b = 0; b < 4; ++b) {
        const int i0 = 16 * b;
        int P[16];
        P1_STEP(A0, 0); P1_STEP(A1, 1); P1_STEP(A2, 2); P1_STEP(A3, 3); P1_STEP(A4, 4); P1_STEP(A5, 5); P1_STEP(A6, 6); P1_STEP(A7, 7);
        P1_STEP(A8, 8); P1_STEP(A9, 9); P1_STEP(A10, 10); P1_STEP(A11, 11); P1_STEP(A12, 12); P1_STEP(A13, 13); P1_STEP(A14, 14); P1_STEP(A15, 15);
        int Q8[8], R4[4], S2[2], hi;
#pragma unroll
        for (int k = 0; k < 8; ++k) { const int mine = b4 ? P[8 + k] : P[k], send = b4 ? P[k] : P[8 + k]; Q8[k] = mine + __builtin_amdgcn_ds_swizzle(send, 0x401F); }
#pragma unroll
        for (int k = 0; k < 4; ++k) { const int mine = b3 ? Q8[4 + k] : Q8[k], send = b3 ? Q8[k] : Q8[4 + k]; R4[k] = mine + DPP_MOVI(send, 0x128); }
#pragma unroll
        for (int k = 0; k < 2; ++k) { const int mine = b2 ? R4[2 + k] : R4[k], send = b2 ? R4[k] : R4[2 + k]; S2[k] = mine + DPP_MOVI(send, 0x141); }
        { const int mine = b1 ? S2[1] : S2[0], send = b1 ? S2[0] : S2[1]; hi = mine + DPP_MOVI(send, 0x4E); }
        hi += DPP_MOVI(hi, 0xB1);
        const float h = ((float)hi - (USE_I3U ? c35 : 0.f)) * sq4[b].x + 32.f * sq4[b].y;
        const int r = 2 * (i0 + rho) + gg;
        const float sc = sc4[b];
        const float m0 = __shfl(sc, lane & 16);
        const float ex = __expf((sc - m0) * rstd);
        float z = ex;
        z += DPP_MOV(z, 0x4E); z += DPP_MOV(z, 0x141) ; z += DPP_MOV(z, 0x128);
        z += __shfl_xor(z, 32);
        const float a = (ex / z) * gelu_fast(h * xscale) * sv4[b];
        if ((lane & 1) == 0) wl[128 + r] = __float_as_uint(a);
    }
#undef P1_LOAD
#undef P1_COMPUTE
#undef P1_STEP
}

__device__ __forceinline__ void gather_pass2_lean(int l, int t, float* out, const bf16_t* XB, float* rstd_out, const unsigned char* PV, bf16_t* XN, LAS unsigned* wl, int lane) {
    const int gg = lane >> 5, j = lane & 31;
    const unsigned jofs = (unsigned)j * 16u;
    float* xrow = out + (size_t)t * DM; const bf16_t* xbrow = XB + (size_t)t * DM;
#if P2_F16
    typedef _Float16 h16x2 __attribute__((ext_vector_type(2)));
    h16x2 acch[16];
#pragma unroll
    for (int q = 0; q < 16; ++q) acch[q] = (h16x2){(_Float16)0.f, (_Float16)0.f};
#else
    f32x2 acc[16];
#pragma unroll
    for (int q = 0; q < 16; ++q) acc[q] = (f32x2){0.f, 0.f};
#endif
    struct StV { u32x4 v; float a; };
    StV B0, B1, B2, B3, B4, B5, B6, B7, B8, B9, B10, B11, B12, B13, B14, B15;
#define P2_LOAD(S, i) do { const unsigned _e = wl[2 * (i) + gg]; S.a = __uint_as_float(wl[128 + 2 * (i) + gg]); S.v = *(const u32x4*)(PV + (size_t)(_e * 512u + jofs)); } while (0)
#if P2_F16
#define P2_AXPY1(W, Q) do { acch[(Q)] = __builtin_amdgcn_cvt_scalef32_pk_f16_fp4((W), 1.0f, 0) * a2 + acch[(Q)]; acch[(Q) + 1] = __builtin_amdgcn_cvt_scalef32_pk_f16_fp4((W), 1.0f, 1) * a2 + acch[(Q) + 1]; \
        acch[(Q) + 2] = __builtin_amdgcn_cvt_scalef32_pk_f16_fp4((W), 1.0f, 2) * a2 + acch[(Q) + 2]; acch[(Q) + 3] = __builtin_amdgcn_cvt_scalef32_pk_f16_fp4((W), 1.0f, 3) * a2 + acch[(Q) + 3]; } while (0)
#define P2_A2(S) const _Float16 _ah = (_Float16)S.a; const h16x2 a2 = (h16x2){_ah, _ah}
#else
#define P2_AXPY1(W, Q) do { acc[(Q)] = __builtin_amdgcn_cvt_scalef32_pk_f32_fp4((W), 1.0f, 0) * a2 + acc[(Q)]; acc[(Q) + 1] = __builtin_amdgcn_cvt_scalef32_pk_f32_fp4((W), 1.0f, 1) * a2 + acc[(Q) + 1]; \
        acc[(Q) + 2] = __builtin_amdgcn_cvt_scalef32_pk_f32_fp4((W), 1.0f, 2) * a2 + acc[(Q) + 2]; acc[(Q) + 3] = __builtin_amdgcn_cvt_scalef32_pk_f32_fp4((W), 1.0f, 3) * a2 + acc[(Q) + 3]; } while (0)
#define P2_A2(S) const f32x2 a2 = (f32x2){S.a, S.a}
#endif
#define P2_STEP(S, k) do { { P2_A2(S); P2_AXPY1(S.v.x, 0); P2_AXPY1(S.v.y, 4); P2_AXPY1(S.v.z, 8); P2_AXPY1(S.v.w, 12); } \
        if (i0 + 16 < 64) P2_LOAD(S, i0 + (k) + 16); } while (0)
    P2_LOAD(B0, 0); P2_LOAD(B1, 1); P2_LOAD(B2, 2); P2_LOAD(B3, 3); P2_LOAD(B4, 4); P2_LOAD(B5, 5); P2_LOAD(B6, 6); P2_LOAD(B7, 7);
    P2_LOAD(B8, 8); P2_LOAD(B9, 9); P2_LOAD(B10, 10); P2_LOAD(B11, 11); P2_LOAD(B12, 12); P2_LOAD(B13, 13); P2_LOAD(B14, 14); P2_LOAD(B15, 15);
#pragma unroll
    for (int i0 = 0; i0 < 64; i0 += 16) {
        P2_STEP(B0, 0); P2_STEP(B1, 1); P2_STEP(B2, 2); P2_STEP(B3, 3); P2_STEP(B4, 4); P2_STEP(B5, 5); P2_STEP(B6, 6); P2_STEP(B7, 7);
        P2_STEP(B8, 8); P2_STEP(B9, 9); P2_STEP(B10, 10); P2_STEP(B11, 11); P2_STEP(B12, 12); P2_STEP(B13, 13); P2_STEP(B14, 14); P2_STEP(B15, 15);
    }
#undef P2_LOAD
#undef P2_AXPY1
#undef P2_A2
#undef P2_STEP
#if P2_F16
    f32x2 acc[16];
#pragma unroll
    for (int q = 0; q < 16; ++q) acc[q] = (f32x2){(float)acch[q].x, (float)acch[q].y};
#endif
    float s2[16];
#pragma unroll
    for (int q = 0; q < 8; ++q) {
        const f32x2 mine2 = gg ? acc[8 + q] : acc[q], send = gg ? acc[q] : acc[8 + q];
        s2[2 * q] = mine2.x + __shfl_xor(send.x, 32); s2[2 * q + 1] = mine2.y + __shfl_xor(send.y, 32);
    }
    const int e0 = 32 * j + 16 * gg;
    f32x4 xo[4]; float sq = 0.f;
    { float f0[8], f1[8]; unpack8(__builtin_nontemporal_load((const u32x4*)(xbrow + e0)), f0); unpack8(__builtin_nontemporal_load((const u32x4*)(xbrow + e0 + 8)), f1);
      xo[0] = (f32x4){f0[0], f0[1], f0[2], f0[3]}; xo[1] = (f32x4){f0[4], f0[5], f0[6], f0[7]}; xo[2] = (f32x4){f1[0], f1[1], f1[2], f1[3]}; xo[3] = (f32x4){f1[4], f1[5], f1[6], f1[7]}; }
#pragma unroll
    for (int q = 0; q < 4; ++q) { xo[q] += (f32x4){s2[4 * q], s2[4 * q + 1], s2[4 * q + 2], s2[4 * q + 3]};
        sq += (xo[q].x * xo[q].x + xo[q].y * xo[q].y) + (xo[q].z * xo[q].z + xo[q].w * xo[q].w); }
    if (l + 1 < DEPTH) {
        const float r1 = rsqrtf(wave_sum(sq) * (1.f / DM) + EPS);
        u32x4 o0, o1;
        o0.x = pk2(xo[0].x, xo[0].y); o0.y = pk2(xo[0].z, xo[0].w); o0.z = pk2(xo[1].x, xo[1].y); o0.w = pk2(xo[1].z, xo[1].w);
        o1.x = pk2(xo[2].x, xo[2].y); o1.y = pk2(xo[2].z, xo[2].w); o1.z = pk2(xo[3].x, xo[3].y); o1.w = pk2(xo[3].z, xo[3].w);
        u32x4* po = (u32x4*)(XN + (size_t)t * DM + e0);
        po[0] = o0; po[1] = o1;
        if (lane == 0) rstd_out[t] = r1;
    } else {
#pragma unroll
        for (int q = 0; q < 4; ++q) *(f32x4*)(xrow + e0 + 4 * q) = xo[q];
    }
}

#define BSORT_LOCAL(K) do { const bool _asc = (lane & ((K) >> 1)) == 0; const unsigned _mn = k0 < k1 ? k0 : k1, _mx = k0 < k1 ? k1 : k0; k0 = _asc ? _mn : _mx; k1 = _asc ? _mx : _mn; } while (0)
#define BSORT_CROSS(K, J) do { const unsigned _o0 = (unsigned)__shfl_xor((int)k0, (J) >> 1), _o1 = (unsigned)__shfl_xor((int)k1, (J) >> 1); \
        const bool _keepmin = ((lane & ((J) >> 1)) == 0) == ((lane & ((K) >> 1)) == 0); \
        k0 = _keepmin ? (k0 < _o0 ? k0 : _o0) : (k0 < _o0 ? _o0 : k0); k1 = _keepmin ? (k1 < _o1 ? k1 : _o1) : (k1 < _o1 ? _o1 : k1); } while (0)
__device__ __forceinline__ void gather_prep(int t, const bf16_t* XB, const int* idxs, const float* scos, LAS unsigned* wl, LAS float* rs_slot, int lane) {
    const bf16_t* xbrow = XB + (size_t)t * DM;
    float ss = 0.f;
    { float f[8]; unpack8(*(const u32x4*)(xbrow + 16 * lane), f);
#pragma unroll
      for (int e = 0; e < 8; ++e) ss += f[e] * f[e];
      unpack8(*(const u32x4*)(xbrow + 16 * lane + 8), f);
#pragma unroll
      for (int e = 0; e < 8; ++e) ss += f[e] * f[e]; }
    const float rstd = rsqrtf(wave_sum(ss) * (1.f / DM) + EPS);
    if (lane == 0) *rs_slot = rstd;
    const u32x2 iv = *(const u32x2*)(idxs + (size_t)t * 128 + 2 * lane);
    const f32x2 sv = *(const f32x2*)(scos + (size_t)t * 128 + 2 * lane);
    const float m0 = __shfl(sv.x, lane & ~7);
    const float e0 = __expf((sv.x - m0) * rstd), e1 = __expf((sv.y - m0) * rstd);
    float z = e0 + e1; DPP_ADD8(z);
    const float iz = 1.f / z;
    wl[128 + 2 * lane] = __float_as_uint(e0 * iz); wl[128 + 2 * lane + 1] = __float_as_uint(e1 * iz);
    unsigned k0 = (iv.x << 7) | (unsigned)(2 * lane), k1 = (iv.y << 7) | (unsigned)(2 * lane + 1);
    BSORT_LOCAL(2);
    BSORT_CROSS(4, 2); BSORT_LOCAL(4);
    BSORT_CROSS(8, 4); BSORT_CROSS(8, 2); BSORT_LOCAL(8);
    BSORT_CROSS(16, 8); BSORT_CROSS(16, 4); BSORT_CROSS(16, 2); BSORT_LOCAL(16);
    BSORT_CROSS(32, 16); BSORT_CROSS(32, 8); BSORT_CROSS(32, 4); BSORT_CROSS(32, 2); BSORT_LOCAL(32);
    BSORT_CROSS(64, 32); BSORT_CROSS(64, 16); BSORT_CROSS(64, 8); BSORT_CROSS(64, 4); BSORT_CROSS(64, 2); BSORT_LOCAL(64);
    BSORT_CROSS(128, 64); BSORT_CROSS(128, 32); BSORT_CROSS(128, 16); BSORT_CROSS(128, 8); BSORT_CROSS(128, 4); BSORT_CROSS(128, 2); BSORT_LOCAL(128);
    const unsigned gs0 = wl[128 + (k0 & 127u)], gs1 = wl[128 + (k1 & 127u)];
    asm volatile("s_waitcnt lgkmcnt(0)" ::: "memory");
    wl[2 * lane] = k0 >> 7; wl[2 * lane + 1] = k1 >> 7;
    wl[128 + 2 * lane] = gs0; wl[128 + 2 * lane + 1] = gs1;
}

__device__ __forceinline__ void gather_pass1_sorted(int tbase, const bf16_t* XB, const float* g2w, const unsigned char* PU, LAS unsigned* wl0, LAS float* rs, int lane, LAS unsigned char* lds_all) {
    const int gg = lane >> 5, j = lane & 31;
    f32x4 gv[8];
#pragma unroll
    for (int q = 0; q < 8; ++q) gv[q] = *(const f32x4*)(g2w + 32 * j + 4 * q);
    struct StU { u32x4 u; unsigned short su; };
    StU A0, A1, A2, A3, A4, A5, A6, A7;
#define BATCH_IDX(n) (wl0 + ((n) & 15) * 256 + 32 * ((n) >> 4))
#define P1_LOAD(S, lp, k) do { const int _e = (int)(lp)[2 * (k) + gg]; const unsigned char* _ur = PU + (size_t)_e * F4_ROW; S.u = *(const u32x4*)(_ur + j * 16); S.su = *(const unsigned short*)(_ur + 512 + 2 * j); } while (0)
#define P1_DOT1(W, Q) do { d2 = __builtin_amdgcn_cvt_scalef32_pk_f32_fp4((W), 1.0f, 0) * xv[(Q)] + d2; e2 = __builtin_amdgcn_cvt_scalef32_pk_f32_fp4((W), 1.0f, 1) * xv[(Q) + 1] + e2; \
        d2 = __builtin_amdgcn_cvt_scalef32_pk_f32_fp4((W), 1.0f, 2) * xv[(Q) + 2] + d2; e2 = __builtin_amdgcn_cvt_scalef32_pk_f32_fp4((W), 1.0f, 3) * xv[(Q) + 3] + e2; } while (0)
#define P1_COMPUTE(S, PD) do { f32x2 d2 = (f32x2){0.f, 0.f}, e2 = (f32x2){0.f, 0.f}; P1_DOT1(S.u.x, 0); P1_DOT1(S.u.y, 4); P1_DOT1(S.u.z, 8); P1_DOT1(S.u.w, 12); \
        PD = ((d2.x + d2.y) + (e2.x + e2.y)) * bf2f(S.su); } while (0)
#define P1_STEP_A(S, k) do { P1_COMPUTE(S, P[(k)]); P1_LOAD(S, cur, (k) + 8); } while (0)
#define P1_STEP_B(S, k) do { P1_COMPUTE(S, P[(k)]); if (n + 1 < 64) P1_LOAD(S, nxt, (k) - 8); } while (0)
    { LAS unsigned* cur = BATCH_IDX(0);
      P1_LOAD(A0, cur, 0); P1_LOAD(A1, cur, 1); P1_LOAD(A2, cur, 2); P1_LOAD(A3, cur, 3); P1_LOAD(A4, cur, 4); P1_LOAD(A5, cur, 5); P1_LOAD(A6, cur, 6); P1_LOAD(A7, cur, 7); }
    u32x4 xraw[4];
    { const bf16_t* xb = XB + (size_t)tbase * DM + 32 * j;
#pragma unroll
      for (int q = 0; q < 4; ++q) xraw[q] = *(const u32x4*)(xb + 8 * q); }
    const bool b4 = (lane & 16) != 0, b3 = (lane & 8) != 0, b2 = (lane & 4) != 0, b1 = (lane & 2) != 0;
    const int rho = (lane >> 1) & 15;
#pragma unroll 1
    for (int n = 0; n < 64; ++n) {
#if QUARTILE_BARRIER
        if (n > 0 && (n & 15) == 0) {
            FRESH_PARAMS; XcdBarrier xb_; xb_.bar = (unsigned*)(p.ws + WS_CTL) + 1024; xb_.x = xb_xcc_id(); xb_.st = (volatile LAS unsigned*)(lds_all + LDS_BYTES - 64); xcd_barrier(xb_);
        }
#endif
        LAS unsigned* cur = BATCH_IDX(n); LAS unsigned* nxt = BATCH_IDX(n + 1);
        const float rstd = rs[n & 15];
        f32x2 xv[16];
#pragma unroll
        for (int q = 0; q < 4; ++q) { float f[8]; unpack8(xraw[q], f); const f32x4 ga = gv[2 * q] * rstd, gb = gv[2 * q + 1] * rstd;
            xv[4 * q] = (f32x2){f[0] * ga.x, f[1] * ga.y}; xv[4 * q + 1] = (f32x2){f[2] * ga.z, f[3] * ga.w}; xv[4 * q + 2] = (f32x2){f[4] * gb.x, f[5] * gb.y}; xv[4 * q + 3] = (f32x2){f[6] * gb.z, f[7] * gb.w}; }
        { const bf16_t* xb = XB + (size_t)(tbase + ((n + 1) & 15)) * DM + 32 * j;
#pragma unroll
          for (int q = 0; q < 4; ++q) xraw[q] = *(const u32x4*)(xb + 8 * q); }
        float P[16];
        P1_STEP_A(A0, 0); P1_STEP_A(A1, 1); P1_STEP_A(A2, 2); P1_STEP_A(A3, 3); P1_STEP_A(A4, 4); P1_STEP_A(A5, 5); P1_STEP_A(A6, 6); P1_STEP_A(A7, 7);
        P1_STEP_B(A0, 8); P1_STEP_B(A1, 9); P1_STEP_B(A2, 10); P1_STEP_B(A3, 11); P1_STEP_B(A4, 12); P1_STEP_B(A5, 13); P1_STEP_B(A6, 14); P1_STEP_B(A7, 15);
        float Q8[8], R4[4], S2[2], h;
#pragma unroll
        for (int k = 0; k < 8; ++k) { const float mine = b4 ? P[8 + k] : P[k], send = b4 ? P[k] : P[8 + k]; Q8[k] = mine + __builtin_bit_cast(float, __builtin_amdgcn_ds_swizzle(__builtin_bit_cast(int, send), 0x401F)); }
#pragma unroll
        for (int k = 0; k < 4; ++k) { const float mine = b3 ? Q8[4 + k] : Q8[k], send = b3 ? Q8[k] : Q8[4 + k]; R4[k] = mine + DPP_MOV(send, 0x128); }
#pragma unroll
        for (int k = 0; k < 2; ++k) { const float mine = b2 ? R4[2 + k] : R4[k], send = b2 ? R4[k] : R4[2 + k]; S2[k] = mine + DPP_MOV(send, 0x141); }
        { const float mine = b1 ? S2[1] : S2[0], send = b1 ? S2[0] : S2[1]; h = mine + DPP_MOV(send, 0x4E); }
        h += DPP_MOV(h, 0xB1);
        LAS unsigned* ap = wl0 + (n & 15) * 256 + 128 + 32 * (n >> 4) + 2 * rho + gg;
        const float a = __uint_as_float(*ap) * gelu_fast(h);
        if ((lane & 1) == 0) *ap = __float_as_uint(a);
    }
#undef BATCH_IDX
#undef P1_LOAD
#undef P1_DOT1
#undef P1_COMPUTE
#undef P1_STEP_A
#undef P1_STEP_B
}

__device__ __forceinline__ void phase_peer(int wv0, int l, LAS unsigned char* lds) {
    FRESH_PARAMS; FRESH_IDS;
    const bf16_t* qp = (const bf16_t*)(p.ws + WS_Z);
    const bf16_t* SK = (const bf16_t*)(p.ws + WS_SK) + (size_t)l * 2 * 128 * 128;
    int* idxo = (int*)(p.ws + WS_IDX); float* sco = (float*)(p.ws + WS_GATE);
#if USE_FP4
    const unsigned char* PU = p.ws + WS_P8 + (size_t)(2 * l) * NEXP * F4_ROW; const unsigned char* PV = PU + (size_t)NEXP * F4_ROW;
    const float* SU4 = (const float*)(p.ws + WS_SCL) + (size_t)(2 * l) * NEXP; const float* SV4 = SU4 + NEXP;
#else
    const unsigned char* PU = p.ws + WS_P8 + (size_t)(2 * l) * NEXP * 1024; const unsigned char* PV = PU + (size_t)NEXP * 1024;
    const float* SU = (const float*)(p.ws + WS_SCL) + (size_t)(2 * l) * NEXP; const float* SV = SU + NEXP;
#endif
    const float* g2 = p.norm2_g + l * DM;
    bf16_t* XN = (bf16_t*)(p.ws + WS_XN);
    const int r = lane & 31, hh = lane >> 5;
    LAS float* mine = (LAS float*)(lds + RT_SK_BYTES + wave * RT_WAVE_BYTES + lane * RT_LANE_STRIDE);
#pragma unroll 1
    for (int tb = bid; tb < T / 128; tb += nblk) {
        __syncthreads();
        int tid2 = tid; asm volatile("" : "+v"(tid2));
        for (int i = tid2; i < 4096; i += NTHREADS) {
            const int row = i >> 4, ch = i & 15;
            *(LAS u32x4*)(lds + row * 256 + ((ch ^ (row & 15)) << 4)) = *(const u32x4*)(SK + (size_t)i * 8);
        }
        __syncthreads();
#pragma unroll 1
        for (int uu = wave; uu < 32; uu += NWAVES) route_unit(lds, mine, qp, idxo, sco, tb * 128 + (uu >> 3) * 32, uu & 7, r, hh);
#if PROBE_MASK & 16
#pragma unroll 1
        for (int uu = wave; uu < 32; uu += NWAVES) route_unit(lds, mine, qp, idxo, sco, tb * 128 + (uu >> 3) * 32, uu & 7, r, hh);
#endif
        asm volatile("s_waitcnt vmcnt(0)" ::: "memory");
        __syncthreads();
#if USE_FP4 == 4
        {
            int ln = lane, wv = wave; asm volatile("" : "+v"(ln)); asm volatile("" : "+s"(wv));
            LAS unsigned* wl0 = (LAS unsigned*)(lds + wv * 16384);
            LAS float* rs = (LAS float*)(lds + 131072 + wv * 256);
            const int tok0 = tb * 128 + wv * 16;
#pragma unroll 1
            for (int i = 0; i < 16; ++i) gather_prep(tok0 + i, (const bf16_t*)(p.ws + WS_XN2), idxo, sco, wl0 + i * 256, rs + i, ln);
            gather_pass1_sorted(tok0, (const bf16_t*)(p.ws + WS_XN2), g2, PU, wl0, rs, ln, lds);
#pragma unroll 1
            for (int i = 0; i < 16; ++i) gather_pass2<false>(l, tok0 + i, p.out, (const bf16_t*)(p.ws + WS_XN2), (float*)(p.ws + WS_RSTD), PV, SV4, XN, wl0 + i * 256, ln);
        }
#elif USE_FP4 == 3
        {
            int ln = lane, wv = wave; asm volatile("" : "+v"(ln)); asm volatile("" : "+s"(wv));
            LAS unsigned* wl0 = (LAS unsigned*)(lds + wv * 16384);
            const int tok0 = tb * 128 + wv * 16;
#if P1_PRESTAGE
            {
                const u32x4* ip = (const u32x4*)(idxo + (size_t)tok0 * 128);
#pragma unroll
                for (int k = 0; k < 8; ++k) { const int w4 = k * 64 + ln; const u32x4 v4 = __builtin_nontemporal_load(ip + w4); *(LAS u32x4*)(wl0 + (w4 >> 5) * 256 + (w4 & 31) * 4) = v4; }
            }
#endif
#pragma unroll 1
            for (int i = 0; i < 16; ++i) gather_pass1_lean(tok0 + i, (const bf16_t*)(p.ws + WS_XN2), g2, PU, (const f32x2*)(p.ws + WS_SUQ + (size_t)l * NEXP * 8), SV4, sco, wl0 + i * 256, ln);
#pragma unroll 1
            for (int i = 0; i < 16; ++i) gather_pass2_lean(l, tok0 + i, p.out, (const bf16_t*)(p.ws + WS_XN2), (float*)(p.ws + WS_RSTD), PV, XN, wl0 + i * 256, ln);
        }
#elif USE_FP4 == 2
        { LAS unsigned* wl = (LAS unsigned*)(lds + RT_SK_BYTES + wave * RT_WAVE_BYTES);
#if PROBE_MASK & 8
#pragma unroll 1
          for (int i = 0; i < 16; ++i) gather_token4b<true>(l, tb * 128 + wave * 16 + i, p.out, (const bf16_t*)(p.ws + WS_XN2), (float*)(p.ws + WS_RSTD), g2, PU, PV, idxo, sco, XN, wl, lane);
#endif
#pragma unroll 1
          for (int i = 0; i < 16; ++i) gather_token4b<false>(l, tb * 128 + wave * 16 + i, p.out, (const bf16_t*)(p.ws + WS_XN2), (float*)(p.ws + WS_RSTD), g2, PU, PV, idxo, sco, XN, wl, lane); }
#elif USE_FP4
#if PROBE_MASK & 8
#pragma unroll 1
        for (int i = 0; i < 16; ++i) gather_token4<true>(l, tb * 128 + wave * 16 + i, p.out, g2, PU, PV, idxo, sco, XN, lane);
#endif
#pragma unroll 1
        for (int i = 0; i < 16; ++i) gather_token4<false>(l, tb * 128 + wave * 16 + i, p.out, g2, PU, PV, idxo, sco, XN, lane);
#else
#if PROBE_MASK & 8
#pragma unroll 1
        for (int i = 0; i < 16; ++i) gather_token8<true>(l, tb * 128 + wave * 16 + i, p.out, g2, PU, PV, SU, SV, idxo, sco, XN, lane);
#endif
#pragma unroll 1
        for (int i = 0; i < 16; ++i) gather_token8<false>(l, tb * 128 + wave * 16 + i, p.out, g2, PU, PV, SU, SV, idxo, sco, XN, lane);
#endif
    }
}

__global__ void __launch_bounds__(NTHREADS, 2) fwd_kernel(Params p_unused) {
    extern __shared__ __attribute__((aligned(16))) unsigned char lds_raw[];
    LAS unsigned char* lds = (LAS unsigned char*)lds_raw;
    cg::grid_group grid = cg::this_grid();
    const int wv0 = __builtin_amdgcn_readfirstlane(threadIdx.x >> 6);
    volatile LAS unsigned* bar_st = (volatile LAS unsigned*)(lds + LDS_BYTES - 64);
    if (threadIdx.x < 16) bar_st[threadIdx.x] = 0u;
    __syncthreads();
    { FRESH_PARAMS; (void)xcd_barrier_post((unsigned*)(p.ws + WS_CTL) + 1024, bar_st); }
#if USE_XBAR
#define GRID_SYNC() do { FRESH_PARAMS; XcdBarrier xb_; xb_.bar = (unsigned*)(p.ws + WS_CTL) + 1024; xb_.x = xb_xcc_id(); xb_.st = (volatile LAS unsigned*)(lds + LDS_BYTES - 64); xcd_barrier(xb_); } while (0)
#else
#define GRID_SYNC() grid.sync()
#endif
    phase_prep(wv0, lds);
#if PROBE_MASK & 32
    __syncthreads(); phase_prep(wv0, lds);
#endif
#if USE_FP4
    phase_table_fp4(wv0);
#if PROBE_MASK & 64
    phase_table_fp4(wv0);
#endif
#elif USE_GATHER == 2
    phase_table_fp8(wv0);
#endif
#if USE_XBAR
    { FRESH_PARAMS; if (p.ws == nullptr) grid.sync(); }
    GRID_SYNC();
#else
    grid.sync();
#endif
#pragma unroll 1
    for (int l = 0; l < DEPTH; ++l) {
        { FRESH_PARAMS; FRESH_IDS; const bf16_t* XN = (const bf16_t*)(p.ws + WS_XN); bf16_t* Z = (bf16_t*)(p.ws + WS_Z); const bf16_t* WinT = (const bf16_t*)(p.ws + WS_WIN) + (size_t)l * NZ * DM;
#if USE_PG8 & 1
          pg8::Gemm g{XN, WinT, T, NZ, DM}; pg8::StaticOrderHT S; S.init(T, NZ, nblk, bid); pg8::EpiBf16RS E{Z, NZ, (const float*)(p.ws + WS_RSTD)};
          pg8::gemm_phase<pg8::EpiBf16RS, pg8::StaticOrderHT, true, true>(lds, g, S, E, tid);
#if PROBE_MASK & 128
          pg8::gemm_phase<pg8::EpiBf16RS, pg8::StaticOrder, true, true>(lds, g, S, E, tid);
#endif
#else
          EpiStoreBf16 E{Z, NZ}; gemm_simple(XN, WinT, T, NZ, DM, E, gw, ngw, lane);
#endif
        }
        GRID_SYNC();
#if !USE_ATTN
        phase_qknorm(wv0, l);
        GRID_SYNC();
#endif
#if USE_POOLFOLD
        phase_poolconv4(wv0, l);
#if PROBE_MASK & 4
        phase_poolconv4(wv0, l);
#endif
#else
        phase_poolconv(wv0, l, lds);
#if PROBE_MASK & 4
        __syncthreads(); phase_poolconv(wv0, l, lds);
#endif
#endif
#if USE_ATTN
        phase_attn(wv0, l, lds);
#if PROBE_MASK & 1
        __syncthreads(); phase_attn(wv0, l, lds);
#endif
#else
        phase_swa_naive(wv0, l);
        phase_diff_naive(wv0, l);
#endif
        GRID_SYNC();
        { FRESH_PARAMS; FRESH_IDS; const bf16_t* Y = (const bf16_t*)(p.ws + WS_Y); const bf16_t* WoutT = (const bf16_t*)(p.ws + WS_WOUT) + (size_t)l * DM * DM; const float* base = (l == 0) ? p.x : p.out;
#if USE_PG8 & 2
          pg8::Gemm g{Y, WoutT, T, DM, DM}; pg8::StaticOrder S; S.init(T, DM, nblk, bid);
          pg8::EpiResB E{nullptr, (const bf16_t*)(p.ws + WS_XN), (bf16_t*)(p.ws + WS_XN2), DM}; (void)base;
          pg8::gemm_phase<pg8::EpiResB, pg8::StaticOrder, true, true>(lds, g, S, E, tid);
#else
          EpiResidual E{base, p.out, DM}; gemm_simple(Y, WoutT, T, DM, DM, E, gw, ngw, lane);
#endif
        }
        GRID_SYNC();
#if !USE_PEER
        { FRESH_PARAMS; FRESH_IDS; bf16_t* XN2 = (bf16_t*)(p.ws + WS_XN2);
          for (int m = gw; m < T; m += ngw) rms_row_to_bf16(p.out + (size_t)m * DM, XN2 + (size_t)m * DM, lane); }
#if USE_GATHER == 1
        phase_table_convert(wv0, l);
#endif
        GRID_SYNC();
#endif
        { FRESH_PARAMS; FRESH_IDS; const bf16_t* XN2 = (const bf16_t*)(p.ws + WS_XN2); bf16_t* Z = (bf16_t*)(p.ws + WS_Z); const bf16_t* WqT = (const bf16_t*)(p.ws + WS_WQ) + (size_t)l * NQ * DM;
#if USE_PG8 & 4
          pg8::Gemm g{XN2, WqT, T, NQ, DM}; pg8::StaticOrder S; S.init(T, NQ, nblk, bid); pg8::EpiBf16<0> E{Z, NQ, nullptr, 0, 0, 1.f};
          pg8::gemm_phase<pg8::EpiBf16<0>, pg8::StaticOrder, true, true>(lds, g, S, E, tid);
#if PROBE_MASK & 128
          pg8::gemm_phase<pg8::EpiBf16<0>, pg8::StaticOrder, true, true>(lds, g, S, E, tid);
#endif
#else
          EpiStoreBf16 E{Z, NQ}; gemm_simple(XN2, WqT, T, NQ, DM, E, gw, ngw, lane);
#endif
        }
        GRID_SYNC();
#if USE_PEER
        phase_peer(wv0, l, lds);
#else
#if USE_ROUTE
        phase_route(wv0, l, lds);
#if PROBE_MASK & 2
        __syncthreads(); phase_route(wv0, l, lds);
#endif
#else
        phase_route_a_naive(wv0, l);
        GRID_SYNC();
        phase_route_b_naive(wv0, l);
#endif
        GRID_SYNC();
#if USE_GATHER == 2
        phase_gather8(wv0, l);
#elif USE_GATHER == 1
        phase_gather(wv0, l);
#else
        phase_gather_naive(wv0, l);
#endif
#endif
        GRID_SYNC();
    }
}

extern "C" void kernel_launch(void* const* d_in, const int* in_sizes, int n_in, void* d_out, int out_size, void* d_ws, size_t ws_size, hipStream_t stream) {
    static int grid_blocks = 0;
    if (grid_blocks == 0) {
        if (n_in != 21 || out_size != T * DM || ws_size < WS_END) { fprintf(stderr, "kernel_launch: unexpected shapes (n_in %d out %d ws %zu)\n", n_in, out_size, ws_size); grid_blocks = -1; return; }
        int dev = 0, cus = 0, per_cu = 0;
        hipGetDevice(&dev);
        hipDeviceGetAttribute(&cus, hipDeviceAttributeMultiprocessorCount, dev);
        if (hipFuncSetAttribute((const void*)fwd_kernel, hipFuncAttributeMaxDynamicSharedMemorySize, LDS_BYTES) != hipSuccess) { fprintf(stderr, "kernel_launch: hipFuncSetAttribute failed\n"); }
        if (hipOccupancyMaxActiveBlocksPerMultiprocessor(&per_cu, (const void*)fwd_kernel, NTHREADS, LDS_BYTES) != hipSuccess || per_cu < 1) { fprintf(stderr, "kernel_launch: occupancy query says %d\n", per_cu); per_cu = 1; }
        (void)hipGetLastError();
        if (per_cu > 1) per_cu = 1;
        grid_blocks = cus * per_cu;
    }
    if (grid_blocks < 0) return;
    Params p{};
    p.x = (const float*)d_in[0]; p.norm1_g = (const float*)d_in[1]; p.w_in = (const float*)d_in[2]; p.w_pool = (const float*)d_in[3];
    p.swa_q_norm = (const float*)d_in[4]; p.swa_k_norm = (const float*)d_in[5]; p.swa_sinks = (const float*)d_in[6]; p.conv_w = (const float*)d_in[7];
    p.diff_q_norm = (const float*)d_in[8]; p.diff_k_norm = (const float*)d_in[9]; p.lam_q1 = (const float*)d_in[10]; p.lam_k1 = (const float*)d_in[11];
    p.lam_q2 = (const float*)d_in[12]; p.lam_k2 = (const float*)d_in[13]; p.out_norm_g = (const float*)d_in[14]; p.w_out = (const float*)d_in[15];
    p.norm2_g = (const float*)d_in[16]; p.w_query = (const float*)d_in[17]; p.sub_keys = (const float*)d_in[18]; p.peer_u = (const float*)d_in[19];
    p.peer_v = (const float*)d_in[20];
    p.out = (float*)d_out; p.ws = (unsigned char*)d_ws;
    if (hipMemsetAsync((char*)d_ws + WS_CTL, 0, 65536, stream) != hipSuccess) { fprintf(stderr, "kernel_launch: memset failed\n"); return; }
    void* args[] = {&p};
    hipError_t e = hipLaunchCooperativeKernel((const void*)fwd_kernel, dim3(grid_blocks), dim3(NTHREADS), args, LDS_BYTES, stream);
    if (e != hipSuccess) fprintf(stderr, "kernel_launch: cooperative launch failed: %s (grid %d)\n", hipGetErrorString(e), grid_blocks);
}
```

```cpp
#include <hip/hip_runtime.h>
#include <hip/hip_cooperative_groups.h>
#include <cstdio>
#include <cstdint>
namespace cg = cooperative_groups;

#define LAS __attribute__((address_space(3)))
typedef unsigned short bf16_t;
typedef short bf16x8 __attribute__((ext_vector_type(8)));
typedef float f32x4 __attribute__((ext_vector_type(4)));
typedef float f32x16 __attribute__((ext_vector_type(16)));
typedef unsigned u32x4 __attribute__((ext_vector_type(4)));
typedef unsigned u32x2 __attribute__((ext_vector_type(2)));

constexpr int BATCH = 16, SEQ = 2048, T = BATCH * SEQ, DM = 1024, NZ = 2304, NQ = 2048, DEPTH = 2;
constexpr int NTHREADS = 512, NWAVES = 8;
constexpr int NEXP = 16384;
constexpr float EPS = 1e-6f;
constexpr int ZC_PA = 0, ZC_QB = 256, ZC_KB = 512, ZC_VB = 640, ZC_HC = 768, ZC_BC = 1024, ZC_CC = 1280, ZC_QD = 1536, ZC_KD = 1792, ZC_VD = 2048;

constexpr size_t MiB = 1u << 20;
constexpr size_t WS_CTL = 0;
constexpr size_t WS_WIN = 1 * MiB;
constexpr size_t WS_WOUT = 10 * MiB;
constexpr size_t WS_WQ = 14 * MiB;
constexpr size_t WS_SK = 22 * MiB;
constexpr size_t WS_MISC = 23 * MiB;
constexpr size_t WS_XN = 24 * MiB;
constexpr size_t WS_Y = 88 * MiB;
constexpr size_t WS_XN2 = 152 * MiB;
constexpr size_t WS_Z = 216 * MiB;
constexpr size_t WS_IDX = 360 * MiB;
constexpr size_t WS_GATE = 376 * MiB;
constexpr size_t WS_PU = 392 * MiB;
constexpr size_t WS_PV = 424 * MiB;
constexpr size_t WS_P8 = 392 * MiB;
constexpr size_t WS_SCL = 23 * MiB + 65536;
constexpr size_t WS_RSTD = 23 * MiB + 524288;
constexpr size_t WS_SUQ = 23 * MiB + 655360;
constexpr size_t WS_END = 456 * MiB;

constexpr int LDS_BYTES = 147456;
#ifndef USE_I3U
#define USE_I3U 1
#endif
#ifndef P2_F16
#define P2_F16 1
#endif
#ifndef P1_PRESTAGE
#define P1_PRESTAGE 1
#endif
#ifndef USE_I4U
#define USE_I4U 1
#endif
#ifndef USE_POOLFOLD
#define USE_POOLFOLD 1
#endif
#ifndef USE_FP4
#define USE_FP4 3
#endif
#ifndef USE_PEER
#define USE_PEER 1
#endif
#ifndef USE_XBAR
#define USE_XBAR 1
#endif
#ifndef QUARTILE_BARRIER
#define QUARTILE_BARRIER 1
#endif
#ifndef PROBE_IDXMASK
#define PROBE_IDXMASK 0
#endif
#ifndef PROBE_HALFWAVES
#define PROBE_HALFWAVES 0
#endif
#ifndef PROBE_MASK
#define PROBE_MASK 0
#endif
#ifndef USE_ROUTE
#define USE_ROUTE 1
#endif
#ifndef USE_ATTN
#define USE_ATTN 1
#endif
#ifndef USE_GATHER
#define USE_GATHER 2
#endif
#ifndef USE_PG8
#define USE_PG8 7
#endif

struct Params {
    const float* x; const float* norm1_g; const float* w_in; const float* w_pool; const float* swa_q_norm; const float* swa_k_norm;
    const float* swa_sinks; const float* conv_w; const float* diff_q_norm; const float* diff_k_norm; const float* lam_q1; const float* lam_k1;
    const float* lam_q2; const float* lam_k2; const float* out_norm_g; const float* w_out; const float* norm2_g; const float* w_query;
    const float* sub_keys; const float* peer_u; const float* peer_v;
    float* out; unsigned char* ws;
};

#if defined(__HIP_DEVICE_COMPILE__)
typedef const __attribute__((address_space(4))) Params* KP;
__device__ __forceinline__ KP kargs() { KP k = (KP)__builtin_amdgcn_kernarg_segment_ptr(); asm volatile("" : "+s"(k)); return k; }
#endif
#if defined(__HIP_DEVICE_COMPILE__)
#define FRESH_PARAMS const Params p = *kargs()
#else
#define FRESH_PARAMS const Params p{}
#endif

struct Ids { int tid, lane, wave, bid, nblk, gw, ngw, gtid, gthreads; };
__device__ __forceinline__ int hw_lane() { unsigned z = 0u; asm volatile("" : "+v"(z)); return (int)__builtin_amdgcn_mbcnt_hi(~0u, __builtin_amdgcn_mbcnt_lo(~0u, z)); }
__device__ __forceinline__ Ids fresh_ids(int wv0) {
    Ids I; int bid = blockIdx.x, nblk = gridDim.x, wv = wv0;
    asm volatile("" : "+s"(wv)); asm volatile("" : "+s"(bid)); asm volatile("" : "+s"(nblk));
    int lane = hw_lane(); asm volatile("" : "+v"(lane));
    const int tid = wv * 64 + lane;
    I.tid = tid; I.lane = lane; I.wave = wv; I.bid = bid; I.nblk = nblk;
    I.gw = bid * NWAVES + I.wave; I.ngw = nblk * NWAVES; I.gtid = bid * NTHREADS + tid; I.gthreads = nblk * NTHREADS;
    return I;
}
#define FRESH_IDS const Ids I = fresh_ids(wv0); const int tid = I.tid, lane = I.lane, wave = I.wave, bid = I.bid, nblk = I.nblk, gw = I.gw, ngw = I.ngw, gtid = I.gtid, gthreads = I.gthreads; \
    (void)tid; (void)lane; (void)wave; (void)bid; (void)nblk; (void)gw; (void)ngw; (void)gtid; (void)gthreads

__device__ __forceinline__ float bf2f(unsigned v) { return __uint_as_float(v << 16); }
__device__ __forceinline__ unsigned f2bf(float f) { unsigned u = __float_as_uint(f); return (u + 0x7fffu + ((u >> 16) & 1u)) >> 16; }
typedef __bf16 bf16x2_t __attribute__((ext_vector_type(2)));
typedef float f32x2 __attribute__((ext_vector_type(2)));
typedef unsigned u32x3 __attribute__((ext_vector_type(3)));
__device__ __forceinline__ unsigned pk2(float lo, float hi) { const f32x2 f = {lo, hi}; return __builtin_bit_cast(unsigned, __builtin_convertvector(f, bf16x2_t)); }
__device__ __forceinline__ float dot2bf(unsigned a, unsigned b, float acc) { return __builtin_amdgcn_fdot2_f32_bf16(__builtin_bit_cast(bf16x2_t, a), __builtin_bit_cast(bf16x2_t, b), acc, false); }
__device__ __forceinline__ float wave_sum(float v) {
#pragma unroll
    for (int o = 1; o < 64; o <<= 1) v += __shfl_xor(v, o);
    return v;
}
__device__ __forceinline__ float wave_max(float v) {
#pragma unroll
    for (int o = 1; o < 64; o <<= 1) v = fmaxf(v, __shfl_xor(v, o));
    return v;
}
__device__ __forceinline__ void unpack8(const u32x4 w, float* f) {
    f[0] = __uint_as_float(w.x << 16); f[1] = __uint_as_float(w.x & 0xffff0000u);
    f[2] = __uint_as_float(w.y << 16); f[3] = __uint_as_float(w.y & 0xffff0000u);
    f[4] = __uint_as_float(w.z << 16); f[5] = __uint_as_float(w.z & 0xffff0000u);
    f[6] = __uint_as_float(w.w << 16); f[7] = __uint_as_float(w.w & 0xffff0000u);
}
__device__ __forceinline__ float lam_init_of(int l) { return l == 0 ? 0.2f : 0.35550907f; }

#define MFMA32(a, b, c) __builtin_amdgcn_mfma_f32_32x32x16_bf16((a), (b), (c), 0, 0, 0)
__device__ __forceinline__ int crow(int reg, int h) { return (reg & 3) + 8 * (reg >> 2) + 4 * h; }

#define RLX_AGENT __ATOMIC_RELAXED, __HIP_MEMORY_SCOPE_AGENT
#define XB_TMO      128
#define XB_XCNT(j)  (256  + 64 * (j))
#define XB_XSUB(j)  (1280 + 64 * (j))
#define XB_XGEN(j)  (2304 + 64 * (j))
#define XB_TOP      3328
#define XB_TOPGEN   3392
#define XCD_BAR_WORDS 3456
#define XB_SPIN_CAP (1u << 18)

__device__ __forceinline__ unsigned xb_ld(unsigned* p)              { return __hip_atomic_load(p, __ATOMIC_RELAXED, __HIP_MEMORY_SCOPE_AGENT); }
__device__ __forceinline__ unsigned xb_add(unsigned* p, unsigned v) { return __hip_atomic_fetch_add(p, v, __ATOMIC_RELAXED, __HIP_MEMORY_SCOPE_AGENT); }
__device__ __forceinline__ unsigned xb_xcc_id() { return (unsigned)__builtin_amdgcn_s_getreg((3 << 11) | 20) & 0xFu; }
#define XB_SPIN(cond, bar) do { unsigned _sp = 0; while (cond) { __builtin_amdgcn_s_sleep(1); \
    if ((++_sp & 255u) == 0u) { if (xb_ld(&(bar)[XB_TMO])) break; if (_sp > XB_SPIN_CAP) { atomicAdd(&(bar)[XB_TMO], 1u); break; } } } } while (0)

struct XcdBarrier {
    unsigned* bar; unsigned x;
    volatile LAS unsigned* st;
};

__device__ __forceinline__ XcdBarrier xcd_barrier_post(unsigned* bar, volatile LAS unsigned* st) {
    XcdBarrier b; b.bar = bar; b.x = xb_xcc_id(); b.st = st;
    if (threadIdx.x == 0) (void)xb_add(&bar[XB_XCNT(b.x)], 1u);
    return b;
}
__device__ __forceinline__ void xcd_barrier_complete(unsigned* bar, unsigned x, unsigned& nloc, unsigned& nx) {
    const unsigned G = gridDim.x * gridDim.y * gridDim.z;
    unsigned sum, cnt, mine, sp = 0u;
    for (;;) {
        sum = 0u; cnt = 0u; mine = 0u;
#pragma unroll
        for (unsigned j = 0; j < 16; ++j) { const unsigned c = xb_ld(&bar[XB_XCNT(j)]); sum += c; cnt += (c > 0u) ? 1u : 0u; mine = (j == x) ? c : mine; }
        if (sum == G) break;
        __builtin_amdgcn_s_sleep(1);
        if ((++sp & 255u) == 0u) { if (xb_ld(&bar[XB_TMO])) break; if (sp > XB_SPIN_CAP) { atomicAdd(&bar[XB_TMO], 1u); break; } }
    }
    nloc = mine > 0u ? mine : 1u; nx = cnt > 0u ? cnt : 1u;
}

__device__ __forceinline__ void xcd_barrier(const XcdBarrier& b) {
    asm volatile("s_waitcnt vmcnt(0)" ::: "memory");
    __syncthreads();
    if (threadIdx.x == 0) {
        unsigned* bar = b.bar;
        __builtin_amdgcn_s_waitcnt(0);
        unsigned nloc = b.st[0], nx = b.st[1];
        if (nloc == 0u) { xcd_barrier_complete(bar, b.x, nloc, nx); b.st[0] = nloc; b.st[1] = nx; }
        const unsigned old = xb_add(&bar[XB_XSUB(b.x)], 1u);
        const unsigned gen = old / nloc;
        if (old + 1u == (gen + 1u) * nloc) {
            __builtin_amdgcn_fence(__ATOMIC_RELEASE, "agent");
            asm volatile("s_waitcnt vmcnt(0)" ::: "memory");
            const unsigned og = xb_add(&bar[XB_TOP], 1u);
            const unsigned tg = og / nx;
            if (og + 1u == (tg + 1u) * nx) xb_add(&bar[XB_TOPGEN], 1u);
            else XB_SPIN(xb_ld(&bar[XB_TOPGEN]) == tg, bar);
            __builtin_amdgcn_fence(__ATOMIC_ACQUIRE, "agent");
            xb_add(&bar[XB_XGEN(b.x)], 1u);
            asm volatile("s_waitcnt vmcnt(0)" ::: "memory");
        } else {
            XB_SPIN(xb_ld(&bar[XB_XGEN(b.x)]) == gen, bar);
            __builtin_amdgcn_fence(__ATOMIC_ACQUIRE, "agent");
            asm volatile("s_waitcnt vmcnt(0)" ::: "memory");
        }
    }
    __syncthreads();
}

namespace pg8 {
#define PG8_LAS __attribute__((address_space(3)))
typedef unsigned short bf16_t;
typedef short bf16x8 __attribute__((ext_vector_type(8)));
typedef float f32x4 __attribute__((ext_vector_type(4)));
typedef unsigned u32x4 __attribute__((ext_vector_type(4)));
constexpr int BM = 256, BK = 64, HALF = 128, HTB = HALF * BK * 2  , STAGE_BYTES = 8 * HTB, NXCD = 8, WGM = 8;

__host__ __device__ __forceinline__ int lds_byte(int r, int c) { const int st = (r >> 4) * 2 + (c >> 5), rr = r & 15, cc = c & 31, ob = rr * 64 + cc * 2; return st * 1024 + (ob ^ (((ob >> 9) & 1) << 5)); }
__host__ __device__ __forceinline__ void stage_rc(int b, int& R, int& C) { const int st = b / 1024, sb = b % 1024, swz = sb ^ (((sb >> 9) & 1) << 5); R = (st >> 1) * 16 + swz / 64; C = (st & 1) * 32 + (swz % 64) / 2; }
__host__ __device__ __forceinline__ int perm32(int rho) { const int n = rho >> 4, i = rho & 15; return 8 * (i >> 2) + 4 * n + (i & 3); }

struct Unit { int pm, pn, hm; };
struct Gemm { const bf16_t* A; const bf16_t* Bt; int M, N, K; };

struct StaticOrder {
    static constexpr bool HALF_TAIL = false;
    int nM, nN, nwg, G, c;
    __host__ __device__ void init(int M, int N, int G_, int c_) { nM = M / BM; nN = N / BM; nwg = nM * nN; G = G_; c = c_; }
    __host__ __device__ bool next(int i, Unit& u) const {
        const long L = (long)i * G + c; if (L >= nwg) return false;
        int wgid = (int)L; { const int q = nwg / NXCD, r = nwg % NXCD, xcd = wgid % NXCD, off = wgid / NXCD; wgid = (xcd < r ? xcd * (q + 1) : r * (q + 1) + (xcd - r) * q) + off; }
        const int nig = WGM * nN, gid = wgid / nig, fm = gid * WGM, gsz = (nM - fm) < WGM ? (nM - fm) : WGM;
        u.pm = fm + ((wgid % nig) % gsz); u.pn = (wgid % nig) / gsz; u.hm = -1; return true;
    }
    __device__ __forceinline__ void a_ready(const Unit&) const {}
    __device__ __forceinline__ void done(const Unit&) const {}
};
struct StaticOrderHT : StaticOrder {
    static constexpr bool HALF_TAIL = true;
    __host__ __device__ bool next(int i, Unit& u) const {
        const int full = nwg / G, left = nwg - full * G;
        if (i < full || 2 * left > G) return StaticOrder::next(i, u);
        if (i > full || c >= 2 * left) return false;
        StaticOrder t = *this; t.c = c >> 1;
        if (!t.StaticOrder::next(i, u)) return false;
        u.hm = c & 1; return true;
    }
};

__device__ __forceinline__ unsigned cvt_pk_bf16(float lo, float hi) { unsigned r; asm volatile("v_cvt_pk_bf16_f32 %0, %1, %2" : "=v"(r) : "v"(lo), "v"(hi)); return r; }
typedef float f32x2 __attribute__((ext_vector_type(2)));
__device__ __forceinline__ f32x2 gelu_pk(f32x2 v) {
    const f32x2 av = __builtin_elementwise_abs(v), d = av * 0.2316418882f + 1.0f;
    f32x2 t; t.x = __builtin_amdgcn_rcpf(d.x); t.y = __builtin_amdgcn_rcpf(d.y);
    f32x2 q = t * 0.5307027145f + (-0.7265760135f); q = q * t + 0.7107068705f; q = q * t + (-0.142248368f); q = q * t + 0.127414796f; q = q * t;
    const f32x2 s = (v * v) * (-0.72134752044f);
    f32x2 e; e.x = __builtin_amdgcn_exp2f(s.x); e.y = __builtin_amdgcn_exp2f(s.y);
    const f32x2 m = v * (q * e), r = v - m;
    f32x2 o; o.x = v.x < 0.f ? m.x : r.x; o.y = v.y < 0.f ? m.y : r.y; return o;
}

template <int ACT  > struct EpiBf16 {
    static constexpr bool PERM = true, AFTER_DRAIN = false; static_assert(ACT == 0 || ACT == 1, "EpiBf16: ACT is 0 (none) or 1 (gelu_pk)");
    bf16_t* O; int ldc; const float* bias; int split_cols; size_t split_stride; float scale0;
    __device__ __forceinline__ void operator()(const f32x4 (&acc)[2][2][4][2], const Unit& u, int wr, int wc, int fr, int fq) const {
        const int row0 = u.pm * BM + wr * 64 + fr; int colt = u.pn * BM; bf16_t* base = O;
        float sc = 1.f; if (split_cols) { const int t = colt / split_cols; base += (size_t)t * split_stride; colt -= t * split_cols; if (t == 0) sc = scale0; }
        const int col0 = colt + wc * 32 + 8 * fq, bcol0 = u.pn * BM + wc * 32 + 8 * fq;
        f32x4 bv[2][2];
#pragma unroll
        for (int bj = 0; bj < 2; ++bj)
#pragma unroll
            for (int n = 0; n < 2; ++n) bv[bj][n] = bias ? *(const f32x4*)(bias + bcol0 + bj * HALF + 4 * n) : (f32x4){0.f, 0.f, 0.f, 0.f};
#pragma unroll
        for (int ai = 0; ai < 2; ++ai)
#pragma unroll
            for (int m = 0; m < 4; ++m) { bf16_t* rowp = base + (size_t)(row0 + ai * HALF + m * 16) * ldc + col0;
#pragma unroll
                for (int bj = 0; bj < 2; ++bj) { f32x4 v0 = acc[ai][bj][m][0] + bv[bj][0], v1 = acc[ai][bj][m][1] + bv[bj][1];
                    if (ACT == 1) { f32x2 a = gelu_pk((f32x2){v0[0], v0[1]}), b = gelu_pk((f32x2){v0[2], v0[3]}), c = gelu_pk((f32x2){v1[0], v1[1]}), d = gelu_pk((f32x2){v1[2], v1[3]});
                        v0 = (f32x4){a.x, a.y, b.x, b.y}; v1 = (f32x4){c.x, c.y, d.x, d.y}; }
                    v0 = v0 * sc; v1 = v1 * sc; u32x4 w; w.x = cvt_pk_bf16(v0[0], v0[1]); w.y = cvt_pk_bf16(v0[2], v0[3]); w.z = cvt_pk_bf16(v1[0], v1[1]); w.w = cvt_pk_bf16(v1[2], v1[3]);
                    *(u32x4*)(rowp + bj * HALF) = w; } }
    }
};
struct EpiBf16RS {
    static constexpr bool PERM = true, AFTER_DRAIN = false;
    bf16_t* O; int ldc; const float* rowscale;
    __device__ __forceinline__ void operator()(const f32x4 (&acc)[2][2][4][2], const Unit& u, int wr, int wc, int fr, int fq) const {
        const int row0 = u.pm * BM + wr * 64 + fr + (u.hm > 0 ? HALF : 0), col0 = u.pn * BM + wc * 32 + 8 * fq;
#pragma unroll
        for (int ai = 0; ai < 2; ++ai) if (ai == 0 || u.hm < 0)
#pragma unroll
            for (int m = 0; m < 4; ++m) { const int row = row0 + ai * HALF + m * 16; bf16_t* rowp = O + (size_t)row * ldc + col0; const float sc = rowscale ? rowscale[row] : 1.f;
#pragma unroll
                for (int bj = 0; bj < 2; ++bj) { const f32x4 v0 = acc[ai][bj][m][0] * sc, v1 = acc[ai][bj][m][1] * sc;
                    u32x4 w; w.x = cvt_pk_bf16(v0[0], v0[1]); w.y = cvt_pk_bf16(v0[2], v0[3]); w.z = cvt_pk_bf16(v1[0], v1[1]); w.w = cvt_pk_bf16(v1[2], v1[3]);
                    *(u32x4*)(rowp + bj * HALF) = w; } }
    }
};
struct EpiResB {
    static constexpr bool PERM = true, AFTER_DRAIN = false;
    const float* base32; const bf16_t* base16; bf16_t* xb; int ldc;
    __device__ __forceinline__ void operator()(const f32x4 (&acc)[2][2][4][2], const Unit& u, int wr, int wc, int fr, int fq) const {
        const int row0 = u.pm * BM + wr * 64 + fr, col0 = u.pn * BM + wc * 32 + 8 * fq;
#pragma unroll
        for (int ai = 0; ai < 2; ++ai)
#pragma unroll
            for (int m = 0; m < 4; ++m) { const size_t off = (size_t)(row0 + ai * HALF + m * 16) * ldc + col0;
#pragma unroll
                for (int bj = 0; bj < 2; ++bj) {
                    f32x4 b0, b1;
                    if (base16) { const u32x4 bw = *(const u32x4*)(base16 + off + bj * HALF);
                        b0 = (f32x4){__uint_as_float(bw.x << 16), __uint_as_float(bw.x & 0xffff0000u), __uint_as_float(bw.y << 16), __uint_as_float(bw.y & 0xffff0000u)};
                        b1 = (f32x4){__uint_as_float(bw.z << 16), __uint_as_float(bw.z & 0xffff0000u), __uint_as_float(bw.w << 16), __uint_as_float(bw.w & 0xffff0000u)}; }
                    else { b0 = *(const f32x4*)(base32 + off + bj * HALF); b1 = *(const f32x4*)(base32 + off + bj * HALF + 4); }
                    const f32x4 v0 = b0 + acc[ai][bj][m][0], v1 = b1 + acc[ai][bj][m][1];
                    u32x4 w; w.x = cvt_pk_bf16(v0[0], v0[1]); w.y = cvt_pk_bf16(v0[2], v0[3]); w.z = cvt_pk_bf16(v1[0], v1[1]); w.w = cvt_pk_bf16(v1[2], v1[3]);
                    *(u32x4*)(xb + off + bj * HALF) = w; }
                if (m & 1) asm volatile("" ::: "memory"); }
    }
};
struct EpiRes {
    static constexpr bool PERM = false, AFTER_DRAIN = false;
    const float* base; float* out; int ldc; bf16_t* xb;
    __device__ __forceinline__ void operator()(const f32x4 (&acc)[2][2][4][2], const Unit& u, int wr, int wc, int fr, int fq) const {
        const int col0 = u.pn * BM + wc * 32 + 4 * fq;
#pragma unroll
        for (int ai = 0; ai < 2; ++ai)
#pragma unroll
            for (int m = 0; m < 4; ++m) { const size_t off = (size_t)(u.pm * BM + ai * HALF + wr * 64 + m * 16 + fr) * ldc + col0;
#pragma unroll
                for (int bj = 0; bj < 2; ++bj)
#pragma unroll
                    for (int n = 0; n < 2; ++n) { const f32x4 bs = *(const f32x4*)(base + off + bj * HALF + n * 16); const f32x4 v = bs + acc[ai][bj][m][n]; *(f32x4*)(out + off + bj * HALF + n * 16) = v;
                        if (xb) { unsigned w0 = cvt_pk_bf16(v[0], v[1]), w1 = cvt_pk_bf16(v[2], v[3]); unsigned long long w = (unsigned long long)w0 | ((unsigned long long)w1 << 32); *(unsigned long long*)(xb + off + bj * HALF + n * 16) = w; } }
                if (m & 1) asm volatile("" ::: "memory"); }
    }
};
template <class Epi, class Sched, bool ALIGN_EPI = false, bool SP2 = false>
__device__ __forceinline__ void gemm_phase(PG8_LAS unsigned char* lds, const Gemm g, const Sched& S, const Epi& E, const int tid_in) {
    int tid_ = tid_in; asm volatile("" : "+v"(tid_));
    const int tid = tid_, wid = __builtin_amdgcn_readfirstlane(tid >> 6), lane = tid & 63, wr = wid >> 2, wc = wid & 3, fr = lane & 15, fq = lane >> 4;
    const int K = g.K, nt = K / BK;
    unsigned voffA[2], voffB[2];
#pragma unroll
    for (int i = 0; i < 2; ++i) { int R, C; stage_rc(tid * 16 + i * 8192, R, C); const int Rb = Epi::PERM ? ((R & ~31) + perm32(R & 31)) : R;
        voffA[i] = (unsigned)(R * K + C) * 2u; voffB[i] = (unsigned)(Rb * K + C) * 2u; }
    const size_t kstep = (size_t)(BK * 2);
    const size_t hstep = (size_t)HALF * K * 2;
    const size_t tstep = 2 * hstep;
    const unsigned ldsw = (unsigned)wid * 1024u;
    const int aoff = lds_byte(wr * 64 + fr, fq * 8), boff = lds_byte(wc * 32 + fr, fq * 8);
#define PG8_SA(b, h) (((b) * 2 + (h)) * HTB)
#define PG8_SB(b, h) ((4 + (b) * 2 + (h)) * HTB)
#define PG8_STAGE(bufoff, gbase, voff) do { _Pragma("unroll") for (int _i = 0; _i < 2; ++_i) \
        __builtin_amdgcn_global_load_lds((const unsigned*)((const char*)(gbase) + (voff)[_i]), (PG8_LAS unsigned*)(lds + (bufoff) + ldsw + _i * 8192), 16, 0, 0); } while (0)
#define PG8_LDA(dst, b, h) do { _Pragma("unroll") for (int m = 0; m < 4; ++m) _Pragma("unroll") for (int k = 0; k < 2; ++k) dst[m][k] = *(const PG8_LAS bf16x8*)(lds + PG8_SA(b, h) + aoff + m * 2048 + k * 1024); } while (0)
#define PG8_LDB(dst, b, h) do { _Pragma("unroll") for (int n = 0; n < 2; ++n) _Pragma("unroll") for (int k = 0; k < 2; ++k) dst[n][k] = *(const PG8_LAS bf16x8*)(lds + PG8_SB(b, h) + boff + n * 2048 + k * 1024); } while (0)
#define PG8_MMA(ai, bj, At, Bt) do { __builtin_amdgcn_s_setprio(1); _Pragma("unroll") for (int m = 0; m < 4; ++m) _Pragma("unroll") for (int n = 0; n < 2; ++n) _Pragma("unroll") for (int k = 0; k < 2; ++k) \
        acc[ai][bj][m][n] = __builtin_amdgcn_mfma_f32_16x16x32_bf16(Bt[n][k], At[m][k], acc[ai][bj][m][n], 0, 0, 0); __builtin_amdgcn_s_setprio(0); } while (0)
#define PG8_WAIT_V(n) asm volatile("s_waitcnt vmcnt(" #n ")" ::: "memory")
#define PG8_WAIT_L(n) asm volatile("s_waitcnt lgkmcnt(" #n ")" ::: "memory")
#define PG8_BAR __builtin_amdgcn_s_barrier()
#define PG8_SCHED __builtin_amdgcn_sched_barrier(0)
    Unit cur, nxt; int ui = 0;
    if (!S.next(0, cur)) return;
    f32x4 acc[2][2][4][2];
#pragma unroll
    for (int a = 0; a < 2; ++a)
#pragma unroll
        for (int b = 0; b < 2; ++b)
#pragma unroll
            for (int m = 0; m < 4; ++m)
#pragma unroll
                for (int n = 0; n < 2; ++n) acc[a][b][m][n] = (f32x4){0.f, 0.f, 0.f, 0.f};
    bf16x8 At[4][2], B0[2][2], B1[2][2];
    const char* cA = (const char*)g.A + (size_t)cur.pm * tstep + ((Sched::HALF_TAIL && cur.hm > 0) ? hstep : 0); const char* cB = (const char*)g.Bt + (size_t)cur.pn * tstep;
    size_t cHs = (Sched::HALF_TAIL && cur.hm >= 0) ? 0 : hstep;
    S.a_ready(cur);
    if constexpr (SP2) {
        PG8_STAGE(PG8_SB(0, 0), cB, voffB); PG8_STAGE(PG8_SB(0, 1), cB + hstep, voffB); PG8_STAGE(PG8_SA(0, 0), cA, voffA); PG8_STAGE(PG8_SA(0, 1), cA + cHs, voffA);
        if (wr == 1) PG8_BAR;
        PG8_WAIT_V(2); PG8_BAR;
        PG8_STAGE(PG8_SB(1, 0), cB + kstep, voffB); PG8_STAGE(PG8_SA(1, 0), cA + kstep, voffA); PG8_STAGE(PG8_SB(1, 1), cB + hstep + kstep, voffB);
        PG8_WAIT_V(6); PG8_BAR;
    } else {
        PG8_STAGE(PG8_SB(0, 0), cB, voffB); PG8_STAGE(PG8_SA(0, 0), cA, voffA); PG8_STAGE(PG8_SB(0, 1), cB + hstep, voffB); PG8_STAGE(PG8_SA(0, 1), cA + cHs, voffA);
        if (wr == 1) PG8_BAR;
        PG8_WAIT_V(4); PG8_BAR;
        PG8_STAGE(PG8_SB(1, 0), cB + kstep, voffB); PG8_STAGE(PG8_SA(1, 0), cA + kstep, voffA); PG8_STAGE(PG8_SB(1, 1), cB + hstep + kstep, voffB);
        PG8_WAIT_V(6); PG8_BAR;
    }
    for (;;) {
        const bool has_next = S.next(ui + 1, nxt);
        const char* nA = has_next ? (const char*)g.A + (size_t)nxt.pm * tstep + ((Sched::HALF_TAIL && nxt.hm > 0) ? hstep : 0) : cA; const char* nB = has_next ? (const char*)g.Bt + (size_t)nxt.pn * tstep : cB;
        const size_t nHs = (Sched::HALF_TAIL && has_next && nxt.hm >= 0) ? 0 : (has_next ? hstep : cHs);
        const bool curHalf = Sched::HALF_TAIL && cur.hm >= 0;
        if (!curHalf) {
        for (int t = 0; t < nt; t += 2) {
            const bool last = (t == nt - 2);
            const char* a1 = cA + (size_t)(t + 1) * kstep;
            const char* a2 = last ? nA : cA + (size_t)(t + 2) * kstep; const char* b2 = last ? nB : cB + (size_t)(t + 2) * kstep;
            const char* a3 = a2 + kstep; const char* b3 = b2 + kstep;
            const size_t hs2 = last ? nHs : cHs;
            if (last && has_next) S.a_ready(nxt);
            if constexpr (SP2) {
            PG8_LDB(B0, 0, 0); PG8_LDB(B1, 0, 1); PG8_SCHED; PG8_LDA(At, 0, 0); PG8_STAGE(PG8_SA(1, 1), a1 + cHs, voffA);
            PG8_WAIT_V(8); PG8_WAIT_L(0); PG8_BAR; PG8_MMA(0, 0, At, B0); PG8_MMA(0, 1, At, B1); PG8_BAR; PG8_SCHED;
            PG8_LDA(At, 0, 1);
            PG8_STAGE(PG8_SB(0, 0), b2, voffB); PG8_STAGE(PG8_SB(0, 1), b2 + hstep, voffB); PG8_STAGE(PG8_SA(0, 0), a2, voffA);
            PG8_WAIT_V(8); PG8_WAIT_L(0); PG8_BAR; PG8_MMA(1, 0, At, B0); PG8_MMA(1, 1, At, B1); PG8_BAR; PG8_SCHED;
            PG8_LDB(B0, 1, 0); PG8_LDB(B1, 1, 1); PG8_SCHED; PG8_LDA(At, 1, 0); PG8_STAGE(PG8_SA(0, 1), a2 + hs2, voffA);
            PG8_WAIT_V(8); PG8_WAIT_L(0); PG8_BAR; PG8_MMA(0, 0, At, B0); PG8_MMA(0, 1, At, B1); PG8_BAR; PG8_SCHED;
            PG8_LDA(At, 1, 1);
            PG8_STAGE(PG8_SB(1, 0), b3, voffB); PG8_STAGE(PG8_SB(1, 1), b3 + hstep, voffB); PG8_STAGE(PG8_SA(1, 0), a3, voffA);
            PG8_WAIT_V(8); PG8_WAIT_L(0); PG8_BAR; PG8_MMA(1, 0, At, B0); PG8_MMA(1, 1, At, B1); PG8_BAR; PG8_SCHED;
            } else {
            PG8_LDB(B0, 0, 0); PG8_SCHED; PG8_LDA(At, 0, 0); PG8_STAGE(PG8_SA(1, 1), a1 + hstep, voffA);
            PG8_WAIT_L(8); PG8_BAR; PG8_WAIT_L(0); PG8_MMA(0, 0, At, B0); PG8_BAR; PG8_SCHED;
            PG8_LDB(B1, 0, 1); PG8_STAGE(PG8_SB(0, 0), b2, voffB);
            PG8_BAR; PG8_WAIT_L(0); PG8_MMA(0, 1, At, B1); PG8_BAR;
            PG8_LDA(At, 0, 1); PG8_STAGE(PG8_SA(0, 0), a2, voffA);
            PG8_BAR; PG8_WAIT_L(0); PG8_MMA(1, 0, At, B0); PG8_BAR; PG8_SCHED;
            PG8_STAGE(PG8_SB(0, 1), b2 + hstep, voffB);
            PG8_WAIT_V(6); PG8_BAR; PG8_MMA(1, 1, At, B1); PG8_BAR;
            PG8_LDB(B0, 1, 0); PG8_SCHED; PG8_LDA(At, 1, 0); PG8_STAGE(PG8_SA(0, 1), a2 + hstep, voffA);
            PG8_WAIT_L(8); PG8_BAR; PG8_WAIT_L(0); PG8_MMA(0, 0, At, B0); PG8_BAR; PG8_SCHED;
            PG8_LDB(B1, 1, 1); PG8_STAGE(PG8_SB(1, 0), b3, voffB);
            PG8_BAR; PG8_WAIT_L(0); PG8_MMA(0, 1, At, B1); PG8_BAR;
            PG8_LDA(At, 1, 1); PG8_STAGE(PG8_SA(1, 0), a3, voffA);
            PG8_BAR; PG8_WAIT_L(0); PG8_MMA(1, 0, At, B0); PG8_BAR; PG8_SCHED;
            PG8_STAGE(PG8_SB(1, 1), b3 + hstep, voffB);
            PG8_WAIT_V(6); PG8_BAR; PG8_MMA(1, 1, At, B1); PG8_BAR;
            }
        }
        } else if constexpr (Sched::HALF_TAIL) {
        for (int t = 0; t < nt; t += 2) {
            const bool last = (t == nt - 2);
            const char* a1 = cA + (size_t)(t + 1) * kstep;
            const char* a2 = last ? nA : cA + (size_t)(t + 2) * kstep; const char* b2 = last ? nB : cB + (size_t)(t + 2) * kstep;
            const char* a3 = a2 + kstep; const char* b3 = b2 + kstep;
            const size_t hs2 = last ? nHs : cHs;
            if (last && has_next) S.a_ready(nxt);
            if constexpr (SP2) {
            PG8_LDB(B0, 0, 0); PG8_LDB(B1, 0, 1); PG8_SCHED; PG8_LDA(At, 0, 0); PG8_STAGE(PG8_SA(1, 1), a1 + cHs, voffA);
            PG8_WAIT_V(8); PG8_WAIT_L(0); PG8_BAR; PG8_MMA(0, 0, At, B0); PG8_MMA(0, 1, At, B1); PG8_BAR; PG8_SCHED;
            PG8_STAGE(PG8_SB(0, 0), b2, voffB); PG8_STAGE(PG8_SB(0, 1), b2 + hstep, voffB); PG8_STAGE(PG8_SA(0, 0), a2, voffA);
            PG8_WAIT_V(8); PG8_WAIT_L(0); PG8_BAR; PG8_BAR; PG8_SCHED;
            PG8_LDB(B0, 1, 0); PG8_LDB(B1, 1, 1); PG8_SCHED; PG8_LDA(At, 1, 0); PG8_STAGE(PG8_SA(0, 1), a2 + hs2, voffA);
            PG8_WAIT_V(8); PG8_WAIT_L(0); PG8_BAR; PG8_MMA(0, 0, At, B0); PG8_MMA(0, 1, At, B1); PG8_BAR; PG8_SCHED;
            PG8_STAGE(PG8_SB(1, 0), b3, voffB); PG8_STAGE(PG8_SB(1, 1), b3 + hstep, voffB); PG8_STAGE(PG8_SA(1, 0), a3, voffA);
            PG8_WAIT_V(8); PG8_WAIT_L(0); PG8_BAR; PG8_BAR; PG8_SCHED;
            } else {
            PG8_LDB(B0, 0, 0); PG8_SCHED; PG8_LDA(At, 0, 0); PG8_STAGE(PG8_SA(1, 1), a1 + hstep, voffA);
            PG8_WAIT_L(8); PG8_BAR; PG8_WAIT_L(0); PG8_MMA(0, 0, At, B0); PG8_BAR; PG8_SCHED;
            PG8_LDB(B1, 0, 1); PG8_STAGE(PG8_SB(0, 0), b2, voffB);
            PG8_BAR; PG8_WAIT_L(0); PG8_MMA(0, 1, At, B1); PG8_BAR;
            PG8_LDA(At, 0, 1); PG8_STAGE(PG8_SA(0, 0), a2, voffA);
            PG8_BAR; PG8_WAIT_L(0); PG8_MMA(1, 0, At, B0); PG8_BAR; PG8_SCHED;
            PG8_STAGE(PG8_SB(0, 1), b2 + hstep, voffB);
            PG8_WAIT_V(6); PG8_BAR; PG8_MMA(1, 1, At, B1); PG8_BAR;
            PG8_LDB(B0, 1, 0); PG8_SCHED; PG8_LDA(At, 1, 0); PG8_STAGE(PG8_SA(0, 1), a2 + hstep, voffA);
            PG8_WAIT_L(8); PG8_BAR; PG8_WAIT_L(0); PG8_MMA(0, 0, At, B0); PG8_BAR; PG8_SCHED;
            PG8_LDB(B1, 1, 1); PG8_STAGE(PG8_SB(1, 0), b3, voffB);
            PG8_BAR; PG8_WAIT_L(0); PG8_MMA(0, 1, At, B1); PG8_BAR;
            PG8_LDA(At, 1, 1); PG8_STAGE(PG8_SA(1, 0), a3, voffA);
            PG8_BAR; PG8_WAIT_L(0); PG8_MMA(1, 0, At, B0); PG8_BAR; PG8_SCHED;
            PG8_STAGE(PG8_SB(1, 1), b3 + hstep, voffB);
            PG8_WAIT_V(6); PG8_BAR; PG8_MMA(1, 1, At, B1); PG8_BAR;
            }
        }
        }
        if constexpr (ALIGN_EPI) { if (wr == 0) PG8_BAR; }
        if constexpr (!Epi::AFTER_DRAIN) { E(acc, cur, wr, wc, fr, fq); S.done(cur); }
        if (!has_next) break;
#pragma unroll
        for (int a = 0; a < 2; ++a)
#pragma unroll
            for (int b = 0; b < 2; ++b)
#pragma unroll
                for (int m = 0; m < 4; ++m)
#pragma unroll
                    for (int n = 0; n < 2; ++n) acc[a][b][m][n] = (f32x4){0.f, 0.f, 0.f, 0.f};
        cur = nxt; cA = nA; cB = nB; cHs = nHs; ++ui;
        if constexpr (ALIGN_EPI) { if (wr == 1) PG8_BAR; }
    }
    PG8_WAIT_V(0);
    if constexpr (!ALIGN_EPI) { if (wr == 0) PG8_BAR; }
    PG8_BAR;
    if constexpr (Epi::AFTER_DRAIN) { E.fused(acc, cur, wr, wc, fr, fq, lds, wid, lane); S.done(cur); }
#undef PG8_SA
#undef PG8_SB
#undef PG8_STAGE
#undef PG8_LDA
#undef PG8_LDB
#undef PG8_MMA
#undef PG8_WAIT_V
#undef PG8_WAIT_L
#undef PG8_BAR
#undef PG8_SCHED
}
}

__device__ __forceinline__ void transpose_item(const float* W, int K, int N, bf16_t* WT, const float* scale, float mulhi, int khi,
                                               LAS float* scr, int item, int lane, const float* fold = nullptr) {
    const int nblk = N / 32, kb = item / nblk, nb = item % nblk, k0 = 64 * kb, n0 = 32 * nb;
    if (fold != nullptr && n0 < 256) {
        const int g = n0 >> 6, dd = (n0 & 63) + (lane & 31);
        const float* wp = fold + (size_t)g * 64 * 64 + dd;
        float wpv[64];
#pragma unroll
        for (int c = 0; c < 64; ++c) wpv[c] = wp[c * 64];
#pragma unroll 2
        for (int i = 0; i < 32; ++i) {
            const int kk = 2 * i + (lane >> 5);
            const f32x4* wr = (const f32x4*)(W + (size_t)(k0 + kk) * N + g * 64);
            float a = 0.f;
#pragma unroll
            for (int c = 0; c < 16; ++c) { const f32x4 w4 = wr[c]; a += w4.x * wpv[4 * c] + w4.y * wpv[4 * c + 1] + w4.z * wpv[4 * c + 2] + w4.w * wpv[4 * c + 3]; }
            scr[kk * 33 + (lane & 31)] = a * scale[k0 + kk];
        }
    } else {
#pragma unroll 8
    for (int i = 0; i < 32; ++i) {
        const int kk = 2 * i + (lane >> 5);
        float s = scale[k0 + kk]; if (k0 + kk >= khi) s *= mulhi;
        scr[kk * 33 + (lane & 31)] = __builtin_nontemporal_load(W + (size_t)(k0 + kk) * N + n0 + (lane & 31)) * s;
    }
    }
    asm volatile("s_waitcnt lgkmcnt(0)" ::: "memory");
    const int c = lane & 7;
#pragma unroll
    for (int j = 0; j < 4; ++j) {
        const int n = (lane >> 3) + 8 * j; const LAS float* s = scr + (8 * c) * 33 + n;
        u32x4 o; o.x = pk2(s[0 * 33], s[1 * 33]); o.y = pk2(s[2 * 33], s[3 * 33]); o.z = pk2(s[4 * 33], s[5 * 33]); o.w = pk2(s[6 * 33], s[7 * 33]);
        *(u32x4*)(WT + (size_t)(n0 + n) * K + k0 + 8 * c) = o;
    }
    asm volatile("s_waitcnt lgkmcnt(0)" ::: "memory");
}

__device__ __forceinline__ void rms_row_to_bf16(const float* xrow, bf16_t* orow, int lane) {
    const f32x4* xr = (const f32x4*)xrow + lane;
    f32x4 v[4]; float s = 0.f;
#pragma unroll
    for (int j = 0; j < 4; ++j) { v[j] = xr[64 * j]; s += (v[j].x * v[j].x + v[j].y * v[j].y) + (v[j].z * v[j].z + v[j].w * v[j].w); }
    const float rstd = rsqrtf(wave_sum(s) * (1.f / DM) + EPS);
    u32x2* o8 = (u32x2*)orow + lane;
#pragma unroll
    for (int j = 0; j < 4; ++j) { u32x2 o; o.x = pk2(v[j].x * rstd, v[j].y * rstd); o.y = pk2(v[j].z * rstd, v[j].w * rstd); o8[64 * j] = o; }
}

__device__ __forceinline__ void phase_prep(int wv0, LAS unsigned char* lds) {
    FRESH_PARAMS; FRESH_IDS;
    LAS float* scr = (LAS float*)(lds + wave * 16384);
    bf16_t* WinT = (bf16_t*)(p.ws + WS_WIN); bf16_t* WoutT = (bf16_t*)(p.ws + WS_WOUT); bf16_t* WqT = (bf16_t*)(p.ws + WS_WQ);
    constexpr int I_IN = 16 * 72, I_OUT = 16 * 32, I_Q = 16 * 64, I_L = I_IN + I_OUT + I_Q;
    for (int it = gw; it < DEPTH * I_L; it += ngw) {
        const int l = it / I_L; int r = it % I_L;
        if (r < I_IN) { transpose_item(p.w_in + (size_t)l * DM * NZ, DM, NZ, WinT + (size_t)l * NZ * DM, p.norm1_g + l * DM, 1.f, 1 << 30, scr, r, lane, USE_POOLFOLD ? p.w_pool + (size_t)l * 4 * 64 * 64 : nullptr); continue; }
        r -= I_IN;
        if (r < I_OUT) { transpose_item(p.w_out + (size_t)l * DM * DM, DM, DM, WoutT + (size_t)l * DM * DM, p.out_norm_g + l * DM, 1.f - lam_init_of(l), 768, scr, r, lane); continue; }
        r -= I_OUT;
        transpose_item(p.w_query + (size_t)l * DM * NQ, DM, NQ, WqT + (size_t)l * NQ * DM, p.norm2_g + l * DM, 1.f, 1 << 30, scr, r, lane);
    }
    {
        bf16_t* SK = (bf16_t*)(p.ws + WS_SK);
        for (int i = gw * 64 + lane; i < DEPTH * 2 * 128 * 128; i += ngw * 64) SK[i] = (bf16_t)f2bf(p.sub_keys[i]);
    }
    bf16_t* XN = (bf16_t*)(p.ws + WS_XN);
    {
        float* RS = (float*)(p.ws + WS_RSTD);
#pragma unroll 1
        for (int m0 = 4 * gw; m0 < T; m0 += 4 * ngw) {
            f32x4 vb[4][4];
#pragma unroll
            for (int bi = 0; bi < 4; ++bi) { const f32x4* xr = (const f32x4*)(p.x + (size_t)(m0 + bi) * DM) + lane;
#pragma unroll
                for (int jj = 0; jj < 4; ++jj) vb[bi][jj] = __builtin_nontemporal_load(xr + 64 * jj); }
#pragma unroll
            for (int bi = 0; bi < 4; ++bi) { const int m = m0 + bi;
                float sq = 0.f;
#pragma unroll
                for (int jj = 0; jj < 4; ++jj) { const f32x4 v = vb[bi][jj]; sq += (v.x * v.x + v.y * v.y) + (v.z * v.z + v.w * v.w); }
                const float rstd = rsqrtf(wave_sum(sq) * (1.f / DM) + EPS);
                u32x2* o8 = (u32x2*)(XN + (size_t)m * DM) + lane;
#pragma unroll
                for (int jj = 0; jj < 4; ++jj) { const f32x4 v = vb[bi][jj]; u32x2 o; o.x = pk2(v.x, v.y); o.y = pk2(v.z, v.w); o8[64 * jj] = o; }
                if (lane == 0) RS[m] = rstd;
            }
        }
    }
    if (gw == 0) {
        float* misc = (float*)(p.ws + WS_MISC);
        for (int l = 0; l < DEPTH; ++l) {
            float a = 0.f, b = 0.f, gq = 0.f, gk = 0.f;
            if (lane < 32) { a = p.lam_q1[l * 32 + lane] * p.lam_k1[l * 32 + lane]; b = p.lam_q2[l * 32 + lane] * p.lam_k2[l * 32 + lane];
                             gq = fabsf(p.diff_q_norm[l * 32 + lane]); gk = fabsf(p.diff_k_norm[l * 32 + lane]); }
            a = wave_sum(a); b = wave_sum(b); gq = wave_max(gq); gk = wave_max(gk);
            const float sq = wave_max(fabsf(p.swa_q_norm[l * 64 + lane])), sk = wave_max(fabsf(p.swa_k_norm[l * 64 + lane]));
            if (lane == 0) {
                misc[l * 16 + 0] = __expf(a) - __expf(b) + lam_init_of(l);
                misc[l * 16 + 1] = 32.f * 0.17677669529663687f * gq * gk * 1.02f + 0.05f;
                misc[l * 16 + 2] = 64.f * 0.125f * sq * sk * 1.02f + 0.05f;
            }
        }
    }
}

struct EpiStoreBf16 { bf16_t* O; int ldc; __device__ __forceinline__ void operator()(int row, int col, float v) const { O[(size_t)row * ldc + col] = (bf16_t)f2bf(v); } };
struct EpiResidual { const float* base; float* out; int ldc; __device__ __forceinline__ void operator()(int row, int col, float v) const { const size_t o = (size_t)row * ldc + col; out[o] = base[o] + v; } };

template <class Epi>
__device__ __forceinline__ void gemm_simple(const bf16_t* A, const bf16_t* Bt, int M, int N, int K, const Epi& E, int gw, int ngw, int lane) {
    const int r = lane & 31, h = lane >> 5;
    const int ntn = N / 64, ntiles = (M / 64) * ntn;
    for (int tile = gw; tile < ntiles; tile += ngw) {
        const int m0 = (tile / ntn) * 64, n0 = (tile % ntn) * 64;
        f32x16 acc[2][2];
#pragma unroll
        for (int i = 0; i < 2; ++i)
#pragma unroll
            for (int j = 0; j < 2; ++j)
#pragma unroll
                for (int q = 0; q < 16; ++q) acc[i][j][q] = 0.f;
        const bf16_t* a0 = A + (size_t)(m0 + r) * K + 8 * h; const bf16_t* a1 = a0 + (size_t)32 * K;
        const bf16_t* b0 = Bt + (size_t)(n0 + r) * K + 8 * h; const bf16_t* b1 = b0 + (size_t)32 * K;
#pragma unroll 2
        for (int k = 0; k < K; k += 16) {
            const bf16x8 fa0 = *(const bf16x8*)(a0 + k), fa1 = *(const bf16x8*)(a1 + k), fb0 = *(const bf16x8*)(b0 + k), fb1 = *(const bf16x8*)(b1 + k);
            acc[0][0] = MFMA32(fa0, fb0, acc[0][0]); acc[0][1] = MFMA32(fa0, fb1, acc[0][1]);
            acc[1][0] = MFMA32(fa1, fb0, acc[1][0]); acc[1][1] = MFMA32(fa1, fb1, acc[1][1]);
        }
#pragma unroll
        for (int i = 0; i < 2; ++i)
#pragma unroll
            for (int j = 0; j < 2; ++j)
#pragma unroll
                for (int q = 0; q < 16; ++q) E(m0 + 32 * i + crow(q, h), n0 + 32 * j + r, acc[i][j][q]);
    }
}

__device__ __forceinline__ void phase_qknorm(int wv0, int l) {
    FRESH_PARAMS; FRESH_IDS;
    bf16_t* z = (bf16_t*)(p.ws + WS_Z);
    for (int idx = gtid; idx < T * 22; idx += gthreads) {
        const int t = idx / 22, u = idx % 22;
        int col, W; const float* g; float sc;
        if (u < 4) { col = ZC_QB + 64 * u; W = 64; g = p.swa_q_norm + l * 64; sc = 0.125f; }
        else if (u < 6) { col = ZC_KB + 64 * (u - 4); W = 64; g = p.swa_k_norm + l * 64; sc = 1.f; }
        else if (u < 14) { col = ZC_QD + 32 * (u - 6); W = 32; g = p.diff_q_norm + l * 32; sc = 0.17677669529663687f; }
        else { col = ZC_KD + 32 * (u - 14); W = 32; g = p.diff_k_norm + l * 32; sc = 1.f; }
        u32x4* ptr = (u32x4*)(z + (size_t)t * NZ + col);
        float ss = 0.f;
#pragma unroll 1
        for (int c = 0; c < W / 8; ++c) { float f[8]; unpack8(ptr[c], f);
#pragma unroll
            for (int i = 0; i < 8; ++i) ss += f[i] * f[i]; }
        const float rn = rsqrtf(ss / (float)W + EPS) * sc;
#pragma unroll 1
        for (int c = 0; c < W / 8; ++c) { float f[8]; unpack8(ptr[c], f); u32x4 o;
            const float* gg = g + 8 * c;
            o.x = pk2(f[0] * rn * gg[0], f[1] * rn * gg[1]); o.y = pk2(f[2] * rn * gg[2], f[3] * rn * gg[3]);
            o.z = pk2(f[4] * rn * gg[4], f[5] * rn * gg[5]); o.w = pk2(f[6] * rn * gg[6], f[7] * rn * gg[7]);
            ptr[c] = o; }
    }
}

#define DPP_MOV(v, CTRL) __builtin_bit_cast(float, __builtin_amdgcn_update_dpp(__builtin_bit_cast(int, (v)), __builtin_bit_cast(int, (v)), (CTRL), 0xf, 0xf, false))
#define DPP_ADD8(v) do { (v) += DPP_MOV((v), 0xB1); (v) += DPP_MOV((v), 0x4E); (v) += DPP_MOV((v), 0x141); } while (0)
__device__ __forceinline__ void phase_poolconv3(int wv0, int l) {
    FRESH_PARAMS; FRESH_IDS;
    const bf16_t* z = (const bf16_t*)(p.ws + WS_Z); bf16_t* y = (bf16_t*)(p.ws + WS_Y);
    const int oc = lane & 7, tk = lane >> 3;
#pragma unroll 1
    for (int u = gw; u < (T / 8) * 4; u += ngw) {
        const int g = u & 3, t = (u >> 2) * 8 + tk, pos = t & (SEQ - 1);
        const int win = 2 << g, cnt = (pos + 1 < win) ? pos + 1 : win;
        const bf16_t* zp = z + (size_t)t * NZ + ZC_PA + g * 64 + 8 * oc;
        float cur[8], sm[8];
        unpack8(*(const u32x4*)zp, cur);
#pragma unroll
        for (int q = 0; q < 8; ++q) sm[q] = cur[q];
        u32x4 wrow[15];
#pragma unroll
        for (int jj = 1; jj < 16; ++jj) wrow[jj - 1] = (jj < cnt) ? *(const u32x4*)(zp - (size_t)jj * NZ) : (u32x4){0u, 0u, 0u, 0u};
#pragma unroll
        for (int jj = 1; jj < 16; ++jj) { float f[8]; unpack8(wrow[jj - 1], f);
#pragma unroll
            for (int q = 0; q < 8; ++q) sm[q] += f[q]; }
        const float ic = 1.f / (float)cnt;
        float d[8], ss = 0.f;
#pragma unroll
        for (int q = 0; q < 8; ++q) { d[q] = sm[q] * ic - cur[q]; ss += d[q] * d[q]; }
        DPP_ADD8(ss);
        const float rn = rsqrtf(ss * (1.f / 64.f) + EPS);
        u32x4 o; o.x = pk2(d[0] * rn, d[1] * rn); o.y = pk2(d[2] * rn, d[3] * rn); o.z = pk2(d[4] * rn, d[5] * rn); o.w = pk2(d[6] * rn, d[7] * rn);
        *(u32x4*)(y + (size_t)t * DM + g * 64 + 8 * oc) = o;
    }
    {
        const int oc32 = lane & 31, tp = lane >> 5;
        f32x4 cwa[3], cwb[3];
#pragma unroll
        for (int k = 0; k < 3; ++k) { cwa[k] = *(const f32x4*)(p.conv_w + (l * 3 + k) * 256 + 8 * oc32); cwb[k] = *(const f32x4*)(p.conv_w + (l * 3 + k) * 256 + 8 * oc32 + 4); }
#pragma unroll 1
        for (int u = gw; u < T / 4; u += ngw) {
            const int ta = u * 4 + 2 * tp, pa = ta & (SEQ - 1);
            const bf16_t* zr = z + (size_t)ta * NZ + 8 * oc32;
            float zc[4][8];
#pragma unroll
            for (int k = 0; k < 4; ++k) {
                if (pa + k - 2 >= 0) { float fc[8], fh[8]; unpack8(*(const u32x4*)(zr + (size_t)(k - 2) * NZ + ZC_CC), fc); unpack8(*(const u32x4*)(zr + (size_t)(k - 2) * NZ + ZC_HC), fh);
#pragma unroll
                    for (int q = 0; q < 8; ++q) zc[k][q] = fc[q] * fh[q]; }
                else {
#pragma unroll
                    for (int q = 0; q < 8; ++q) zc[k][q] = 0.f; }
            }
#pragma unroll
            for (int k = 0; k < 2; ++k) {
                float fb[8]; unpack8(*(const u32x4*)(zr + (size_t)k * NZ + ZC_BC), fb);
                float yc[8], ss = 0.f;
#pragma unroll
                for (int q = 0; q < 8; ++q) {
                    const float c0 = q < 4 ? cwa[0][q & 3] : cwb[0][q & 3], c1 = q < 4 ? cwa[1][q & 3] : cwb[1][q & 3], c2 = q < 4 ? cwa[2][q & 3] : cwb[2][q & 3];
                    yc[q] = fb[q] * (c0 * zc[k][q] + c1 * zc[k + 1][q] + c2 * zc[k + 2][q]); ss += yc[q] * yc[q];
                }
                DPP_ADD8(ss);
                const float rn = rsqrtf(ss * (1.f / 64.f) + EPS);
                u32x4 o; o.x = pk2(yc[0] * rn, yc[1] * rn); o.y = pk2(yc[2] * rn, yc[3] * rn); o.z = pk2(yc[4] * rn, yc[5] * rn); o.w = pk2(yc[6] * rn, yc[7] * rn);
                *(u32x4*)(y + (size_t)(ta + k) * DM + 512 + 8 * oc32) = o;
            }
        }
    }
}

template <int G>
__device__ __forceinline__ void pool_unit4(const bf16_t* z, bf16_t* y, int tbase, int lane) {
    constexpr int WIN = 2 << G, NR = WIN + 7;
    const int oc = lane & 7, t0 = tbase + 8 * (lane >> 3), pos0 = t0 & (SEQ - 1);
    const bf16_t* zp = z + (size_t)t0 * NZ + ZC_PA + G * 64 + 8 * oc;
    u32x4 R[NR];
#pragma unroll
    for (int k = 0; k < NR; ++k) R[k] = (pos0 - (WIN - 1) + k >= 0) ? __builtin_nontemporal_load((const u32x4*)(zp + ((ptrdiff_t)k - (WIN - 1)) * NZ)) : (u32x4){0u, 0u, 0u, 0u};
    float sm[8];
#pragma unroll
    for (int q = 0; q < 8; ++q) sm[q] = 0.f;
#pragma unroll
    for (int k = 0; k < WIN - 1; ++k) { float f[8]; unpack8(R[k], f);
#pragma unroll
        for (int q = 0; q < 8; ++q) sm[q] += f[q]; }
#pragma unroll
    for (int i = 0; i < 8; ++i) {
        float cur[8]; unpack8(R[WIN - 1 + i], cur);
#pragma unroll
        for (int q = 0; q < 8; ++q) sm[q] += cur[q];
        const int pos = pos0 + i, cnt = (pos + 1 < WIN) ? pos + 1 : WIN;
        const float ic = 1.f / (float)cnt;
        float d[8], ss = 0.f;
#pragma unroll
        for (int q = 0; q < 8; ++q) { d[q] = sm[q] * ic - cur[q]; ss += d[q] * d[q]; }
        DPP_ADD8(ss);
        const float rn = rsqrtf(ss * (1.f / 64.f) + EPS);
        u32x4 o; o.x = pk2(d[0] * rn, d[1] * rn); o.y = pk2(d[2] * rn, d[3] * rn); o.z = pk2(d[4] * rn, d[5] * rn); o.w = pk2(d[6] * rn, d[7] * rn);
        *(u32x4*)(y + (size_t)(t0 + i) * DM + G * 64 + 8 * oc) = o;
        { float f[8]; unpack8(R[i], f);
#pragma unroll
          for (int q = 0; q < 8; ++q) sm[q] -= f[q]; }
    }
}
__device__ __forceinline__ void phase_poolconv4(int wv0, int l) {
    FRESH_PARAMS; FRESH_IDS;
    const bf16_t* z = (const bf16_t*)(p.ws + WS_Z); bf16_t* y = (bf16_t*)(p.ws + WS_Y);
#pragma unroll 1
    for (int u = gw; u < (T / 64) * 4; u += ngw) {
        const int g = u & 3, tbase = (u >> 2) * 64;
        if (g == 0) pool_unit4<0>(z, y, tbase, lane); else if (g == 1) pool_unit4<1>(z, y, tbase, lane); else if (g == 2) pool_unit4<2>(z, y, tbase, lane); else pool_unit4<3>(z, y, tbase, lane);
    }
    {
        int ln = lane; asm volatile("" : "+v"(ln));
        const int oc32 = ln & 31, tr = ln >> 5;
        f32x4 cwa[3], cwb[3];
#pragma unroll
        for (int k = 0; k < 3; ++k) { cwa[k] = *(const f32x4*)(p.conv_w + (l * 3 + k) * 256 + 8 * oc32); cwb[k] = *(const f32x4*)(p.conv_w + (l * 3 + k) * 256 + 8 * oc32 + 4); }
#pragma unroll 1
        for (int u = gw; u < T / 16; u += ngw) {
            const int t0 = u * 16 + 8 * tr, pos0 = t0 & (SEQ - 1);
            const bf16_t* zr = z + (size_t)t0 * NZ + 8 * oc32;
            u32x4 rc[10], rh[10], rb[8];
#pragma unroll
            for (int k = 0; k < 10; ++k) {
                const bool ok = pos0 + k - 2 >= 0;
                rc[k] = ok ? __builtin_nontemporal_load((const u32x4*)(zr + ((ptrdiff_t)k - 2) * NZ + ZC_CC)) : (u32x4){0u, 0u, 0u, 0u};
                rh[k] = ok ? __builtin_nontemporal_load((const u32x4*)(zr + ((ptrdiff_t)k - 2) * NZ + ZC_HC)) : (u32x4){0u, 0u, 0u, 0u};
            }
#pragma unroll
            for (int k = 0; k < 8; ++k) rb[k] = __builtin_nontemporal_load((const u32x4*)(zr + (size_t)k * NZ + ZC_BC));
            float z0[8], z1[8];
            { float fc[8], fh[8]; unpack8(rc[0], fc); unpack8(rh[0], fh);
#pragma unroll
              for (int q = 0; q < 8; ++q) z0[q] = fc[q] * fh[q];
              unpack8(rc[1], fc); unpack8(rh[1], fh);
#pragma unroll
              for (int q = 0; q < 8; ++q) z1[q] = fc[q] * fh[q]; }
#pragma unroll
            for (int k = 0; k < 8; ++k) {
                float z2[8], fb[8];
                { float fc[8], fh[8]; unpack8(rc[k + 2], fc); unpack8(rh[k + 2], fh);
#pragma unroll
                  for (int q = 0; q < 8; ++q) z2[q] = fc[q] * fh[q]; }
                unpack8(rb[k], fb);
                float yc[8], ss = 0.f;
#pragma unroll
                for (int q = 0; q < 8; ++q) {
                    const float c0 = q < 4 ? cwa[0][q & 3] : cwb[0][q & 3], c1 = q < 4 ? cwa[1][q & 3] : cwb[1][q & 3], c2 = q < 4 ? cwa[2][q & 3] : cwb[2][q & 3];
                    yc[q] = fb[q] * (c0 * z0[q] + c1 * z1[q] + c2 * z2[q]); ss += yc[q] * yc[q];
                }
                DPP_ADD8(ss);
                const float rn = rsqrtf(ss * (1.f / 64.f) + EPS);
                u32x4 o; o.x = pk2(yc[0] * rn, yc[1] * rn); o.y = pk2(yc[2] * rn, yc[3] * rn); o.z = pk2(yc[4] * rn, yc[5] * rn); o.w = pk2(yc[6] * rn, yc[7] * rn);
                *(u32x4*)(y + (size_t)(t0 + k) * DM + 512 + 8 * oc32) = o;
#pragma unroll
                for (int q = 0; q < 8; ++q) { z0[q] = z1[q]; z1[q] = z2[q]; }
            }
        }
    }
}

constexpr int PC_P_OFF = 0, PC_D_OFF = 48 * 256 * 4;
__device__ __forceinline__ void phase_poolconv(int wv0, int l, LAS unsigned char* lds) {
    FRESH_PARAMS; FRESH_IDS;
    const bf16_t* z = (const bf16_t*)(p.ws + WS_Z); bf16_t* y = (bf16_t*)(p.ws + WS_Y);
    LAS float* P = (LAS float*)(lds + PC_P_OFF); LAS float* dl = (LAS float*)(lds + PC_D_OFF);
    const int ch = tid & 255, half = tid >> 8, g = ch >> 6, dd = ch & 63;
    const int win = 2 << g;
    float w[64];
#pragma unroll
    for (int c = 0; c < 64; ++c) w[c] = p.w_pool[((size_t)(l * 4 + g) * 64 + c) * 64 + dd];
    const int oc = tid & 31, tp = tid >> 5;
    f32x4 cwa[3], cwb[3];
#pragma unroll
    for (int k = 0; k < 3; ++k) { cwa[k] = *(const f32x4*)(p.conv_w + (l * 3 + k) * 256 + 8 * oc); cwb[k] = *(const f32x4*)(p.conv_w + (l * 3 + k) * 256 + 8 * oc + 4); }
#pragma unroll 1
    for (int tile = bid; tile < T / 32; tile += nblk) {
        const int t0 = tile * 32, pos0 = t0 & (SEQ - 1);
#pragma unroll
        for (int k = 0; k < 3; ++k) {
            const int idx = tid + 512 * k;
            if (idx < 47 * 32) {
                const int row = idx >> 5, c8 = idx & 31;
                float f[8];
                if (pos0 + row - 15 >= 0) unpack8(*(const u32x4*)(z + (size_t)(t0 + row - 15) * NZ + ZC_PA + 8 * c8), f);
                else {
#pragma unroll
                    for (int q = 0; q < 8; ++q) f[q] = 0.f; }
                *(LAS f32x4*)(P + row * 256 + 8 * c8) = (f32x4){f[0], f[1], f[2], f[3]};
                *(LAS f32x4*)(P + row * 256 + 8 * c8 + 4) = (f32x4){f[4], f[5], f[6], f[7]};
            }
        }
        {
            const int ta = t0 + 2 * tp, pa = pos0 + 2 * tp;
            const bf16_t* zr = z + (size_t)ta * NZ + 8 * oc;
            float zc[4][8];
#pragma unroll
            for (int k = 0; k < 4; ++k) {
                if (pa + k - 2 >= 0) { float fc[8], fh[8]; unpack8(*(const u32x4*)(zr + (size_t)(k - 2) * NZ + ZC_CC), fc); unpack8(*(const u32x4*)(zr + (size_t)(k - 2) * NZ + ZC_HC), fh);
#pragma unroll
                    for (int q = 0; q < 8; ++q) zc[k][q] = fc[q] * fh[q]; }
                else {
#pragma unroll
                    for (int q = 0; q < 8; ++q) zc[k][q] = 0.f; }
            }
#pragma unroll
            for (int k = 0; k < 2; ++k) {
                float fb[8]; unpack8(*(const u32x4*)(zr + (size_t)k * NZ + ZC_BC), fb);
                float yc[8], ss = 0.f;
#pragma unroll
                for (int q = 0; q < 8; ++q) {
                    const float c0 = q < 4 ? cwa[0][q & 3] : cwb[0][q & 3], c1 = q < 4 ? cwa[1][q & 3] : cwb[1][q & 3], c2 = q < 4 ? cwa[2][q & 3] : cwb[2][q & 3];
                    yc[q] = fb[q] * (c0 * zc[k][q] + c1 * zc[k + 1][q] + c2 * zc[k + 2][q]); ss += yc[q] * yc[q];
                }
                ss += __shfl_xor(ss, 1); ss += __shfl_xor(ss, 2); ss += __shfl_xor(ss, 4);
                const float rn = rsqrtf(ss * (1.f / 64.f) + EPS);
                u32x4 o; o.x = pk2(yc[0] * rn, yc[1] * rn); o.y = pk2(yc[2] * rn, yc[3] * rn); o.z = pk2(yc[4] * rn, yc[5] * rn); o.w = pk2(yc[6] * rn, yc[7] * rn);
                *(u32x4*)(y + (size_t)(ta + k) * DM + 512 + 8 * oc) = o;
            }
        }
        __syncthreads();
        {
            const int tl0 = half * 16;
            float sum = 0.f;
#pragma unroll 1
            for (int jj = 0; jj < win; ++jj) sum += P[(15 + tl0 - jj) * 256 + ch];
#pragma unroll 1
            for (int i = 0; i < 16; ++i) {
                const int tl = tl0 + i, pos = pos0 + tl;
                const int cnt = (pos + 1 < win) ? pos + 1 : win;
                const float cur = P[(15 + tl) * 256 + ch];
                dl[tl * 256 + ch] = sum / (float)cnt - cur;
                if (i < 15) sum += P[(16 + tl) * 256 + ch] - P[(16 + tl - win) * 256 + ch];
            }
        }
        __syncthreads();
#pragma unroll 1
        for (int i = 0; i < 16; ++i) {
            const int tl = half * 16 + i;
            float acc = 0.f;
#pragma unroll
            for (int c = 0; c < 64; c += 4) { const f32x4 dv = *(const LAS f32x4*)(dl + tl * 256 + g * 64 + c);
                acc += dv.x * w[c] + dv.y * w[c + 1] + dv.z * w[c + 2] + dv.w * w[c + 3]; }
            const float ss = wave_sum(acc * acc);
            const float rn = rsqrtf(ss * (1.f / 64.f) + EPS);
            y[(size_t)(t0 + tl) * DM + ch] = (bf16_t)f2bf(acc * rn);
        }
        __syncthreads();
    }
}

__device__ __forceinline__ void phase_swa_naive(int wv0, int l) {
    FRESH_PARAMS; FRESH_IDS;
    const bf16_t* z = (const bf16_t*)(p.ws + WS_Z); bf16_t* y = (bf16_t*)(p.ws + WS_Y);
    const float* misc = (const float*)(p.ws + WS_MISC);
    const float bound = misc[l * 16 + 2];
    for (int idx = gtid; idx < BATCH * 4 * SEQ * 4; idx += gthreads) {
        const int dg = idx & 3, q = (idx >> 2) & (SEQ - 1), hq = (idx >> 13) & 3, b = idx >> 15;
        const int hkv = hq >> 1;
        const float slope = exp2f(-(float)(hq + 1));
        const float sink = p.swa_sinks[l * 4 + hq];
        const float mx = fmaxf(bound, sink);
        float qf[64];
        { const u32x4* qp = (const u32x4*)(z + (size_t)(b * SEQ + q) * NZ + ZC_QB + hq * 64);
#pragma unroll
          for (int c = 0; c < 8; ++c) unpack8(qp[c], qf + 8 * c); }
        float lsum = 0.f, o[16];
#pragma unroll
        for (int i = 0; i < 16; ++i) o[i] = 0.f;
        const bf16_t* kbase = z + (size_t)(b * SEQ) * NZ + ZC_KB + hkv * 64;
        const bf16_t* vbase = z + (size_t)(b * SEQ) * NZ + ZC_VB + hkv * 64 + dg * 16;
        const int s0 = (q - 127 > 0) ? q - 127 : 0;
#pragma unroll 1
        for (int s = s0; s <= q; ++s) {
            const u32x4* kp = (const u32x4*)(kbase + (size_t)s * NZ);
            float sc = 0.f;
#pragma unroll
            for (int c = 0; c < 8; ++c) { float f[8]; unpack8(kp[c], f);
#pragma unroll
                for (int i = 0; i < 8; ++i) sc += f[i] * qf[8 * c + i]; }
            const float pr = __expf(sc - slope * (float)(q - s) - mx);
            lsum += pr;
            const u32x4* vp = (const u32x4*)(vbase + (size_t)s * NZ);
            float vf[16]; unpack8(vp[0], vf); unpack8(vp[1], vf + 8);
#pragma unroll
            for (int i = 0; i < 16; ++i) o[i] += pr * vf[i];
        }
        lsum += __expf(sink - mx);
        const float inv = 1.f / lsum;
        float ss = 0.f;
#pragma unroll
        for (int i = 0; i < 16; ++i) { o[i] *= inv; ss += o[i] * o[i]; }
        ss += __shfl_xor(ss, 1); ss += __shfl_xor(ss, 2);
        const float rn = rsqrtf(ss * (1.f / 64.f) + EPS);
        u32x4 w0, w1;
        w0.x = pk2(o[0] * rn, o[1] * rn); w0.y = pk2(o[2] * rn, o[3] * rn); w0.z = pk2(o[4] * rn, o[5] * rn); w0.w = pk2(o[6] * rn, o[7] * rn);
        w1.x = pk2(o[8] * rn, o[9] * rn); w1.y = pk2(o[10] * rn, o[11] * rn); w1.z = pk2(o[12] * rn, o[13] * rn); w1.w = pk2(o[14] * rn, o[15] * rn);
        u32x4* yo = (u32x4*)(y + (size_t)(b * SEQ + q) * DM + 256 + hq * 64 + dg * 16);
        yo[0] = w0; yo[1] = w1;
    }
}

__device__ __forceinline__ void phase_diff_naive(int wv0, int l) {
    FRESH_PARAMS; FRESH_IDS;
    const bf16_t* z = (const bf16_t*)(p.ws + WS_Z); bf16_t* y = (bf16_t*)(p.ws + WS_Y);
    const float* misc = (const float*)(p.ws + WS_MISC);
    const float lam = misc[l * 16 + 0], bound = misc[l * 16 + 1];
    for (int idx = gtid; idx < BATCH * 4 * SEQ * 4; idx += gthreads) {
        const int dg = idx & 3, q = (idx >> 2) & (SEQ - 1), h = (idx >> 13) & 3, b = idx >> 15;
        const float slope = exp2f(-(float)(h + 5));
        float qf[64];
        { const u32x4* qp = (const u32x4*)(z + (size_t)(b * SEQ + q) * NZ + ZC_QD + h * 64);
#pragma unroll
          for (int c = 0; c < 8; ++c) unpack8(qp[c], qf + 8 * c); }
        float l1 = 0.f, l2 = 0.f, o1[16], o2[16];
#pragma unroll
        for (int i = 0; i < 16; ++i) { o1[i] = 0.f; o2[i] = 0.f; }
        const bf16_t* kbase = z + (size_t)(b * SEQ) * NZ + ZC_KD + h * 64;
        const bf16_t* vbase = z + (size_t)(b * SEQ) * NZ + ZC_VD + h * 64 + dg * 16;
#pragma unroll 1
        for (int s = 0; s <= q; ++s) {
            const u32x4* kp = (const u32x4*)(kbase + (size_t)s * NZ);
            float s1 = 0.f, s2 = 0.f;
#pragma unroll
            for (int c = 0; c < 4; ++c) { float f[8]; unpack8(kp[c], f);
#pragma unroll
                for (int i = 0; i < 8; ++i) s1 += f[i] * qf[8 * c + i]; }
#pragma unroll
            for (int c = 4; c < 8; ++c) { float f[8]; unpack8(kp[c], f);
#pragma unroll
                for (int i = 0; i < 8; ++i) s2 += f[i] * qf[8 * c + i]; }
            const float ab = slope * (float)(q - s) + bound;
            const float p1 = __expf(s1 - ab), p2 = __expf(s2 - ab);
            l1 += p1; l2 += p2;
            const u32x4* vp = (const u32x4*)(vbase + (size_t)s * NZ);
            float vf[16]; unpack8(vp[0], vf); unpack8(vp[1], vf + 8);
#pragma unroll
            for (int i = 0; i < 16; ++i) { o1[i] += p1 * vf[i]; o2[i] += p2 * vf[i]; }
        }
        const float i1 = 1.f / l1, i2 = lam / l2;
        float o[16], ss = 0.f;
#pragma unroll
        for (int i = 0; i < 16; ++i) { o[i] = o1[i] * i1 - o2[i] * i2; ss += o[i] * o[i]; }
        ss += __shfl_xor(ss, 1); ss += __shfl_xor(ss, 2);
        const float rn = rsqrtf(ss * (1.f / 64.f) + EPS);
        u32x4 w0, w1;
        w0.x = pk2(o[0] * rn, o[1] * rn); w0.y = pk2(o[2] * rn, o[3] * rn); w0.z = pk2(o[4] * rn, o[5] * rn); w0.w = pk2(o[6] * rn, o[7] * rn);
        w1.x = pk2(o[8] * rn, o[9] * rn); w1.y = pk2(o[10] * rn, o[11] * rn); w1.z = pk2(o[12] * rn, o[13] * rn); w1.w = pk2(o[14] * rn, o[15] * rn);
        u32x4* yo = (u32x4*)(y + (size_t)(b * SEQ + q) * DM + 768 + h * 64 + dg * 16);
        yo[0] = w0; yo[1] = w1;
    }
}

constexpr int ATT_KBYTES = 8192, ATT_VBYTES = 8192, ATT_BUF = ATT_KBYTES + ATT_VBYTES;
typedef short s16x4 __attribute__((ext_vector_type(4)));
template <bool DIFF>
__device__ __forceinline__ void attn_unit(LAS unsigned char* lds, const bf16_t* z, bf16_t* y, int b, int head, int qblk, float lam, float bound, const float* sinks_l,
                                          const float* gq, const float* gk, int tid, int lane, int wave) {
    asm volatile("" : "+v"(tid), "+v"(lane));
    const int r = lane & 31, h = lane >> 5, tq_ = (lane & 15) >> 2, tp_ = lane & 3;
    const float LOG2E = 1.4426950408889634f;
    int q0, qhead, qcol, kcol, vcol, ycol, kt_lo, kt_hi;
    float slope, mx;
    if (DIFF) { q0 = qblk * 256 + 32 * wave; qhead = head; qcol = ZC_QD + head * 64; kcol = ZC_KD + head * 64; vcol = ZC_VD + head * 64; ycol = 768 + head * 64;
                slope = exp2f(-(float)(head + 5)); mx = bound; kt_lo = 0; kt_hi = 4 * qblk + 3; }
    else { const int gq = wave >> 2; q0 = qblk * 128 + 32 * (wave & 3); qhead = head * 2 + gq; qcol = ZC_QB + qhead * 64; kcol = ZC_KB + head * 64; vcol = ZC_VB + head * 64; ycol = 256 + qhead * 64;
           slope = exp2f(-(float)(qhead + 1)); mx = fmaxf(bound, sinks_l[qhead]); kt_lo = (qblk > 0) ? 2 * qblk - 2 : 0; kt_hi = 2 * qblk + 1; }
    const float slope2 = slope * LOG2E, bound2 = mx * LOG2E;
    const int wkt_hi = (q0 + 31) >> 6;
    int wkt_lo = 0; if (!DIFF) { const int k0 = q0 - 127; wkt_lo = (k0 > 0) ? (k0 >> 6) : 0; }
    const int skey = tid >> 3, sch = tid & 7;
    const bf16_t* srow = z + (size_t)(b * SEQ + skey) * NZ + sch * 8;
    const int kw_off = skey * 128 + ((sch ^ ((skey >> 1) & 7)) << 4);
    const int vw_off = skey * 128 + (((2 * sch) ^ (((skey >> 1) & 1) << 3)) << 3);
    u32x4 kreg, vreg;
    u32x4 kr4[4], vr4[4];
    const float* gkp = gk + (DIFF ? ((8 * sch) & 31) : (8 * sch));
#define ATT_LOAD(kt, KR, VR) do { const bf16_t* _p = srow + (size_t)(kt) * 64 * NZ; KR = *(const u32x4*)(_p + kcol); VR = *(const u32x4*)(_p + vcol); } while (0)
#define ATT_KNORM() do { float _f[8]; unpack8(kreg, _f); const f32x4 _ga = *(const f32x4*)gkp, _gb = *(const f32x4*)(gkp + 4); const float gkv[8] = {_ga.x, _ga.y, _ga.z, _ga.w, _gb.x, _gb.y, _gb.z, _gb.w}; float _ss = 0.f; _Pragma("unroll") for (int _e = 0; _e < 8; ++_e) _ss += _f[_e] * _f[_e]; \
        _ss += __shfl_xor(_ss, 1); _ss += __shfl_xor(_ss, 2); if (!DIFF) _ss += __shfl_xor(_ss, 4); \
        const float _rn = rsqrtf(_ss * (DIFF ? 1.f / 32.f : 1.f / 64.f) + EPS); \
        kreg.x = pk2(_f[0] * _rn * gkv[0], _f[1] * _rn * gkv[1]); kreg.y = pk2(_f[2] * _rn * gkv[2], _f[3] * _rn * gkv[3]); \
        kreg.z = pk2(_f[4] * _rn * gkv[4], _f[5] * _rn * gkv[5]); kreg.w = pk2(_f[6] * _rn * gkv[6], _f[7] * _rn * gkv[7]); } while (0)
#define ATT_WRITE(bufi) do { LAS unsigned char* _kb = lds + (bufi) * ATT_BUF; *(LAS u32x4*)(_kb + kw_off) = kreg; *(LAS u32x4*)(_kb + ATT_KBYTES + vw_off) = vreg; } while (0)
    if (!DIFF) {
#pragma unroll
        for (int ti = 0; ti < 4; ++ti) if (kt_lo + ti <= kt_hi) ATT_LOAD(kt_lo + ti, kr4[ti], vr4[ti]);
    }
    bf16x8 qf[4];
    { const bf16_t* qp = z + (size_t)(b * SEQ + q0 + r) * NZ + qcol + 8 * h;
      float qv[4][8], ssq[2] = {0.f, 0.f};
#pragma unroll
      for (int ks = 0; ks < 4; ++ks) { unpack8(__builtin_nontemporal_load((const u32x4*)(qp + 16 * ks)), qv[ks]);
#pragma unroll
          for (int e = 0; e < 8; ++e) ssq[DIFF ? (ks >> 1) : 0] += qv[ks][e] * qv[ks][e]; }
      ssq[0] += __shfl_xor(ssq[0], 32); ssq[1] += __shfl_xor(ssq[1], 32);
      const float rq0 = rsqrtf(ssq[0] * (DIFF ? 1.f / 32.f : 1.f / 64.f) + EPS) * (DIFF ? 0.17677669529663687f : 0.125f) * LOG2E;
      const float rq1 = DIFF ? rsqrtf(ssq[1] * (1.f / 32.f) + EPS) * 0.17677669529663687f * LOG2E : rq0;
#pragma unroll
      for (int ks = 0; ks < 4; ++ks) { const float rq = (DIFF && ks >= 2) ? rq1 : rq0; const float* gp = gq + (DIFF ? ((16 * ks + 8 * h) & 31) : (16 * ks + 8 * h));
          u32x4 w; w.x = pk2(qv[ks][0] * rq * gp[0], qv[ks][1] * rq * gp[1]); w.y = pk2(qv[ks][2] * rq * gp[2], qv[ks][3] * rq * gp[3]);
          w.z = pk2(qv[ks][4] * rq * gp[4], qv[ks][5] * rq * gp[5]); w.w = pk2(qv[ks][6] * rq * gp[6], qv[ks][7] * rq * gp[7]);
          qf[ks] = __builtin_bit_cast(bf16x8, w); }
    }
    f32x16 O1[2], O2[2];
#pragma unroll
    for (int dt = 0; dt < 2; ++dt)
#pragma unroll
        for (int q = 0; q < 16; ++q) { O1[dt][q] = 0.f; O2[dt][q] = 0.f; }
    float l1 = 0.f, l2 = 0.f;
    if (DIFF) { ATT_LOAD(kt_lo, kreg, vreg); ATT_KNORM(); ATT_WRITE(0); }
    else {
        __syncthreads();
#pragma unroll
        for (int ti = 0; ti < 4; ++ti) if (kt_lo + ti <= kt_hi) { kreg = kr4[ti]; vreg = vr4[ti]; ATT_KNORM(); ATT_WRITE(ti); }
    }
    __syncthreads();
#pragma unroll 1
    for (int kt = (DIFF ? kt_lo : wkt_lo); kt <= (DIFF ? kt_hi : wkt_hi); ++kt) {
        const int bufi = DIFF ? ((kt - kt_lo) & 1) : (kt - kt_lo);
        if (DIFF && kt < kt_hi) ATT_LOAD(kt + 1, kreg, vreg);
        if (!DIFF || (kt >= wkt_lo && kt <= wkt_hi)) {
            const LAS unsigned char* kbuf = lds + bufi * ATT_BUF; const LAS unsigned char* vbuf = kbuf + ATT_KBYTES;
            const bool need_mask = (kt * 64 + 63 > q0) || (!DIFF && (q0 + 31 - kt * 64 >= 128));
#pragma unroll
            for (int kb = 0; kb < 2; ++kb) {
                const int key = kb * 32 + r;
                bf16x8 kf[4];
#pragma unroll
                for (int ks = 0; ks < 4; ++ks) kf[ks] = *(const LAS bf16x8*)(kbuf + key * 128 + (((2 * ks + h) ^ ((key >> 1) & 7)) << 4));
                const int base_d = (q0 + r) - (kt * 64 + kb * 32) - 4 * h;
                const float t0 = -(slope2 * (float)base_d + bound2);
                f32x16 S1, S2;
#pragma unroll
                for (int q = 0; q < 16; ++q) { S1[q] = t0 + slope2 * (float)((q & 3) + 8 * (q >> 2)); S2[q] = S1[q]; }
                if (DIFF) { S1 = MFMA32(kf[0], qf[0], S1); S1 = MFMA32(kf[1], qf[1], S1); S2 = MFMA32(kf[2], qf[2], S2); S2 = MFMA32(kf[3], qf[3], S2); }
                else { S1 = MFMA32(kf[0], qf[0], S1); S1 = MFMA32(kf[1], qf[1], S1); S1 = MFMA32(kf[2], qf[2], S1); S1 = MFMA32(kf[3], qf[3], S1); }
                if (need_mask) {
                    asm volatile("" ::: "memory");
#pragma unroll
                    for (int q = 0; q < 16; ++q) {
                        const int dist = base_d - ((q & 3) + 8 * (q >> 2)); const bool ok = (dist >= 0) && (DIFF || dist < 128);
                        S1[q] = ok ? __builtin_amdgcn_exp2f(S1[q]) : 0.f; if (DIFF) S2[q] = ok ? __builtin_amdgcn_exp2f(S2[q]) : 0.f;
                    }
                } else {
#pragma unroll
                    for (int q = 0; q < 16; ++q) { S1[q] = __builtin_amdgcn_exp2f(S1[q]); if (DIFF) S2[q] = __builtin_amdgcn_exp2f(S2[q]); }
                }
                bf16x8 pb1[2], pb2[2];
#pragma unroll
                for (int s2 = 0; s2 < 2; ++s2) {
                    u32x4 w; w.x = pk2(S1[8 * s2 + 0], S1[8 * s2 + 1]); w.y = pk2(S1[8 * s2 + 2], S1[8 * s2 + 3]); w.z = pk2(S1[8 * s2 + 4], S1[8 * s2 + 5]); w.w = pk2(S1[8 * s2 + 6], S1[8 * s2 + 7]);
                    pb1[s2] = __builtin_bit_cast(bf16x8, w);
                    l1 = dot2bf(w.x, 0x3F803F80u, l1); l1 = dot2bf(w.y, 0x3F803F80u, l1); l1 = dot2bf(w.z, 0x3F803F80u, l1); l1 = dot2bf(w.w, 0x3F803F80u, l1);
                    if (DIFF) { u32x4 w2; w2.x = pk2(S2[8 * s2 + 0], S2[8 * s2 + 1]); w2.y = pk2(S2[8 * s2 + 2], S2[8 * s2 + 3]); w2.z = pk2(S2[8 * s2 + 4], S2[8 * s2 + 5]); w2.w = pk2(S2[8 * s2 + 6], S2[8 * s2 + 7]);
                                pb2[s2] = __builtin_bit_cast(bf16x8, w2);
                                l2 = dot2bf(w2.x, 0x3F803F80u, l2); l2 = dot2bf(w2.y, 0x3F803F80u, l2); l2 = dot2bf(w2.z, 0x3F803F80u, l2); l2 = dot2bf(w2.w, 0x3F803F80u, l2); }
                }
#pragma unroll
                for (int dt = 0; dt < 2; ++dt)
#pragma unroll
                    for (int s2 = 0; s2 < 2; ++s2) {
                        const int key0 = kb * 32 + 16 * s2 + 4 * h + tq_, unit = dt * 8 + 4 * ((lane >> 4) & 1) + tp_;
                        LAS unsigned char* va = (LAS unsigned char*)vbuf + key0 * 128 + ((unit ^ (((key0 >> 1) & 1) << 3)) << 3);
                        const s16x4 lo = __builtin_amdgcn_ds_read_tr16_b64_v4i16((LAS s16x4*)va), hi = __builtin_amdgcn_ds_read_tr16_b64_v4i16((LAS s16x4*)(va + 8 * 128));
                        const bf16x8 vf = __builtin_shufflevector(lo, hi, 0, 1, 2, 3, 4, 5, 6, 7);
                        O1[dt] = MFMA32(vf, pb1[s2], O1[dt]);
                        if (DIFF) O2[dt] = MFMA32(vf, pb2[s2], O2[dt]);
                    }
            }
        }
        if (DIFF) { if (kt < kt_hi) { ATT_KNORM(); ATT_WRITE(bufi ^ 1); } __syncthreads(); }
    }
#undef ATT_LOAD
#undef ATT_KNORM
#undef ATT_WRITE
    l1 += __shfl_xor(l1, 32);
    float i1, i2 = 0.f;
    if (DIFF) { l2 += __shfl_xor(l2, 32); i1 = 1.f / l1; i2 = lam / l2; }
    else { l1 += __builtin_amdgcn_exp2f((sinks_l[qhead] - mx) * LOG2E); i1 = 1.f / l1; }
    float ss = 0.f;
#pragma unroll
    for (int dt = 0; dt < 2; ++dt)
#pragma unroll
        for (int q = 0; q < 16; ++q) { const float o = DIFF ? (O1[dt][q] * i1 - O2[dt][q] * i2) : O1[dt][q] * i1; O1[dt][q] = o; ss += o * o; }
    ss += __shfl_xor(ss, 32);
    const float rn = rsqrtf(ss * (1.f / 64.f) + EPS);
    bf16_t* yrow = y + (size_t)(b * SEQ + q0 + r) * DM + ycol + 4 * h;
#pragma unroll
    for (int dt = 0; dt < 2; ++dt)
#pragma unroll
        for (int g4 = 0; g4 < 4; ++g4) { u32x2 o; o.x = pk2(O1[dt][4 * g4 + 0] * rn, O1[dt][4 * g4 + 1] * rn); o.y = pk2(O1[dt][4 * g4 + 2] * rn, O1[dt][4 * g4 + 3] * rn);
            *(u32x2*)(yrow + dt * 32 + 8 * g4) = o; }
}

__device__ __forceinline__ void phase_attn(int wv0, int l, LAS unsigned char* lds) {
    FRESH_PARAMS; FRESH_IDS;
    const bf16_t* z = (const bf16_t*)(p.ws + WS_Z); bf16_t* y = (bf16_t*)(p.ws + WS_Y);
    const float* misc = (const float*)(p.ws + WS_MISC);
    const float lam = misc[l * 16 + 0], bound_d = misc[l * 16 + 1], bound_s = misc[l * 16 + 2];
    const float* sinks_l = p.swa_sinks + l * 4;
    const float* gqd = p.diff_q_norm + l * 32; const float* gkd = p.diff_k_norm + l * 32; const float* gqs = p.swa_q_norm + l * 64; const float* gks = p.swa_k_norm + l * 64;
#pragma unroll 1
    for (int u = bid; u < 256; u += nblk) {
        const int bh = u >> 2, pp = u & 3;
        attn_unit<true>(lds, z, y, bh >> 2, bh & 3, 7 - pp, lam, bound_d, sinks_l, gqd, gkd, tid, lane, wave);
        attn_unit<true>(lds, z, y, bh >> 2, bh & 3, pp, lam, bound_d, sinks_l, gqd, gkd, tid, lane, wave);
    }
#pragma unroll 1
    for (int u = bid; u < 512; u += nblk)
        attn_unit<false>(lds, z, y, u >> 5, (u >> 4) & 1, u & 15, lam, bound_s, sinks_l, gqs, gks, tid, lane, wave);
}

#define INS_PACKED(L, xv) do { float _x = (xv); _Pragma("unroll") for (int _m = 0; _m < 16; ++_m) { const float _hi = fmaxf(L[_m], _x); _x = fminf(L[_m], _x); L[_m] = _hi; } } while (0)
#define INS_MED3(L, xv) do { const float _x = (xv); float _pv = L[0]; L[0] = fmaxf(_pv, _x); _Pragma("unroll") for (int _m = 1; _m < 16; ++_m) { const float _cu = L[_m]; L[_m] = __builtin_amdgcn_fmed3f(_pv, _cu, _x); _pv = _cu; } } while (0)

__device__ __forceinline__ void phase_route_a_naive(int wv0, int l) {
    FRESH_PARAMS; FRESH_IDS;
    const bf16_t* qp = (const bf16_t*)(p.ws + WS_Z);
    const bf16_t* SK = (const bf16_t*)(p.ws + WS_SK) + (size_t)l * 2 * 128 * 128;
    float* tops = (float*)(p.ws + WS_Y);
    for (int idx = gtid; idx < T * 16; idx += gthreads) {
        const int t = idx % T, hc = idx / T, h = hc >> 1, c = hc & 1;
        float qf[128];
        { const u32x4* q4 = (const u32x4*)(qp + (size_t)t * NQ + h * 256 + c * 128);
#pragma unroll
          for (int i = 0; i < 16; ++i) unpack8(q4[i], qf + 8 * i); }
        float L[16];
#pragma unroll
        for (int m = 0; m < 16; ++m) L[m] = -3.0e38f;
#pragma unroll 1
        for (int k = 0; k < 128; ++k) {
            const u32x4* s4 = (const u32x4*)(SK + (size_t)(c * 128 + k) * 128);
            float sc = 0.f;
#pragma unroll
            for (int i = 0; i < 16; ++i) { float f[8]; unpack8(s4[i], f);
#pragma unroll
                for (int j = 0; j < 8; ++j) sc += f[j] * qf[8 * i + j]; }
            const float pkd = __uint_as_float((__float_as_uint(sc) & ~127u) | (unsigned)k);
            INS_PACKED(L, pkd);
        }
        float* o = tops + ((size_t)(t * 8 + h) * 2 + c) * 16;
#pragma unroll
        for (int m = 0; m < 16; ++m) o[m] = L[m];
    }
}

__device__ __forceinline__ void phase_route_b_naive(int wv0, int l) {
    FRESH_PARAMS; FRESH_IDS;
    const float* tops = (const float*)(p.ws + WS_Y);
    int* idxo = (int*)(p.ws + WS_IDX); float* gate = (float*)(p.ws + WS_GATE);
    for (int th = gtid; th < T * 8; th += gthreads) {
        const float* a = tops + (size_t)th * 32; const float* bq = a + 16;
        float L[16];
#pragma unroll
        for (int m = 0; m < 16; ++m) L[m] = -3.0e38f;
#pragma unroll 1
        for (int i = 0; i < 16; ++i) {
            const float sa = __uint_as_float(__float_as_uint(a[i]) & ~127u);
#pragma unroll 1
            for (int j = 0; j < 16; ++j) {
                const float sb = __uint_as_float(__float_as_uint(bq[j]) & ~127u);
                const float pkd = __uint_as_float((__float_as_uint(sa + sb) & ~255u) | (unsigned)(i * 16 + j));
                INS_PACKED(L, pkd);
            }
        }
        const float top0 = __uint_as_float(__float_as_uint(L[0]) & ~255u);
        float e[16], sum = 0.f;
#pragma unroll
        for (int m = 0; m < 16; ++m) { e[m] = __expf(__uint_as_float(__float_as_uint(L[m]) & ~255u) - top0); sum += e[m]; }
        const float inv = 1.f / sum;
#pragma unroll
        for (int m = 0; m < 16; ++m) {
            const unsigned pos = __float_as_uint(L[m]) & 255u;
            const int ia = (int)(__float_as_uint(a[pos >> 4]) & 127u), ib = (int)(__float_as_uint(bq[pos & 15u]) & 127u);
            idxo[(size_t)th * 16 + m] = ia * 128 + ib; gate[(size_t)th * 16 + m] = e[m] * inv;
        }
    }
}

#define CE_DESC(a, b) do { const float _hi = fmaxf((a), (b)); const float _lo = fminf((a), (b)); (a) = _hi; (b) = _lo; } while (0)
__device__ __forceinline__ void merge_halves_sorted(float (&L)[16]) {
    float M[16];
#pragma unroll
    for (int i = 0; i < 16; ++i) M[i] = __shfl_xor(L[15 - i], 32);
#pragma unroll
    for (int i = 0; i < 16; ++i) M[i] = fmaxf(L[i], M[i]);
#define BITONIC_STAGE(ST) _Pragma("unroll") for (int i = 0; i < 16; ++i) if ((i & (ST)) == 0) CE_DESC(M[i], M[i + (ST)]);
    BITONIC_STAGE(8) BITONIC_STAGE(4) BITONIC_STAGE(2) BITONIC_STAGE(1)
#undef BITONIC_STAGE
#pragma unroll
    for (int i = 0; i < 16; ++i) L[i] = M[i];
}

#define CE_ASC(a, b) do { const float _hi = fmaxf((a), (b)); const float _lo = fminf((a), (b)); (a) = _lo; (b) = _hi; } while (0)
__device__ __forceinline__ void sort16_desc(float (&a)[16]) {
    CE_DESC(a[0], a[13]); CE_DESC(a[1], a[12]); CE_DESC(a[2], a[15]); CE_DESC(a[3], a[14]); CE_DESC(a[4], a[8]); CE_DESC(a[5], a[6]); CE_DESC(a[7], a[11]); CE_DESC(a[9], a[10]);
    CE_DESC(a[0], a[5]); CE_DESC(a[1], a[7]); CE_DESC(a[2], a[9]); CE_DESC(a[3], a[4]); CE_DESC(a[6], a[13]); CE_DESC(a[8], a[14]); CE_DESC(a[10], a[15]); CE_DESC(a[11], a[12]);
    CE_DESC(a[0], a[1]); CE_DESC(a[2], a[3]); CE_DESC(a[4], a[5]); CE_DESC(a[6], a[8]); CE_DESC(a[7], a[9]); CE_DESC(a[10], a[11]); CE_DESC(a[12], a[13]); CE_DESC(a[14], a[15]);
    CE_DESC(a[0], a[2]); CE_DESC(a[1], a[3]); CE_DESC(a[4], a[10]); CE_DESC(a[5], a[11]); CE_DESC(a[6], a[7]); CE_DESC(a[8], a[9]); CE_DESC(a[12], a[14]); CE_DESC(a[13], a[15]);
    CE_DESC(a[1], a[2]); CE_DESC(a[3], a[12]); CE_DESC(a[4], a[6]); CE_DESC(a[5], a[7]); CE_DESC(a[8], a[10]); CE_DESC(a[9], a[11]); CE_DESC(a[13], a[14]); CE_DESC(a[1], a[4]);
    CE_DESC(a[2], a[6]); CE_DESC(a[5], a[8]); CE_DESC(a[7], a[10]); CE_DESC(a[9], a[13]); CE_DESC(a[11], a[14]); CE_DESC(a[2], a[4]); CE_DESC(a[3], a[6]); CE_DESC(a[9], a[12]);
    CE_DESC(a[11], a[13]); CE_DESC(a[3], a[5]); CE_DESC(a[6], a[8]); CE_DESC(a[7], a[9]); CE_DESC(a[10], a[12]); CE_DESC(a[3], a[4]); CE_DESC(a[5], a[6]); CE_DESC(a[7], a[8]);
    CE_DESC(a[9], a[10]); CE_DESC(a[11], a[12]); CE_DESC(a[6], a[7]); CE_DESC(a[8], a[9]);
}
__device__ __forceinline__ void merge16_desc(float (&L)[16], const float (&T)[16]) {
#pragma unroll
    for (int i = 0; i < 16; ++i) L[i] = fmaxf(L[i], T[15 - i]);
#define BM_STAGE(ST) _Pragma("unroll") for (int i = 0; i < 16; ++i) if ((i & (ST)) == 0) CE_DESC(L[i], L[i + (ST)]);
    BM_STAGE(8) BM_STAGE(4) BM_STAGE(2) BM_STAGE(1)
#undef BM_STAGE
}

__device__ __forceinline__ void route_load_q(const bf16_t* qp, int t0, int r, int hh, int hd, int c, bf16x8 (&qf)[8]) {
    const bf16_t* q8 = qp + (size_t)(t0 + r) * NQ + hd * 256 + c * 128 + 8 * hh;
#pragma unroll
    for (int ks = 0; ks < 8; ++ks) qf[ks] = __builtin_nontemporal_load((const bf16x8*)(q8 + 16 * ks));
}
__device__ __forceinline__ void route_half(const LAS unsigned char* lds, const bf16x8 (&qf)[8], int r, int hh, int c, float (&L)[16]) {
#pragma unroll
    for (int m = 0; m < 16; ++m) L[m] = -3.0e38f;
#pragma unroll 1
    for (int kt = 0; kt < 4; ++kt) {
        const int key = kt * 32 + r;
        const LAS unsigned char* krow = lds + (c * 128 + key) * 256;
        f32x16 S;
#pragma unroll
        for (int q = 0; q < 16; ++q) S[q] = 0.f;
#pragma unroll
        for (int ks = 0; ks < 8; ++ks) { const bf16x8 kf = *(const LAS bf16x8*)(krow + (((2 * ks + hh) ^ (key & 15)) << 4)); S = MFMA32(kf, qf[ks], S); }
        float Tt[16];
#pragma unroll
        for (int q = 0; q < 16; ++q) {
            const unsigned kidx = (unsigned)(kt * 32 + (q & 3) + 8 * (q >> 2) + 4 * hh);
            Tt[q] = __uint_as_float((__float_as_uint(S[q]) & ~127u) | kidx);
        }
        sort16_desc(Tt);
        if (kt == 0) {
#pragma unroll
            for (int m = 0; m < 16; ++m) L[m] = Tt[m];
        } else merge16_desc(L, Tt);
    }
    merge_halves_sorted(L);
}

constexpr int RT_SK_BYTES = 65536, RT_LANE_STRIDE = 33 * 4, RT_WAVE_BYTES = 64 * RT_LANE_STRIDE;
__device__ __forceinline__ void phase_route(int wv0, int l, LAS unsigned char* lds) {
    FRESH_PARAMS; FRESH_IDS;
    const bf16_t* qp = (const bf16_t*)(p.ws + WS_Z);
    const bf16_t* SK = (const bf16_t*)(p.ws + WS_SK) + (size_t)l * 2 * 128 * 128;
    int* idxo = (int*)(p.ws + WS_IDX); float* gate = (float*)(p.ws + WS_GATE);
    const int r = lane & 31, hh = lane >> 5;
    for (int i = tid; i < 4096; i += NTHREADS) {
        const int row = i >> 4, ch = i & 15;
        *(LAS u32x4*)(lds + row * 256 + ((ch ^ (row & 15)) << 4)) = *(const u32x4*)(SK + (size_t)i * 8);
    }
    __syncthreads();
    LAS float* mine = (LAS float*)(lds + RT_SK_BYTES + wave * RT_WAVE_BYTES + lane * RT_LANE_STRIDE);
#pragma unroll 1
    for (int u = gw; u < (T / 32) * 8; u += ngw) {
        const int t0 = (u >> 3) * 32, hd = u & 7;
        float LA[16], LB[16];
        { bf16x8 qa[8], qb[8];
          route_load_q(qp, t0, r, hh, hd, 0, qa); route_load_q(qp, t0, r, hh, hd, 1, qb);
          route_half(lds, qa, r, hh, 0, LA);
          route_half(lds, qb, r, hh, 1, LB); }
#pragma unroll
        for (int m = 0; m < 16; ++m) { mine[m] = LA[m]; mine[16 + m] = LB[m]; }
        float F[16];
#pragma unroll
        for (int m = 0; m < 16; ++m) F[m] = -3.0e38f;
#pragma unroll
        for (int i = 0; i < 16; ++i)
#pragma unroll
            for (int j = 0; j < 16; ++j)
                if ((i + 1) * (j + 1) <= 16) {
                    const float sm = LA[i] + LB[j];
                    const float pkd = __uint_as_float((__float_as_uint(sm) & ~255u) | (unsigned)(i * 16 + j));
                    INS_PACKED(F, pkd);
                }
        float e[16], sum = 0.f;
#pragma unroll
        for (int m = 0; m < 16; ++m) { e[m] = __expf(F[m] - F[0]); sum += e[m]; }
        const float inv = 1.f / sum;
        int io[8]; float go[8];
#pragma unroll
        for (int k = 0; k < 8; ++k) {
            float f_lo = F[k], f_hi = F[8 + k], e_lo = e[k], e_hi = e[8 + k];
            asm volatile("" : "+v"(f_lo), "+v"(f_hi), "+v"(e_lo), "+v"(e_hi));
            const float fv = hh ? f_hi : f_lo; const float ev = hh ? e_hi : e_lo;
            const unsigned pos = __float_as_uint(fv) & 255u;
            const unsigned ia = __float_as_uint(mine[pos >> 4]) & 127u, ib = __float_as_uint(mine[16 + (pos & 15u)]) & 127u;
            io[k] = (int)(ia * 128u + ib); go[k] = ev * inv;
        }
        const size_t ob = ((size_t)(t0 + r) * 8 + hd) * 16 + 8 * hh;
        *(u32x4*)(idxo + ob) = (u32x4){(unsigned)io[0], (unsigned)io[1], (unsigned)io[2], (unsigned)io[3]};
        *(u32x4*)(idxo + ob + 4) = (u32x4){(unsigned)io[4], (unsigned)io[5], (unsigned)io[6], (unsigned)io[7]};
        *(f32x4*)(gate + ob) = (f32x4){go[0], go[1], go[2], go[3]};
        *(f32x4*)(gate + ob + 4) = (f32x4){go[4], go[5], go[6], go[7]};
    }
}

__device__ __forceinline__ void phase_gather_naive(int wv0, int l) {
    FRESH_PARAMS; FRESH_IDS;
    const float* U = p.peer_u + (size_t)l * NEXP * DM; const float* V = p.peer_v + (size_t)l * NEXP * DM;
    const float* g2 = p.norm2_g + l * DM;
    const int* idxs = (const int*)(p.ws + WS_IDX); const float* gate = (const float*)(p.ws + WS_GATE);
    bf16_t* XN = (bf16_t*)(p.ws + WS_XN);
    for (int t = gw; t < T; t += ngw) {
        float* xrow = p.out + (size_t)t * DM;
        f32x4 xr[4], xn[4], acc[4]; float ss = 0.f;
#pragma unroll
        for (int j = 0; j < 4; ++j) { xr[j] = *(const f32x4*)(xrow + j * 256 + lane * 4); ss += (xr[j].x * xr[j].x + xr[j].y * xr[j].y) + (xr[j].z * xr[j].z + xr[j].w * xr[j].w); }
        const float rstd = rsqrtf(wave_sum(ss) * (1.f / DM) + EPS);
#pragma unroll
        for (int j = 0; j < 4; ++j) { const f32x4 g = *(const f32x4*)(g2 + j * 256 + lane * 4); xn[j] = xr[j] * rstd * g; acc[j] = (f32x4){0.f, 0.f, 0.f, 0.f}; }
#pragma unroll 1
        for (int r = 0; r < 128; ++r) {
            const int e = idxs[(size_t)t * 128 + r]; const float gt = gate[(size_t)t * 128 + r];
            const float* ur = U + (size_t)e * DM + lane * 4;
            float d = 0.f;
#pragma unroll
            for (int j = 0; j < 4; ++j) { const f32x4 uv = *(const f32x4*)(ur + j * 256); d += (uv.x * xn[j].x + uv.y * xn[j].y) + (uv.z * xn[j].z + uv.w * xn[j].w); }
            d = wave_sum(d);
            const float a = gt * 0.5f * d * (1.f + erff(d * 0.70710678118654752f));
            const float* vr = V + (size_t)e * DM + lane * 4;
#pragma unroll
            for (int j = 0; j < 4; ++j) { const f32x4 vv = *(const f32x4*)(vr + j * 256); acc[j] += vv * a; }
        }
        float s2 = 0.f;
#pragma unroll
        for (int j = 0; j < 4; ++j) { xr[j] += acc[j]; *(f32x4*)(xrow + j * 256 + lane * 4) = xr[j]; s2 += (xr[j].x * xr[j].x + xr[j].y * xr[j].y) + (xr[j].z * xr[j].z + xr[j].w * xr[j].w); }
        if (l + 1 < DEPTH) {
            const float r1 = rsqrtf(wave_sum(s2) * (1.f / DM) + EPS);
#pragma unroll
            for (int j = 0; j < 4; ++j) { u32x2 o; o.x = pk2(xr[j].x * r1, xr[j].y * r1); o.y = pk2(xr[j].z * r1, xr[j].w * r1); *(u32x2*)(XN + (size_t)t * DM + j * 256 + lane * 4) = o; }
        }
    }
}


__device__ __forceinline__ void phase_table_convert(int wv0, int l) {
    FRESH_PARAMS; FRESH_IDS;
    const f32x4* U = (const f32x4*)(p.peer_u + (size_t)l * NEXP * DM); const f32x4* V = (const f32x4*)(p.peer_v + (size_t)l * NEXP * DM);
    u32x4* PU = (u32x4*)(p.ws + WS_PU); u32x4* PV = (u32x4*)(p.ws + WS_PV);
#pragma unroll 2
    for (int i = gtid; i < NEXP * DM / 8; i += gthreads) {
        const f32x4 a0 = U[2 * i], a1 = U[2 * i + 1], b0 = V[2 * i], b1 = V[2 * i + 1];
        u32x4 o; o.x = pk2(a0.x, a0.y); o.y = pk2(a0.z, a0.w); o.z = pk2(a1.x, a1.y); o.w = pk2(a1.z, a1.w); PU[i] = o;
        u32x4 q; q.x = pk2(b0.x, b0.y); q.y = pk2(b0.z, b0.w); q.z = pk2(b1.x, b1.y); q.w = pk2(b1.z, b1.w); PV[i] = q;
    }
}

__device__ __forceinline__ void phase_gather(int wv0, int l) {
    FRESH_PARAMS; FRESH_IDS;
    const unsigned char* PU = p.ws + WS_PU; const unsigned char* PV = p.ws + WS_PV;
    const float* g2 = p.norm2_g + l * DM;
    const int* idxs = (const int*)(p.ws + WS_IDX); const float* gates = (const float*)(p.ws + WS_GATE);
    bf16_t* XN = (bf16_t*)(p.ws + WS_XN);
    const int g = lane >> 4, j = lane & 15;
#pragma unroll 1
    for (int t = gw; t < T; t += ngw) {
        float* xrow = p.out + (size_t)t * DM;
        unsigned xpk[8][4];
        {
            f32x4 xa[8][2]; float ss = 0.f;
#pragma unroll
            for (int c = 0; c < 8; ++c) {
                xa[c][0] = *(const f32x4*)(xrow + (j + 16 * c) * 8); xa[c][1] = *(const f32x4*)(xrow + (j + 16 * c) * 8 + 4);
                ss += (xa[c][0].x * xa[c][0].x + xa[c][0].y * xa[c][0].y) + (xa[c][0].z * xa[c][0].z + xa[c][0].w * xa[c][0].w);
                ss += (xa[c][1].x * xa[c][1].x + xa[c][1].y * xa[c][1].y) + (xa[c][1].z * xa[c][1].z + xa[c][1].w * xa[c][1].w);
            }
            ss += __shfl_xor(ss, 1); ss += __shfl_xor(ss, 2); ss += __shfl_xor(ss, 4); ss += __shfl_xor(ss, 8);
            const float rstd = rsqrtf(ss * (1.f / DM) + EPS);
#pragma unroll
            for (int c = 0; c < 8; ++c) {
                const f32x4 ga = *(const f32x4*)(g2 + (j + 16 * c) * 8), gb = *(const f32x4*)(g2 + (j + 16 * c) * 8 + 4);
                xpk[c][0] = pk2(xa[c][0].x * rstd * ga.x, xa[c][0].y * rstd * ga.y); xpk[c][1] = pk2(xa[c][0].z * rstd * ga.z, xa[c][0].w * rstd * ga.w);
                xpk[c][2] = pk2(xa[c][1].x * rstd * gb.x, xa[c][1].y * rstd * gb.y); xpk[c][3] = pk2(xa[c][1].z * rstd * gb.z, xa[c][1].w * rstd * gb.w);
            }
        }
        const int my_i0 = idxs[(size_t)t * 128 + 4 * j + g], my_i1 = idxs[(size_t)t * 128 + 4 * (j + 16) + g];
        const float my_g0 = gates[(size_t)t * 128 + 4 * j + g], my_g1 = gates[(size_t)t * 128 + 4 * (j + 16) + g];
        float acc[64];
#pragma unroll
        for (int q = 0; q < 64; ++q) acc[q] = 0.f;
#pragma unroll 1
        for (int i = 0; i < 32; ++i) {
            const int sel = (lane & 48) | (i & 15);
            const int e = __shfl(i < 16 ? my_i0 : my_i1, sel);
            const float gt = __shfl(i < 16 ? my_g0 : my_g1, sel);
            const unsigned char* ur = PU + (size_t)e * 2048 + j * 16; const unsigned char* vr = PV + (size_t)e * 2048 + j * 16;
            u32x4 ub[8], vb[8];
#pragma unroll
            for (int c = 0; c < 8; ++c) ub[c] = *(const u32x4*)(ur + c * 256);
#pragma unroll
            for (int c = 0; c < 8; ++c) vb[c] = *(const u32x4*)(vr + c * 256);
            float d = 0.f;
#pragma unroll
            for (int c = 0; c < 8; ++c) { d = dot2bf(ub[c].x, xpk[c][0], d); d = dot2bf(ub[c].y, xpk[c][1], d); d = dot2bf(ub[c].z, xpk[c][2], d); d = dot2bf(ub[c].w, xpk[c][3], d); }
            d += __shfl_xor(d, 1); d += __shfl_xor(d, 2); d += __shfl_xor(d, 4); d += __shfl_xor(d, 8);
            const float a = gt * 0.5f * d * (1.f + erff(d * 0.70710678118654752f));
#pragma unroll
            for (int c = 0; c < 8; ++c) { float f[8]; unpack8(vb[c], f);
#pragma unroll
                for (int q = 0; q < 8; ++q) acc[c * 8 + q] += a * f[q]; }
        }
        float s1[32];
#pragma unroll
        for (int q = 0; q < 32; ++q) { const float mine = (g & 2) ? acc[32 + q] : acc[q], send = (g & 2) ? acc[q] : acc[32 + q]; s1[q] = mine + __shfl_xor(send, 32); }
        float s2[16];
#pragma unroll
        for (int q = 0; q < 16; ++q) { const float mine = (g & 1) ? s1[16 + q] : s1[q], send = (g & 1) ? s1[q] : s1[16 + q]; s2[q] = mine + __shfl_xor(send, 16); }
        const int cc0 = 4 * (g >> 1) + 2 * (g & 1);
        f32x4 xo[2][2]; float sq = 0.f;
#pragma unroll
        for (int c = 0; c < 2; ++c) {
            float* px = xrow + (j + 16 * (cc0 + c)) * 8;
            xo[c][0] = *(const f32x4*)px; xo[c][1] = *(const f32x4*)(px + 4);
            xo[c][0] += (f32x4){s2[c * 8 + 0], s2[c * 8 + 1], s2[c * 8 + 2], s2[c * 8 + 3]}; xo[c][1] += (f32x4){s2[c * 8 + 4], s2[c * 8 + 5], s2[c * 8 + 6], s2[c * 8 + 7]};
            *(f32x4*)px = xo[c][0]; *(f32x4*)(px + 4) = xo[c][1];
            sq += (xo[c][0].x * xo[c][0].x + xo[c][0].y * xo[c][0].y) + (xo[c][0].z * xo[c][0].z + xo[c][0].w * xo[c][0].w);
            sq += (xo[c][1].x * xo[c][1].x + xo[c][1].y * xo[c][1].y) + (xo[c][1].z * xo[c][1].z + xo[c][1].w * xo[c][1].w);
        }
        if (l + 1 < DEPTH) {
            const float r1 = rsqrtf(wave_sum(sq) * (1.f / DM) + EPS);
#pragma unroll
            for (int c = 0; c < 2; ++c) { u32x4 o; o.x = pk2(xo[c][0].x * r1, xo[c][0].y * r1); o.y = pk2(xo[c][0].z * r1, xo[c][0].w * r1); o.z = pk2(xo[c][1].x * r1, xo[c][1].y * r1); o.w = pk2(xo[c][1].z * r1, xo[c][1].w * r1);
                *(u32x4*)(XN + (size_t)t * DM + (j + 16 * (cc0 + c)) * 8) = o; }
        }
    }
}

__device__ __forceinline__ void phase_table_fp8(int wv0) {
    FRESH_PARAMS; FRESH_IDS;
    unsigned char* P8 = p.ws + WS_P8; float* SCL = (float*)(p.ws + WS_SCL);
#pragma unroll 1
    for (int row = gw; row < DEPTH * 2 * NEXP; row += ngw) {
        const int ti = row / NEXP, e = row % NEXP, l = ti >> 1;
        const float* src = ((ti & 1) ? p.peer_v : p.peer_u) + ((size_t)l * NEXP + e) * DM + lane * 16;
        f32x4 v[4]; float am = 0.f;
#pragma unroll
        for (int q = 0; q < 4; ++q) { v[q] = *(const f32x4*)(src + 4 * q); am = fmaxf(am, fmaxf(fmaxf(fabsf(v[q].x), fabsf(v[q].y)), fmaxf(fabsf(v[q].z), fabsf(v[q].w)))); }
        am = fmaxf(wave_max(am), 1e-30f);
        const float sc = 440.f / am;
        u32x4 o;
        { int w = 0; w = __builtin_amdgcn_cvt_pk_fp8_f32(v[0].x * sc, v[0].y * sc, w, false); w = __builtin_amdgcn_cvt_pk_fp8_f32(v[0].z * sc, v[0].w * sc, w, true); o.x = (unsigned)w; }
        { int w = 0; w = __builtin_amdgcn_cvt_pk_fp8_f32(v[1].x * sc, v[1].y * sc, w, false); w = __builtin_amdgcn_cvt_pk_fp8_f32(v[1].z * sc, v[1].w * sc, w, true); o.y = (unsigned)w; }
        { int w = 0; w = __builtin_amdgcn_cvt_pk_fp8_f32(v[2].x * sc, v[2].y * sc, w, false); w = __builtin_amdgcn_cvt_pk_fp8_f32(v[2].z * sc, v[2].w * sc, w, true); o.z = (unsigned)w; }
        { int w = 0; w = __builtin_amdgcn_cvt_pk_fp8_f32(v[3].x * sc, v[3].y * sc, w, false); w = __builtin_amdgcn_cvt_pk_fp8_f32(v[3].z * sc, v[3].w * sc, w, true); o.w = (unsigned)w; }
        *(u32x4*)(P8 + (size_t)row * 1024 + lane * 16) = o;
        if (lane == 0) SCL[row] = am * (1.f / 440.f);
    }
}

__device__ __forceinline__ void phase_gather8(int wv0, int l) {
    FRESH_PARAMS; FRESH_IDS;
    const unsigned char* PU = p.ws + WS_P8 + (size_t)(2 * l) * NEXP * 1024; const unsigned char* PV = PU + (size_t)NEXP * 1024;
    const float* SU = (const float*)(p.ws + WS_SCL) + (size_t)(2 * l) * NEXP; const float* SV = SU + NEXP;
    const float* g2 = p.norm2_g + l * DM;
    const int* idxs = (const int*)(p.ws + WS_IDX); const float* gates = (const float*)(p.ws + WS_GATE);
    bf16_t* XN = (bf16_t*)(p.ws + WS_XN);
    const int g = lane >> 4, j = lane & 15;
#pragma unroll 1
    for (int t = gw; t < T; t += ngw) {
        float* xrow = p.out + (size_t)t * DM;
        unsigned xp[4][8];
        {
            f32x4 xa[4][4]; float ss = 0.f;
#pragma unroll
            for (int c = 0; c < 4; ++c)
#pragma unroll
                for (int q = 0; q < 4; ++q) { const f32x4 a = *(const f32x4*)(xrow + 16 * (j + 16 * c) + 4 * q); xa[c][q] = a; ss += (a.x * a.x + a.y * a.y) + (a.z * a.z + a.w * a.w); }
            ss += __shfl_xor(ss, 1); ss += __shfl_xor(ss, 2); ss += __shfl_xor(ss, 4); ss += __shfl_xor(ss, 8);
            const float rstd = rsqrtf(ss * (1.f / DM) + EPS);
#pragma unroll
            for (int c = 0; c < 4; ++c)
#pragma unroll
                for (int q = 0; q < 4; ++q) { const f32x4 ga = *(const f32x4*)(g2 + 16 * (j + 16 * c) + 4 * q); const f32x4 a = xa[c][q];
                    xp[c][2 * q] = pk2(a.x * ga.x * rstd, a.y * ga.y * rstd); xp[c][2 * q + 1] = pk2(a.z * ga.z * rstd, a.w * ga.w * rstd); }
        }
        const int my_i0 = idxs[(size_t)t * 128 + 4 * j + g], my_i1 = idxs[(size_t)t * 128 + 4 * (j + 16) + g];
        const float my_g0 = gates[(size_t)t * 128 + 4 * j + g], my_g1 = gates[(size_t)t * 128 + 4 * (j + 16) + g];
        f32x2 acc[4][8];
#pragma unroll
        for (int c = 0; c < 4; ++c)
#pragma unroll
            for (int q = 0; q < 8; ++q) acc[c][q] = (f32x2){0.f, 0.f};
        u32x4 ubA[4], vbA[4], ubB[4], vbB[4]; float usA, vsA, gtA, usB, vsB, gtB;
#define G8_LOAD(UB, VB, US, VS, GT, i) do { const int _sel = (lane & 48) | ((i) & 15); const int _e = __shfl((i) < 16 ? my_i0 : my_i1, _sel); GT = __shfl((i) < 16 ? my_g0 : my_g1, _sel); \
        US = SU[_e]; VS = SV[_e]; const unsigned char* _ur = PU + (size_t)_e * 1024 + j * 16; const unsigned char* _vr = PV + (size_t)_e * 1024 + j * 16; \
        _Pragma("unroll") for (int _c = 0; _c < 4; ++_c) UB[_c] = *(const u32x4*)(_ur + _c * 256); \
        _Pragma("unroll") for (int _c = 0; _c < 4; ++_c) VB[_c] = *(const u32x4*)(_vr + _c * 256); } while (0)
#define G8_XF(P) ((f32x2){__uint_as_float((P) << 16), __uint_as_float((P) & 0xffff0000u)})
#define G8_DOT1(W, X0, X1) do { d2 = __builtin_amdgcn_cvt_pk_f32_fp8((int)(W), false) * G8_XF(X0) + d2; d2 = __builtin_amdgcn_cvt_pk_f32_fp8((int)(W), true) * G8_XF(X1) + d2; } while (0)
#define G8_AXPY1(W, A0, A1) do { A0 = __builtin_amdgcn_cvt_pk_f32_fp8((int)(W), false) * a2 + A0; A1 = __builtin_amdgcn_cvt_pk_f32_fp8((int)(W), true) * a2 + A1; } while (0)
#define G8_COMPUTE(UB, VB, US, VS, GT) do { f32x2 d2 = (f32x2){0.f, 0.f}; \
        _Pragma("unroll") for (int _c = 0; _c < 4; ++_c) { G8_DOT1(UB[_c].x, xp[_c][0], xp[_c][1]); G8_DOT1(UB[_c].y, xp[_c][2], xp[_c][3]); G8_DOT1(UB[_c].z, xp[_c][4], xp[_c][5]); G8_DOT1(UB[_c].w, xp[_c][6], xp[_c][7]); } \
        float _d = d2.x + d2.y; _d += __shfl_xor(_d, 1); _d += __shfl_xor(_d, 2); _d += __shfl_xor(_d, 4); _d += __shfl_xor(_d, 8); _d *= US; \
        const float _a = GT * 0.5f * _d * (1.f + erff(_d * 0.70710678118654752f)) * VS; const f32x2 a2 = (f32x2){_a, _a}; \
        _Pragma("unroll") for (int _c = 0; _c < 4; ++_c) { G8_AXPY1(VB[_c].x, acc[_c][0], acc[_c][1]); G8_AXPY1(VB[_c].y, acc[_c][2], acc[_c][3]); G8_AXPY1(VB[_c].z, acc[_c][4], acc[_c][5]); G8_AXPY1(VB[_c].w, acc[_c][6], acc[_c][7]); } } while (0)
        G8_LOAD(ubA, vbA, usA, vsA, gtA, 0);
#pragma unroll 1
        for (int i = 0; i < 32; i += 2) {
            G8_LOAD(ubB, vbB, usB, vsB, gtB, i + 1);
            G8_COMPUTE(ubA, vbA, usA, vsA, gtA);
            if (i + 2 < 32) G8_LOAD(ubA, vbA, usA, vsA, gtA, i + 2);
            G8_COMPUTE(ubB, vbB, usB, vsB, gtB);
        }
#undef G8_LOAD
#undef G8_XF
#undef G8_DOT1
#undef G8_AXPY1
#undef G8_COMPUTE
        float s1[32];
#pragma unroll
        for (int q = 0; q < 16; ++q) {
            const f32x2 lo = acc[q >> 3][q & 7], hi = acc[2 + (q >> 3)][q & 7];
            const f32x2 mine = (g & 2) ? hi : lo, send = (g & 2) ? lo : hi;
            s1[2 * q] = mine.x + __shfl_xor(send.x, 32); s1[2 * q + 1] = mine.y + __shfl_xor(send.y, 32);
        }
        float s2[16];
#pragma unroll
        for (int q = 0; q < 16; ++q) { const float mine = (g & 1) ? s1[16 + q] : s1[q], send = (g & 1) ? s1[q] : s1[16 + q]; s2[q] = mine + __shfl_xor(send, 16); }
        float* px = xrow + 16 * (j + 16 * g);
        f32x4 xo[4]; float sq = 0.f;
#pragma unroll
        for (int q = 0; q < 4; ++q) { xo[q] = *(const f32x4*)(px + 4 * q); xo[q] += (f32x4){s2[4 * q], s2[4 * q + 1], s2[4 * q + 2], s2[4 * q + 3]}; *(f32x4*)(px + 4 * q) = xo[q];
            sq += (xo[q].x * xo[q].x + xo[q].y * xo[q].y) + (xo[q].z * xo[q].z + xo[q].w * xo[q].w); }
        if (l + 1 < DEPTH) {
            const float r1 = rsqrtf(wave_sum(sq) * (1.f / DM) + EPS);
            u32x4 o0, o1;
            o0.x = pk2(xo[0].x * r1, xo[0].y * r1); o0.y = pk2(xo[0].z * r1, xo[0].w * r1); o0.z = pk2(xo[1].x * r1, xo[1].y * r1); o0.w = pk2(xo[1].z * r1, xo[1].w * r1);
            o1.x = pk2(xo[2].x * r1, xo[2].y * r1); o1.y = pk2(xo[2].z * r1, xo[2].w * r1); o1.z = pk2(xo[3].x * r1, xo[3].y * r1); o1.w = pk2(xo[3].z * r1, xo[3].w * r1);
            u32x4* po = (u32x4*)(XN + (size_t)t * DM + 16 * (j + 16 * g));
            po[0] = o0; po[1] = o1;
        }
    }
}

__host__ __device__ constexpr int cand_i_of(int c) { int n = 0; for (int i = 0; i < 16; ++i) for (int j = 0; j < 16; ++j) if ((i + 1) * (j + 1) <= 16) { if (n == c) return i; ++n; } return 0; }
__host__ __device__ constexpr int cand_j_of(int c) { int n = 0; for (int i = 0; i < 16; ++i) for (int j = 0; j < 16; ++j) if ((i + 1) * (j + 1) <= 16) { if (n == c) return j; ++n; } return 0; }
__device__ __forceinline__ void route_unit(const LAS unsigned char* lds, LAS float* mine, const bf16_t* qp, int* idxo, float* sco, int t0, int hd, int r, int hh) {
    float LA[16], LB[16];
    { bf16x8 qa[8], qb[8];
      route_load_q(qp, t0, r, hh, hd, 0, qa); route_load_q(qp, t0, r, hh, hd, 1, qb);
      route_half(lds, qa, r, hh, 0, LA);
      route_half(lds, qb, r, hh, 1, LB); }
#pragma unroll
    for (int m = 0; m < 16; ++m) { mine[m] = LA[m]; mine[16 + m] = LB[m]; }
    float F[16];
#pragma unroll
    for (int m = 0; m < 16; ++m) F[m] = -3.0e38f;
    {
        constexpr int NC = 50;
#define CAND_I(c) cand_i_of(c)
#pragma unroll
        for (int c = 0; c < NC; c += 2) {
            const int i0 = cand_i_of(c), j0 = cand_j_of(c), i1 = cand_i_of(c + 1), j1 = cand_j_of(c + 1);
            float a_lo = LA[i0], a_hi = LA[i1], b_lo = LB[j0], b_hi = LB[j1];
            const float sm = (hh ? a_hi : a_lo) + (hh ? b_hi : b_lo);
            const unsigned pos = hh ? (unsigned)(i1 * 16 + j1) : (unsigned)(i0 * 16 + j0);
            const float pkd = __uint_as_float((__float_as_uint(sm) & ~255u) | pos);
            INS_MED3(F, pkd);
        }
#undef CAND_I
    }
    merge_halves_sorted(F);
    int io[8]; float so[8];
#pragma unroll
    for (int k = 0; k < 8; ++k) {
        float f_lo = F[k], f_hi = F[8 + k];
        asm volatile("" : "+v"(f_lo), "+v"(f_hi));
        const float fv = hh ? f_hi : f_lo;
        const unsigned pos = __float_as_uint(fv) & 255u;
        const unsigned ia = __float_as_uint(mine[pos >> 4]) & 127u, ib = __float_as_uint(mine[16 + (pos & 15u)]) & 127u;
        io[k] = (int)(ia * 128u + ib); so[k] = __uint_as_float(__float_as_uint(fv) & ~255u);
    }
    const size_t ob = ((size_t)(t0 + r) * 8 + hd) * 16 + 8 * hh;
    *(u32x4*)(idxo + ob) = (u32x4){(unsigned)io[0], (unsigned)io[1], (unsigned)io[2], (unsigned)io[3]};
    *(u32x4*)(idxo + ob + 4) = (u32x4){(unsigned)io[4], (unsigned)io[5], (unsigned)io[6], (unsigned)io[7]};
    *(f32x4*)(sco + ob) = (f32x4){so[0], so[1], so[2], so[3]};
    *(f32x4*)(sco + ob + 4) = (f32x4){so[4], so[5], so[6], so[7]};
}

template <bool DRY>
__device__ __forceinline__ void gather_token8(int l, int t, float* out, const float* g2w, const unsigned char* PU, const unsigned char* PV, const float* SU, const float* SV,
                                              const int* idxs, const float* scos, bf16_t* XN, int lane) {
    const int gg = lane >> 5, j = lane & 31;
    float* xrow = out + (size_t)t * DM;
    unsigned xp[2][8];
    float rstd;
    {
        f32x4 xa[2][4]; float ss = 0.f;
#pragma unroll
        for (int c = 0; c < 2; ++c)
#pragma unroll
            for (int q = 0; q < 4; ++q) { const f32x4 a = *(const f32x4*)(xrow + 16 * (j + 32 * c) + 4 * q); xa[c][q] = a; ss += (a.x * a.x + a.y * a.y) + (a.z * a.z + a.w * a.w); }
        ss += __shfl_xor(ss, 1); ss += __shfl_xor(ss, 2); ss += __shfl_xor(ss, 4); ss += __shfl_xor(ss, 8); ss += __shfl_xor(ss, 16);
        rstd = rsqrtf(ss * (1.f / DM) + EPS);
#pragma unroll
        for (int c = 0; c < 2; ++c)
#pragma unroll
            for (int q = 0; q < 4; ++q) { const f32x4 ga = *(const f32x4*)(g2w + 16 * (j + 32 * c) + 4 * q); const f32x4 a = xa[c][q];
                xp[c][2 * q] = pk2(a.x * ga.x * rstd, a.y * ga.y * rstd); xp[c][2 * q + 1] = pk2(a.z * ga.z * rstd, a.w * ga.w * rstd); }
    }
    const int my_i0 = idxs[(size_t)t * 128 + 2 * j + gg], my_i1 = idxs[(size_t)t * 128 + 2 * (j + 32) + gg];
    float my_g0, my_g1;
    {
        const float s0 = scos[(size_t)t * 128 + 2 * j + gg], s1 = scos[(size_t)t * 128 + 2 * (j + 32) + gg];
        const int src = lane & 24;
        const float m0 = __shfl(s0, src), m1 = __shfl(s1, src);
        const float e0 = __expf((s0 - m0) * rstd), e1 = __expf((s1 - m1) * rstd);
        float z0 = e0, z1 = e1;
        z0 += __shfl_xor(z0, 1); z0 += __shfl_xor(z0, 2); z0 += __shfl_xor(z0, 4); z0 += __shfl_xor(z0, 32);
        z1 += __shfl_xor(z1, 1); z1 += __shfl_xor(z1, 2); z1 += __shfl_xor(z1, 4); z1 += __shfl_xor(z1, 32);
        my_g0 = e0 / z0; my_g1 = e1 / z1;
    }
    f32x2 acc[2][8];
#pragma unroll
    for (int c = 0; c < 2; ++c)
#pragma unroll
        for (int q = 0; q < 8; ++q) acc[c][q] = (f32x2){0.f, 0.f};
    struct Stage { u32x4 u0, u1, v0, v1; float us, vs, gt; };
    Stage S0, S1, S2, S3;
#define G8_LOAD(S, i) do { const int _sel = (lane & 32) | ((i) & 31); const int _e = __shfl((i) < 32 ? my_i0 : my_i1, _sel); S.gt = __shfl((i) < 32 ? my_g0 : my_g1, _sel); \
        S.us = SU[_e]; S.vs = SV[_e]; const unsigned char* _ur = PU + (size_t)_e * 1024 + j * 16; const unsigned char* _vr = PV + (size_t)_e * 1024 + j * 16; \
        S.u0 = *(const u32x4*)_ur; S.u1 = *(const u32x4*)(_ur + 512); S.v0 = *(const u32x4*)_vr; S.v1 = *(const u32x4*)(_vr + 512); } while (0)
#define G8_XF(P) ((f32x2){__uint_as_float((P) << 16), __uint_as_float((P) & 0xffff0000u)})
#define G8_DOT1(W, X0, X1) do { d2 = __builtin_amdgcn_cvt_pk_f32_fp8((int)(W), false) * G8_XF(X0) + d2; d2 = __builtin_amdgcn_cvt_pk_f32_fp8((int)(W), true) * G8_XF(X1) + d2; } while (0)
#define G8_AXPY1(W, A0, A1) do { A0 = __builtin_amdgcn_cvt_pk_f32_fp8((int)(W), false) * a2 + A0; A1 = __builtin_amdgcn_cvt_pk_f32_fp8((int)(W), true) * a2 + A1; } while (0)
#define G8_COMPUTE(S) do { f32x2 d2 = (f32x2){0.f, 0.f}; \
        G8_DOT1(S.u0.x, xp[0][0], xp[0][1]); G8_DOT1(S.u0.y, xp[0][2], xp[0][3]); G8_DOT1(S.u0.z, xp[0][4], xp[0][5]); G8_DOT1(S.u0.w, xp[0][6], xp[0][7]); \
        G8_DOT1(S.u1.x, xp[1][0], xp[1][1]); G8_DOT1(S.u1.y, xp[1][2], xp[1][3]); G8_DOT1(S.u1.z, xp[1][4], xp[1][5]); G8_DOT1(S.u1.w, xp[1][6], xp[1][7]); \
        float _d = d2.x + d2.y; _d += __shfl_xor(_d, 1); _d += __shfl_xor(_d, 2); _d += __shfl_xor(_d, 4); _d += __shfl_xor(_d, 8); _d += __shfl_xor(_d, 16); _d *= S.us; \
        const float _a = S.gt * 0.5f * _d * (1.f + erff(_d * 0.70710678118654752f)) * S.vs; const f32x2 a2 = (f32x2){_a, _a}; \
        G8_AXPY1(S.v0.x, acc[0][0], acc[0][1]); G8_AXPY1(S.v0.y, acc[0][2], acc[0][3]); G8_AXPY1(S.v0.z, acc[0][4], acc[0][5]); G8_AXPY1(S.v0.w, acc[0][6], acc[0][7]); \
        G8_AXPY1(S.v1.x, acc[1][0], acc[1][1]); G8_AXPY1(S.v1.y, acc[1][2], acc[1][3]); G8_AXPY1(S.v1.z, acc[1][4], acc[1][5]); G8_AXPY1(S.v1.w, acc[1][6], acc[1][7]); } while (0)
    G8_LOAD(S0, 0); G8_LOAD(S1, 1); G8_LOAD(S2, 2);
#pragma unroll 1
    for (int i = 0; i < 64; i += 4) {
        G8_LOAD(S3, i + 3); G8_COMPUTE(S0);
        if (i + 4 < 64) G8_LOAD(S0, i + 4);
        G8_COMPUTE(S1);
        if (i + 4 < 64) G8_LOAD(S1, i + 5);
        G8_COMPUTE(S2);
        if (i + 4 < 64) G8_LOAD(S2, i + 6);
        G8_COMPUTE(S3);
    }
#undef G8_LOAD
#undef G8_XF
#undef G8_DOT1
#undef G8_AXPY1
#undef G8_COMPUTE
    float s2[16];
#pragma unroll
    for (int q = 0; q < 8; ++q) {
        const f32x2 mine2 = gg ? acc[1][q] : acc[0][q], send = gg ? acc[0][q] : acc[1][q];
        s2[2 * q] = mine2.x + __shfl_xor(send.x, 32); s2[2 * q + 1] = mine2.y + __shfl_xor(send.y, 32);
    }
    float* px = xrow + 16 * (j + 32 * gg);
    f32x4 xo[4]; float sq = 0.f;
#pragma unroll
    for (int q = 0; q < 4; ++q) { xo[q] = *(const f32x4*)(px + 4 * q); xo[q] += (f32x4){s2[4 * q], s2[4 * q + 1], s2[4 * q + 2], s2[4 * q + 3]}; if (!DRY || xo[q].x == 1.2345e-30f) *(f32x4*)(px + 4 * q) = xo[q];
        sq += (xo[q].x * xo[q].x + xo[q].y * xo[q].y) + (xo[q].z * xo[q].z + xo[q].w * xo[q].w); }
    if (!DRY && l + 1 < DEPTH) {
        const float r1 = rsqrtf(wave_sum(sq) * (1.f / DM) + EPS);
        u32x4 o0, o1;
        o0.x = pk2(xo[0].x * r1, xo[0].y * r1); o0.y = pk2(xo[0].z * r1, xo[0].w * r1); o0.z = pk2(xo[1].x * r1, xo[1].y * r1); o0.w = pk2(xo[1].z * r1, xo[1].w * r1);
        o1.x = pk2(xo[2].x * r1, xo[2].y * r1); o1.y = pk2(xo[2].z * r1, xo[2].w * r1); o1.z = pk2(xo[3].x * r1, xo[3].y * r1); o1.w = pk2(xo[3].z * r1, xo[3].w * r1);
        u32x4* po = (u32x4*)(XN + (size_t)t * DM + 16 * (j + 32 * gg));
        po[0] = o0; po[1] = o1;
    }
}

#define DPP_ROR_ADD(v, N) do { const int _iv = __builtin_bit_cast(int, (v)); const int _r = __builtin_amdgcn_update_dpp(_iv, _iv, 0x120 + (N), 0xf, 0xf, false); (v) += __builtin_bit_cast(float, _r); } while (0)
__device__ __forceinline__ float sum32(float v) {
    DPP_ROR_ADD(v, 8); DPP_ROR_ADD(v, 4); DPP_ROR_ADD(v, 2); DPP_ROR_ADD(v, 1);
    const int sw = __builtin_amdgcn_ds_swizzle(__builtin_bit_cast(int, v), 0x401F);
    return v + __builtin_bit_cast(float, sw);
}
__device__ __forceinline__ float gelu_fast(float v) {
    const float av = fabsf(v), t = __builtin_amdgcn_rcpf(av * 0.2316418882f + 1.0f);
    float q = t * 0.5307027145f + (-0.7265760135f); q = q * t + 0.7107068705f; q = q * t + (-0.142248368f); q = q * t + 0.127414796f; q = q * t;
    const float e = __builtin_amdgcn_exp2f((v * v) * (-0.72134752044f));
    const float m = v * (q * e);
    return v < 0.f ? m : v - m;
}

#ifndef F4_ROWSCALE
#define F4_ROWSCALE 1
#endif
constexpr int F4_ROW = F4_ROWSCALE ? 512 : 576;
#ifndef F4_STAGES
#define F4_STAGES 4
#endif
__device__ __forceinline__ void phase_table_fp4(int wv0) {
    FRESH_PARAMS; FRESH_IDS;
    unsigned char* P4 = p.ws + WS_P8;
    constexpr int NTR = DEPTH * 2 * NEXP, TB = 4;
#pragma unroll 1
    for (int row0 = TB * gw; row0 < NTR; row0 += TB * ngw) {
      f32x4 vb[TB][4];
      {
          const int tib = row0 / NEXP, eb = row0 % NEXP, lb = tib >> 1;
          const float* srcb = ((tib & 1) ? p.peer_v : p.peer_u) + ((size_t)lb * NEXP + eb) * DM + lane * 16;
#pragma unroll
          for (int bi = 0; bi < TB; ++bi)
#pragma unroll
              for (int q = 0; q < 4; ++q) vb[bi][q] = __builtin_nontemporal_load((const f32x4*)(srcb + (size_t)bi * DM + 4 * q));
      }
#pragma unroll
      for (int bi = 0; bi < TB; ++bi) {
        const int row = row0 + bi;
        const int ti = row / NEXP, e = row % NEXP, l = ti >> 1;
        f32x4 v[4]; float am = 0.f;
#pragma unroll
        for (int q = 0; q < 4; ++q) { v[q] = vb[bi][q]; am = fmaxf(am, fmaxf(fmaxf(fabsf(v[q].x), fabsf(v[q].y)), fmaxf(fabsf(v[q].z), fabsf(v[q].w)))); }
#if USE_I3U
        if ((ti & 1) == 0) {
            float sq = 0.f;
#pragma unroll
            for (int q = 0; q < 4; ++q) sq += (v[q].x * v[q].x + v[q].y * v[q].y) + (v[q].z * v[q].z + v[q].w * v[q].w);
            const float rms = sqrtf(wave_sum(sq) * (1.f / DM));
            const float su = fmaxf(rms * (2.0f / 3.5f), 1e-30f), iq = 1.f / su;
            unsigned lo8 = 0u, hi8 = 0u; int qs = 0;
#pragma unroll
            for (int q = 0; q < 4; ++q)
#pragma unroll
                for (int c4 = 0; c4 < 4; ++c4) { const int qv = (int)fminf(fmaxf(floorf(v[q][c4] * iq) + 4.f, 0.f), 7.f); qs += qv;
                    if (q < 2) lo8 |= (unsigned)qv << (4 * (4 * q + c4)); else hi8 |= (unsigned)qv << (4 * (4 * (q - 2) + c4)); }
            const float qsum = wave_sum((float)qs);
            const unsigned s0 = (hi8 & 0x11111111u) << 3, s1 = (hi8 & 0x22222222u) << 2, s2 = (hi8 & 0x44444444u) << 1;
            const unsigned r0 = (unsigned)__shfl_xor((int)s0, 1), r1 = (unsigned)__shfl_xor((int)s1, 1);
            unsigned char* dst = P4 + (size_t)ti * NEXP * F4_ROW + (size_t)e * 384 + (lane >> 1) * 12;
            if ((lane & 1) == 0) { *(unsigned*)dst = lo8 | r0; *(unsigned*)(dst + 4) = hi8 | r1; }
            else *(unsigned*)(dst + 8) = lo8 | s2;
            if (lane == 0) ((f32x2*)(p.ws + WS_SUQ))[(size_t)l * NEXP + e] = (f32x2){su, su * qsum * 0.25f};
            continue;
        }
#elif USE_I4U
        if ((ti & 1) == 0) {
            float sq = 0.f;
#pragma unroll
            for (int q = 0; q < 4; ++q) sq += (v[q].x * v[q].x + v[q].y * v[q].y) + (v[q].z * v[q].z + v[q].w * v[q].w);
            const float rms = sqrtf(wave_sum(sq) * (1.f / DM));
            const float su = fmaxf(rms * (2.4f / 7.f), 1e-30f), iq = 1.f / su;
            unsigned wq0 = 0u, wq1 = 0u; int qs = 0;
#pragma unroll
            for (int q = 0; q < 4; ++q)
#pragma unroll
                for (int c4 = 0; c4 < 4; ++c4) { const int qv = (int)__builtin_rintf(fminf(fmaxf(v[q][c4] * iq, -7.f), 7.f)); qs += qv;
                    if (q < 2) wq0 |= ((unsigned)qv & 0xfu) << (4 * (4 * q + c4)); else wq1 |= ((unsigned)qv & 0xfu) << (4 * (4 * (q - 2) + c4)); }
            const float qsum = wave_sum((float)qs);
            *(u32x2*)(P4 + (size_t)row * F4_ROW + lane * 8) = (u32x2){wq0, wq1};
            if (lane == 0) ((f32x2*)(p.ws + WS_SUQ))[(size_t)l * NEXP + e] = (f32x2){su, su * qsum * 0.25f};
            continue;
        }
#endif
#if F4_ROWSCALE
        am = wave_max(am);
        const float rsc = fmaxf(am * (1.f / 6.f), 1e-30f);
        const unsigned sb = 0u; const float inv = 1.f / rsc;
        if (lane == 0) ((float*)(p.ws + WS_SCL))[row] = rsc;
#else
        am = fmaxf(am, __shfl_xor(am, 1));
        const unsigned sb = f2bf(fmaxf(am * (1.f / 6.f), 1e-30f));
        const float inv = 1.f / bf2f(sb);
#endif
        unsigned w0 = 0u, w1 = 0u;
        w0 = __builtin_amdgcn_cvt_scalef32_pk_fp4_f32(w0, v[0].x * inv, v[0].y * inv, 1.0f, 0); w0 = __builtin_amdgcn_cvt_scalef32_pk_fp4_f32(w0, v[0].z * inv, v[0].w * inv, 1.0f, 1);
        w0 = __builtin_amdgcn_cvt_scalef32_pk_fp4_f32(w0, v[1].x * inv, v[1].y * inv, 1.0f, 2); w0 = __builtin_amdgcn_cvt_scalef32_pk_fp4_f32(w0, v[1].z * inv, v[1].w * inv, 1.0f, 3);
        w1 = __builtin_amdgcn_cvt_scalef32_pk_fp4_f32(w1, v[2].x * inv, v[2].y * inv, 1.0f, 0); w1 = __builtin_amdgcn_cvt_scalef32_pk_fp4_f32(w1, v[2].z * inv, v[2].w * inv, 1.0f, 1);
        w1 = __builtin_amdgcn_cvt_scalef32_pk_fp4_f32(w1, v[3].x * inv, v[3].y * inv, 1.0f, 2); w1 = __builtin_amdgcn_cvt_scalef32_pk_fp4_f32(w1, v[3].z * inv, v[3].w * inv, 1.0f, 3);
        unsigned char* dst = P4 + (size_t)row * F4_ROW;
        *(u32x2*)(dst + lane * 8) = (u32x2){w0, w1};
        if (!F4_ROWSCALE && (lane & 1) == 0) *(bf16_t*)(dst + 512 + lane) = (bf16_t)sb;
      }
    }
}

template <bool DRY>
__device__ __forceinline__ void gather_token4(int l, int t, float* out, const float* g2w, const unsigned char* PU, const unsigned char* PV,
                                              const int* idxs, const float* scos, bf16_t* XN, int lane) {
    const int gg = lane >> 5, j = lane & 31;
    float* xrow = out + (size_t)t * DM;
    f32x2 xv[16];
    float rstd;
    {
        f32x4 xa[8]; float ss = 0.f;
#pragma unroll
        for (int q = 0; q < 8; ++q) { const f32x4 a = *(const f32x4*)(xrow + 32 * j + 4 * q); xa[q] = a; ss += (a.x * a.x + a.y * a.y) + (a.z * a.z + a.w * a.w); }
        ss += __shfl_xor(ss, 1); ss += __shfl_xor(ss, 2); ss += __shfl_xor(ss, 4); ss += __shfl_xor(ss, 8); ss += __shfl_xor(ss, 16);
        rstd = rsqrtf(ss * (1.f / DM) + EPS);
#pragma unroll
        for (int q = 0; q < 8; ++q) { const f32x4 ga = *(const f32x4*)(g2w + 32 * j + 4 * q); const f32x4 a = xa[q];
            xv[2 * q] = (f32x2){bf2f(f2bf(a.x * ga.x * rstd)), bf2f(f2bf(a.y * ga.y * rstd))}; xv[2 * q + 1] = (f32x2){bf2f(f2bf(a.z * ga.z * rstd)), bf2f(f2bf(a.w * ga.w * rstd))}; }
    }
    const int my_i0 = idxs[(size_t)t * 128 + 2 * j + gg], my_i1 = idxs[(size_t)t * 128 + 2 * (j + 32) + gg];
    float my_g0, my_g1;
    {
        const float s0 = scos[(size_t)t * 128 + 2 * j + gg], s1 = scos[(size_t)t * 128 + 2 * (j + 32) + gg];
        const int src = lane & 24;
        const float m0 = __shfl(s0, src), m1 = __shfl(s1, src);
        const float e0 = __expf((s0 - m0) * rstd), e1 = __expf((s1 - m1) * rstd);
        float z0 = e0, z1 = e1;
        z0 += __shfl_xor(z0, 1); z0 += __shfl_xor(z0, 2); z0 += __shfl_xor(z0, 4); z0 += __shfl_xor(z0, 32);
        z1 += __shfl_xor(z1, 1); z1 += __shfl_xor(z1, 2); z1 += __shfl_xor(z1, 4); z1 += __shfl_xor(z1, 32);
        my_g0 = e0 / z0; my_g1 = e1 / z1;
    }
    f32x2 acc[16];
#pragma unroll
    for (int q = 0; q < 16; ++q) acc[q] = (f32x2){0.f, 0.f};
    struct Stage { u32x4 u, v; unsigned short su, sv; float gt; };
#if F4_STAGES == 8
    Stage S0, S1, S2, S3, S4, S5, S6, S7;
#else
    Stage S0, S1, S2, S3;
#endif
#define G4_LOAD(S, i) do { const int _sel = (lane & 32) | ((i) & 31); const int _e = __shfl((i) < 32 ? my_i0 : my_i1, _sel); S.gt = __shfl((i) < 32 ? my_g0 : my_g1, _sel); \
        const unsigned char* _ur = PU + (size_t)_e * F4_ROW; const unsigned char* _vr = PV + (size_t)_e * F4_ROW; \
        S.u = *(const u32x4*)(_ur + j * 16); S.v = *(const u32x4*)(_vr + j * 16); S.su = *(const unsigned short*)(_ur + 512 + 2 * j); S.sv = *(const unsigned short*)(_vr + 512 + 2 * j); } while (0)
#define G4_DOT1(W, Q) do { d2 = __builtin_amdgcn_cvt_scalef32_pk_f32_fp4((W), 1.0f, 0) * xv[(Q)] + d2; d2 = __builtin_amdgcn_cvt_scalef32_pk_f32_fp4((W), 1.0f, 1) * xv[(Q) + 1] + d2; \
        e2 = __builtin_amdgcn_cvt_scalef32_pk_f32_fp4((W), 1.0f, 2) * xv[(Q) + 2] + e2; e2 = __builtin_amdgcn_cvt_scalef32_pk_f32_fp4((W), 1.0f, 3) * xv[(Q) + 3] + e2; } while (0)
#define G4_AXPY1(W, Q) do { acc[(Q)] = __builtin_amdgcn_cvt_scalef32_pk_f32_fp4((W), 1.0f, 0) * a2 + acc[(Q)]; acc[(Q) + 1] = __builtin_amdgcn_cvt_scalef32_pk_f32_fp4((W), 1.0f, 1) * a2 + acc[(Q) + 1]; \
        acc[(Q) + 2] = __builtin_amdgcn_cvt_scalef32_pk_f32_fp4((W), 1.0f, 2) * a2 + acc[(Q) + 2]; acc[(Q) + 3] = __builtin_amdgcn_cvt_scalef32_pk_f32_fp4((W), 1.0f, 3) * a2 + acc[(Q) + 3]; } while (0)
#define G4_COMPUTE(S) do { f32x2 d2 = (f32x2){0.f, 0.f}, e2 = (f32x2){0.f, 0.f}; \
        G4_DOT1(S.u.x, 0); G4_DOT1(S.u.y, 4); G4_DOT1(S.u.z, 8); G4_DOT1(S.u.w, 12); \
        const float _d = sum32(((d2.x + d2.y) + (e2.x + e2.y)) * bf2f(S.su)); \
        const float _a = S.gt * gelu_fast(_d) * bf2f(S.sv); const f32x2 a2 = (f32x2){_a, _a}; \
        G4_AXPY1(S.v.x, 0); G4_AXPY1(S.v.y, 4); G4_AXPY1(S.v.z, 8); G4_AXPY1(S.v.w, 12); } while (0)
#if F4_STAGES == 8
    G4_LOAD(S0, 0); G4_LOAD(S1, 1); G4_LOAD(S2, 2); G4_LOAD(S3, 3); G4_LOAD(S4, 4); G4_LOAD(S5, 5); G4_LOAD(S6, 6);
#pragma unroll 1
    for (int i = 0; i < 64; i += 8) {
        const bool more = i + 8 < 64;
        G4_LOAD(S7, i + 7); G4_COMPUTE(S0);
        if (more) G4_LOAD(S0, i + 8);
        G4_COMPUTE(S1);
        if (more) G4_LOAD(S1, i + 9);
        G4_COMPUTE(S2);
        if (more) G4_LOAD(S2, i + 10);
        G4_COMPUTE(S3);
        if (more) G4_LOAD(S3, i + 11);
        G4_COMPUTE(S4);
        if (more) G4_LOAD(S4, i + 12);
        G4_COMPUTE(S5);
        if (more) G4_LOAD(S5, i + 13);
        G4_COMPUTE(S6);
        if (more) G4_LOAD(S6, i + 14);
        G4_COMPUTE(S7);
    }
#else
    G4_LOAD(S0, 0); G4_LOAD(S1, 1); G4_LOAD(S2, 2);
#pragma unroll 1
    for (int i = 0; i < 64; i += 4) {
        const bool more = i + 4 < 64;
        G4_LOAD(S3, i + 3); G4_COMPUTE(S0);
        if (more) G4_LOAD(S0, i + 4);
        G4_COMPUTE(S1);
        if (more) G4_LOAD(S1, i + 5);
        G4_COMPUTE(S2);
        if (more) G4_LOAD(S2, i + 6);
        G4_COMPUTE(S3);
    }
#endif
#undef G4_LOAD
#undef G4_DOT1
#undef G4_AXPY1
#undef G4_COMPUTE
    float s2[16];
#pragma unroll
    for (int q = 0; q < 8; ++q) {
        const f32x2 mine2 = gg ? acc[8 + q] : acc[q], send = gg ? acc[q] : acc[8 + q];
        s2[2 * q] = mine2.x + __shfl_xor(send.x, 32); s2[2 * q + 1] = mine2.y + __shfl_xor(send.y, 32);
    }
    float* px = xrow + 32 * j + 16 * gg;
    f32x4 xo[4]; float sq = 0.f;
#pragma unroll
    for (int q = 0; q < 4; ++q) { xo[q] = *(const f32x4*)(px + 4 * q); xo[q] += (f32x4){s2[4 * q], s2[4 * q + 1], s2[4 * q + 2], s2[4 * q + 3]}; if (!DRY || xo[q].x == 1.2345e-30f) *(f32x4*)(px + 4 * q) = xo[q];
        sq += (xo[q].x * xo[q].x + xo[q].y * xo[q].y) + (xo[q].z * xo[q].z + xo[q].w * xo[q].w); }
    if (!DRY && l + 1 < DEPTH) {
        const float r1 = rsqrtf(wave_sum(sq) * (1.f / DM) + EPS);
        u32x4 o0, o1;
        o0.x = pk2(xo[0].x * r1, xo[0].y * r1); o0.y = pk2(xo[0].z * r1, xo[0].w * r1); o0.z = pk2(xo[1].x * r1, xo[1].y * r1); o0.w = pk2(xo[1].z * r1, xo[1].w * r1);
        o1.x = pk2(xo[2].x * r1, xo[2].y * r1); o1.y = pk2(xo[2].z * r1, xo[2].w * r1); o1.z = pk2(xo[3].x * r1, xo[3].y * r1); o1.w = pk2(xo[3].z * r1, xo[3].w * r1);
        u32x4* po = (u32x4*)(XN + (size_t)t * DM + 32 * j + 16 * gg);
        po[0] = o0; po[1] = o1;
    }
}

template <bool DRY>
__device__ __forceinline__ void gather_token4b(int l, int t, float* out, const bf16_t* XB, float* rstd_out, const float* g2w, const unsigned char* PU, const unsigned char* PV,
                                               const int* idxs, const float* scos, bf16_t* XN, LAS unsigned* wl  , int lane) {
    const int gg = lane >> 5, j = lane & 31;
    float* xrow = out + (size_t)t * DM; const bf16_t* xbrow = XB + (size_t)t * DM;
    { const u32x2 iv = *(const u32x2*)(idxs + (size_t)t * 128 + 2 * lane); wl[2 * lane] = iv.x; wl[2 * lane + 1] = iv.y; }
    f32x2 xv[16];
    float rstd;
    {
        f32x4 xa[8]; float ss = 0.f;
#pragma unroll
        for (int q = 0; q < 4; ++q) { float f[8]; unpack8(*(const u32x4*)(xbrow + 32 * j + 8 * q), f); xa[2 * q] = (f32x4){f[0], f[1], f[2], f[3]}; xa[2 * q + 1] = (f32x4){f[4], f[5], f[6], f[7]};
#pragma unroll
            for (int e = 0; e < 8; ++e) ss += f[e] * f[e]; }
        ss = sum32(ss);
        rstd = rsqrtf(ss * (1.f / DM) + EPS);
#pragma unroll
        for (int q = 0; q < 8; ++q) { const f32x4 ga = *(const f32x4*)(g2w + 32 * j + 4 * q); const f32x4 a = xa[q];
            xv[2 * q] = (f32x2){a.x * ga.x * rstd, a.y * ga.y * rstd}; xv[2 * q + 1] = (f32x2){a.z * ga.z * rstd, a.w * ga.w * rstd}; }
    }
    struct StU { u32x4 u; unsigned short su; };
    StU A0, A1, A2, A3, A4, A5, A6, A7;
#define P1_LOAD(S, i) do { const int _e = (int)wl[2 * (i) + gg]; const unsigned char* _ur = PU + (size_t)_e * F4_ROW; S.u = *(const u32x4*)(_ur + j * 16); S.su = *(const unsigned short*)(_ur + 512 + 2 * j); } while (0)
#define P1_DOT1(W, Q) do { d2 = __builtin_amdgcn_cvt_scalef32_pk_f32_fp4((W), 1.0f, 0) * xv[(Q)] + d2; e2 = __builtin_amdgcn_cvt_scalef32_pk_f32_fp4((W), 1.0f, 1) * xv[(Q) + 1] + e2; \
        d2 = __builtin_amdgcn_cvt_scalef32_pk_f32_fp4((W), 1.0f, 2) * xv[(Q) + 2] + d2; e2 = __builtin_amdgcn_cvt_scalef32_pk_f32_fp4((W), 1.0f, 3) * xv[(Q) + 3] + e2; } while (0)
#define P1_COMPUTE(S, PD) do { f32x2 d2 = (f32x2){0.f, 0.f}, e2 = (f32x2){0.f, 0.f}; P1_DOT1(S.u.x, 0); P1_DOT1(S.u.y, 4); P1_DOT1(S.u.z, 8); P1_DOT1(S.u.w, 12); \
        PD = ((d2.x + d2.y) + (e2.x + e2.y)) * bf2f(S.su); } while (0)
#define P1_STEP(S, k) do { P1_COMPUTE(S, P[(k)]); if (i0 + (k) + 8 < 64) P1_LOAD(S, i0 + (k) + 8); } while (0)
    P1_LOAD(A0, 0); P1_LOAD(A1, 1); P1_LOAD(A2, 2); P1_LOAD(A3, 3); P1_LOAD(A4, 4); P1_LOAD(A5, 5); P1_LOAD(A6, 6); P1_LOAD(A7, 7);
    const bool b4 = (lane & 16) != 0, b3 = (lane & 8) != 0, b2 = (lane & 4) != 0, b1 = (lane & 2) != 0;
    const int rho = (lane >> 1) & 15;
#pragma unroll 1
    for (int b = 0; b < 4; ++b) {
        const int i0 = 16 * b;
        float P[16];
        P1_STEP(A0, 0); P1_STEP(A1, 1); P1_STEP(A2, 2); P1_STEP(A3, 3); P1_STEP(A4, 4); P1_STEP(A5, 5); P1_STEP(A6, 6); P1_STEP(A7, 7);
        P1_STEP(A0, 8); P1_STEP(A1, 9); P1_STEP(A2, 10); P1_STEP(A3, 11); P1_STEP(A4, 12); P1_STEP(A5, 13); P1_STEP(A6, 14); P1_STEP(A7, 15);
        float Q8[8], R4[4], S2[2], h;
#pragma unroll
        for (int k = 0; k < 8; ++k) { const float mine = b4 ? P[8 + k] : P[k], send = b4 ? P[k] : P[8 + k]; Q8[k] = mine + __builtin_bit_cast(float, __builtin_amdgcn_ds_swizzle(__builtin_bit_cast(int, send), 0x401F)); }
#pragma unroll
        for (int k = 0; k < 4; ++k) { const float mine = b3 ? Q8[4 + k] : Q8[k], send = b3 ? Q8[k] : Q8[4 + k]; R4[k] = mine + DPP_MOV(send, 0x128); }
#pragma unroll
        for (int k = 0; k < 2; ++k) { const float mine = b2 ? R4[2 + k] : R4[k], send = b2 ? R4[k] : R4[2 + k]; S2[k] = mine + DPP_MOV(send, 0x141); }
        { const float mine = b1 ? S2[1] : S2[0], send = b1 ? S2[0] : S2[1]; h = mine + DPP_MOV(send, 0x4E); }
        h += DPP_MOV(h, 0xB1);
        const int r = 2 * (i0 + rho) + gg;
        const float sc = scos[(size_t)t * 128 + r];
        const float m0 = __shfl(sc, lane & 16);
        const float ex = __expf((sc - m0) * rstd);
        float z = ex;
        z += DPP_MOV(z, 0x4E); z += DPP_MOV(z, 0x141) ; z += DPP_MOV(z, 0x128);
        z += __shfl_xor(z, 32);
        const float a = (ex / z) * gelu_fast(h);
        if ((lane & 1) == 0) wl[128 + r] = __float_as_uint(a);
    }
#undef P1_LOAD
#undef P1_DOT1
#undef P1_COMPUTE
#undef P1_STEP
    f32x2 acc[16];
#pragma unroll
    for (int q = 0; q < 16; ++q) acc[q] = (f32x2){0.f, 0.f};
    struct StV { u32x4 v; unsigned short sv; float a; };
    StV B0, B1, B2, B3, B4, B5, B6, B7;
#define P2_LOAD(S, i) do { const int _e = (int)wl[2 * (i) + gg]; S.a = __uint_as_float(wl[128 + 2 * (i) + gg]); const unsigned char* _vr = PV + (size_t)_e * F4_ROW; S.v = *(const u32x4*)(_vr + j * 16); S.sv = *(const unsigned short*)(_vr + 512 + 2 * j); } while (0)
#define P2_AXPY1(W, Q) do { acc[(Q)] = __builtin_amdgcn_cvt_scalef32_pk_f32_fp4((W), 1.0f, 0) * a2 + acc[(Q)]; acc[(Q) + 1] = __builtin_amdgcn_cvt_scalef32_pk_f32_fp4((W), 1.0f, 1) * a2 + acc[(Q) + 1]; \
        acc[(Q) + 2] = __builtin_amdgcn_cvt_scalef32_pk_f32_fp4((W), 1.0f, 2) * a2 + acc[(Q) + 2]; acc[(Q) + 3] = __builtin_amdgcn_cvt_scalef32_pk_f32_fp4((W), 1.0f, 3) * a2 + acc[(Q) + 3]; } while (0)
#define P2_STEP(S, k) do { { const float _a = S.a * bf2f(S.sv); const f32x2 a2 = (f32x2){_a, _a}; P2_AXPY1(S.v.x, 0); P2_AXPY1(S.v.y, 4); P2_AXPY1(S.v.z, 8); P2_AXPY1(S.v.w, 12); } \
        if (i0 + (k) + 8 < 64) P2_LOAD(S, i0 + (k) + 8); } while (0)
    P2_LOAD(B0, 0); P2_LOAD(B1, 1); P2_LOAD(B2, 2); P2_LOAD(B3, 3); P2_LOAD(B4, 4); P2_LOAD(B5, 5); P2_LOAD(B6, 6); P2_LOAD(B7, 7);
#pragma unroll 1
    for (int i0 = 0; i0 < 64; i0 += 8) {
        P2_STEP(B0, 0); P2_STEP(B1, 1); P2_STEP(B2, 2); P2_STEP(B3, 3); P2_STEP(B4, 4); P2_STEP(B5, 5); P2_STEP(B6, 6); P2_STEP(B7, 7);
    }
#undef P2_LOAD
#undef P2_AXPY1
#undef P2_STEP
    float s2[16];
#pragma unroll
    for (int q = 0; q < 8; ++q) {
        const f32x2 mine2 = gg ? acc[8 + q] : acc[q], send = gg ? acc[q] : acc[8 + q];
        s2[2 * q] = mine2.x + __shfl_xor(send.x, 32); s2[2 * q + 1] = mine2.y + __shfl_xor(send.y, 32);
    }
    const int e0 = 32 * j + 16 * gg;
    f32x4 xo[4]; float sq = 0.f;
    { float f0[8], f1[8]; unpack8(*(const u32x4*)(xbrow + e0), f0); unpack8(*(const u32x4*)(xbrow + e0 + 8), f1);
      xo[0] = (f32x4){f0[0], f0[1], f0[2], f0[3]}; xo[1] = (f32x4){f0[4], f0[5], f0[6], f0[7]}; xo[2] = (f32x4){f1[0], f1[1], f1[2], f1[3]}; xo[3] = (f32x4){f1[4], f1[5], f1[6], f1[7]}; }
#pragma unroll
    for (int q = 0; q < 4; ++q) { xo[q] += (f32x4){s2[4 * q], s2[4 * q + 1], s2[4 * q + 2], s2[4 * q + 3]};
        sq += (xo[q].x * xo[q].x + xo[q].y * xo[q].y) + (xo[q].z * xo[q].z + xo[q].w * xo[q].w); }
    if (l + 1 < DEPTH) {
        const float r1 = rsqrtf(wave_sum(sq) * (1.f / DM) + EPS);
        if (!DRY) {
            u32x4 o0, o1;
            o0.x = pk2(xo[0].x, xo[0].y); o0.y = pk2(xo[0].z, xo[0].w); o0.z = pk2(xo[1].x, xo[1].y); o0.w = pk2(xo[1].z, xo[1].w);
            o1.x = pk2(xo[2].x, xo[2].y); o1.y = pk2(xo[2].z, xo[2].w); o1.z = pk2(xo[3].x, xo[3].y); o1.w = pk2(xo[3].z, xo[3].w);
            u32x4* po = (u32x4*)(XN + (size_t)t * DM + e0);
            po[0] = o0; po[1] = o1;
            if (lane == 0) rstd_out[t] = r1;
        }
    } else {
#pragma unroll
        for (int q = 0; q < 4; ++q) if (!DRY || xo[q].x == 1.2345e-30f) *(f32x4*)(xrow + e0 + 4 * q) = xo[q];
    }
}

template <unsigned IDXMASK>
__device__ __forceinline__ void gather_pass1(int t, const bf16_t* XB, const float* g2w, const unsigned char* PU, const float* SU, const int* idxs, const float* scos, LAS unsigned* wl, int lane) {
    const int gg = lane >> 5, j = lane & 31;
    const bf16_t* xbrow = XB + (size_t)t * DM;
#if !P1_PRESTAGE
    { const u32x2 iv = *(const u32x2*)(idxs + (size_t)t * 128 + 2 * lane); wl[2 * lane] = iv.x & IDXMASK; wl[2 * lane + 1] = iv.y & IDXMASK; }
#endif
    float sc4[4];
#pragma unroll
    for (int bb = 0; bb < 4; ++bb) sc4[bb] = scos[(size_t)t * 128 + 2 * (16 * bb + ((lane >> 1) & 15)) + gg];
#if USE_I4U
    unsigned xh[4], xl[4];
    float xscale, rstd;
    {
        float f[32]; float ss = 0.f;
#pragma unroll
        for (int q = 0; q < 4; ++q) { unpack8(*(const u32x4*)(xbrow + 32 * j + 8 * q), f + 8 * q);
#pragma unroll
            for (int e = 0; e < 8; ++e) ss += f[8 * q + e] * f[8 * q + e]; }
        ss = sum32(ss);
        rstd = rsqrtf(ss * (1.f / DM) + EPS);
        float am = 0.f;
#pragma unroll
        for (int q = 0; q < 8; ++q) { const f32x4 ga = *(const f32x4*)(g2w + 32 * j + 4 * q);
            f[4 * q] *= ga.x * rstd; f[4 * q + 1] *= ga.y * rstd; f[4 * q + 2] *= ga.z * rstd; f[4 * q + 3] *= ga.w * rstd;
            am = fmaxf(am, fmaxf(fmaxf(fabsf(f[4 * q]), fabsf(f[4 * q + 1])), fmaxf(fabsf(f[4 * q + 2]), fabsf(f[4 * q + 3])))); }
        am = fmaxf(am, DPP_MOV(am, 0xB1)); am = fmaxf(am, DPP_MOV(am, 0x4E)); am = fmaxf(am, DPP_MOV(am, 0x141)); am = fmaxf(am, DPP_MOV(am, 0x128));
        am = fmaxf(am, __builtin_bit_cast(float, __builtin_amdgcn_ds_swizzle(__builtin_bit_cast(int, am), 0x401F)));
        am = fmaxf(am, 1e-30f);
        xscale = am * (1.f / 127.f);
        const float iq = 127.f / am;
#pragma unroll
        for (int w = 0; w < 4; ++w) { unsigned h4 = 0u, l4 = 0u;
#pragma unroll
            for (int pp = 0; pp < 8; ++pp) { const int bq = (int)__builtin_rintf(f[8 * w + pp] * iq) + 128;
                h4 |= (unsigned)(((bq >> 4) - 8) & 0xf) << (4 * pp); l4 |= (unsigned)(((bq & 15) - 8) & 0xf) << (4 * pp); }
            xh[w] = h4; xl[w] = l4; }
    }
#else
    f32x2 xv[16];
    float rstd;
    {
        f32x4 xa[8]; float ss = 0.f;
#pragma unroll
        for (int q = 0; q < 4; ++q) { float f[8]; unpack8(*(const u32x4*)(xbrow + 32 * j + 8 * q), f); xa[2 * q] = (f32x4){f[0], f[1], f[2], f[3]}; xa[2 * q + 1] = (f32x4){f[4], f[5], f[6], f[7]};
#pragma unroll
            for (int e = 0; e < 8; ++e) ss += f[e] * f[e]; }
        ss = sum32(ss);
        rstd = rsqrtf(ss * (1.f / DM) + EPS);
#pragma unroll
        for (int q = 0; q < 8; ++q) { const f32x4 ga = *(const f32x4*)(g2w + 32 * j + 4 * q); const f32x4 a = xa[q];
            xv[2 * q] = (f32x2){a.x * ga.x * rstd, a.y * ga.y * rstd}; xv[2 * q + 1] = (f32x2){a.z * ga.z * rstd, a.w * ga.w * rstd}; }
    }
#endif
#if USE_I4U
    struct StU { u32x4 u; f32x2 sq; };
#elif F4_ROWSCALE
    struct StU { u32x4 u; float su; };
#else
    struct StU { u32x4 u; unsigned short su; };
#endif
    StU A0, A1, A2, A3, A4, A5, A6, A7, A8, A9, A10, A11, A12, A13, A14, A15;
#if USE_I4U
#define P1_LOAD(S, i) do { const int _e = (int)wl[2 * (i) + gg]; S.u = *(const u32x4*)(PU + (size_t)_e * F4_ROW + j * 16); S.sq = ((const f32x2*)SU)[_e]; } while (0)
#define P1_COMPUTE(S, PD) do { int _ah = 0, _al = 0; \
        _ah = __builtin_amdgcn_sdot8((int)S.u.x, (int)xh[0], _ah, false); _al = __builtin_amdgcn_sdot8((int)S.u.x, (int)xl[0], _al, false); \
        _ah = __builtin_amdgcn_sdot8((int)S.u.y, (int)xh[1], _ah, false); _al = __builtin_amdgcn_sdot8((int)S.u.y, (int)xl[1], _al, false); \
        _ah = __builtin_amdgcn_sdot8((int)S.u.z, (int)xh[2], _ah, false); _al = __builtin_amdgcn_sdot8((int)S.u.z, (int)xl[2], _al, false); \
        _ah = __builtin_amdgcn_sdot8((int)S.u.w, (int)xh[3], _ah, false); _al = __builtin_amdgcn_sdot8((int)S.u.w, (int)xl[3], _al, false); \
        PD = (float)(16 * _ah + _al) * S.sq.x + S.sq.y; } while (0)
#else
#define P1_LOAD(S, i) do { const int _e = (int)wl[2 * (i) + gg]; const unsigned char* _ur = PU + (size_t)_e * F4_ROW; S.u = *(const u32x4*)(_ur + j * 16); if (F4_ROWSCALE) S.su = SU[_e]; else S.su = *(const unsigned short*)(_ur + 512 + 2 * j); } while (0)
#define P1_DOT1(W, Q) do { d2 = __builtin_amdgcn_cvt_scalef32_pk_f32_fp4((W), 1.0f, 0) * xv[(Q)] + d2; e2 = __builtin_amdgcn_cvt_scalef32_pk_f32_fp4((W), 1.0f, 1) * xv[(Q) + 1] + e2; \
        d2 = __builtin_amdgcn_cvt_scalef32_pk_f32_fp4((W), 1.0f, 2) * xv[(Q) + 2] + d2; e2 = __builtin_amdgcn_cvt_scalef32_pk_f32_fp4((W), 1.0f, 3) * xv[(Q) + 3] + e2; } while (0)
#define P1_COMPUTE(S, PD) do { f32x2 d2 = (f32x2){0.f, 0.f}, e2 = (f32x2){0.f, 0.f}; P1_DOT1(S.u.x, 0); P1_DOT1(S.u.y, 4); P1_DOT1(S.u.z, 8); P1_DOT1(S.u.w, 12); \
        PD = ((d2.x + d2.y) + (e2.x + e2.y)) * (F4_ROWSCALE ? (float)S.su : bf2f((unsigned)S.su)); } while (0)
#endif
#define P1_STEP(S, k) do { P1_COMPUTE(S, P[(k)]); if (i0 + 16 < 64) P1_LOAD(S, i0 + (k) + 16); } while (0)
    P1_LOAD(A0, 0); P1_LOAD(A1, 1); P1_LOAD(A2, 2); P1_LOAD(A3, 3); P1_LOAD(A4, 4); P1_LOAD(A5, 5); P1_LOAD(A6, 6); P1_LOAD(A7, 7);
    P1_LOAD(A8, 8); P1_LOAD(A9, 9); P1_LOAD(A10, 10); P1_LOAD(A11, 11); P1_LOAD(A12, 12); P1_LOAD(A13, 13); P1_LOAD(A14, 14); P1_LOAD(A15, 15);
    const bool b4 = (lane & 16) != 0, b3 = (lane & 8) != 0, b2 = (lane & 4) != 0, b1 = (lane & 2) != 0;
    const int rho = (lane >> 1) & 15;
#pragma unroll
    for (int b = 0; b < 4; ++b) {
        const int i0 = 16 * b;
        float P[16];
        P1_STEP(A0, 0); P1_STEP(A1, 1); P1_STEP(A2, 2); P1_STEP(A3, 3); P1_STEP(A4, 4); P1_STEP(A5, 5); P1_STEP(A6, 6); P1_STEP(A7, 7);
        P1_STEP(A8, 8); P1_STEP(A9, 9); P1_STEP(A10, 10); P1_STEP(A11, 11); P1_STEP(A12, 12); P1_STEP(A13, 13); P1_STEP(A14, 14); P1_STEP(A15, 15);
        float Q8[8], R4[4], S2[2], h;
#pragma unroll
        for (int k = 0; k < 8; ++k) { const float mine = b4 ? P[8 + k] : P[k], send = b4 ? P[k] : P[8 + k]; Q8[k] = mine + __builtin_bit_cast(float, __builtin_amdgcn_ds_swizzle(__builtin_bit_cast(int, send), 0x401F)); }
#pragma unroll
        for (int k = 0; k < 4; ++k) { const float mine = b3 ? Q8[4 + k] : Q8[k], send = b3 ? Q8[k] : Q8[4 + k]; R4[k] = mine + DPP_MOV(send, 0x128); }
#pragma unroll
        for (int k = 0; k < 2; ++k) { const float mine = b2 ? R4[2 + k] : R4[k], send = b2 ? R4[k] : R4[2 + k]; S2[k] = mine + DPP_MOV(send, 0x141); }
        { const float mine = b1 ? S2[1] : S2[0], send = b1 ? S2[0] : S2[1]; h = mine + DPP_MOV(send, 0x4E); }
        h += DPP_MOV(h, 0xB1);
        const int r = 2 * (i0 + rho) + gg;
        const float sc = sc4[b];
        const float m0 = __shfl(sc, lane & 16);
        const float ex = __expf((sc - m0) * rstd);
        float z = ex;
        z += DPP_MOV(z, 0x4E); z += DPP_MOV(z, 0x141) ; z += DPP_MOV(z, 0x128);
        z += __shfl_xor(z, 32);
        const float a = (ex / z) * gelu_fast(USE_I4U ? h * xscale : h);
        if ((lane & 1) == 0) wl[128 + r] = __float_as_uint(a);
    }
#undef P1_LOAD
#undef P1_DOT1
#undef P1_COMPUTE
#undef P1_STEP
}

template <bool DRY>
__device__ __forceinline__ void gather_pass2(int l, int t, float* out, const bf16_t* XB, float* rstd_out, const unsigned char* PV, const float* SV, bf16_t* XN, LAS unsigned* wl, int lane) {
    const int gg = lane >> 5, j = lane & 31;
    float* xrow = out + (size_t)t * DM; const bf16_t* xbrow = XB + (size_t)t * DM;
    f32x2 acc[16];
#pragma unroll
    for (int q = 0; q < 16; ++q) acc[q] = (f32x2){0.f, 0.f};
#if F4_ROWSCALE
    struct StV { u32x4 v; float sv; float a; };
#else
    struct StV { u32x4 v; unsigned short sv; float a; };
#endif
    StV B0, B1, B2, B3, B4, B5, B6, B7, B8, B9, B10, B11, B12, B13, B14, B15;
#define P2_LOAD(S, i) do { const int _e = (int)wl[2 * (i) + gg]; S.a = __uint_as_float(wl[128 + 2 * (i) + gg]); const unsigned char* _vr = PV + (size_t)_e * F4_ROW; S.v = *(const u32x4*)(_vr + j * 16); if (F4_ROWSCALE) S.sv = SV[_e]; else S.sv = *(const unsigned short*)(_vr + 512 + 2 * j); } while (0)
#define P2_AXPY1(W, Q) do { acc[(Q)] = __builtin_amdgcn_cvt_scalef32_pk_f32_fp4((W), 1.0f, 0) * a2 + acc[(Q)]; acc[(Q) + 1] = __builtin_amdgcn_cvt_scalef32_pk_f32_fp4((W), 1.0f, 1) * a2 + acc[(Q) + 1]; \
        acc[(Q) + 2] = __builtin_amdgcn_cvt_scalef32_pk_f32_fp4((W), 1.0f, 2) * a2 + acc[(Q) + 2]; acc[(Q) + 3] = __builtin_amdgcn_cvt_scalef32_pk_f32_fp4((W), 1.0f, 3) * a2 + acc[(Q) + 3]; } while (0)
#define P2_STEP(S, k) do { { const float _a = S.a * (F4_ROWSCALE ? (float)S.sv : bf2f((unsigned)S.sv)); const f32x2 a2 = (f32x2){_a, _a}; P2_AXPY1(S.v.x, 0); P2_AXPY1(S.v.y, 4); P2_AXPY1(S.v.z, 8); P2_AXPY1(S.v.w, 12); } \
        if (i0 + 16 < 64) P2_LOAD(S, i0 + (k) + 16); } while (0)
    P2_LOAD(B0, 0); P2_LOAD(B1, 1); P2_LOAD(B2, 2); P2_LOAD(B3, 3); P2_LOAD(B4, 4); P2_LOAD(B5, 5); P2_LOAD(B6, 6); P2_LOAD(B7, 7);
    P2_LOAD(B8, 8); P2_LOAD(B9, 9); P2_LOAD(B10, 10); P2_LOAD(B11, 11); P2_LOAD(B12, 12); P2_LOAD(B13, 13); P2_LOAD(B14, 14); P2_LOAD(B15, 15);
#pragma unroll
    for (int i0 = 0; i0 < 64; i0 += 16) {
        P2_STEP(B0, 0); P2_STEP(B1, 1); P2_STEP(B2, 2); P2_STEP(B3, 3); P2_STEP(B4, 4); P2_STEP(B5, 5); P2_STEP(B6, 6); P2_STEP(B7, 7);
        P2_STEP(B8, 8); P2_STEP(B9, 9); P2_STEP(B10, 10); P2_STEP(B11, 11); P2_STEP(B12, 12); P2_STEP(B13, 13); P2_STEP(B14, 14); P2_STEP(B15, 15);
    }
#undef P2_LOAD
#undef P2_AXPY1
#undef P2_STEP
    float s2[16];
#pragma unroll
    for (int q = 0; q < 8; ++q) {
        const f32x2 mine2 = gg ? acc[8 + q] : acc[q], send = gg ? acc[q] : acc[8 + q];
        s2[2 * q] = mine2.x + __shfl_xor(send.x, 32); s2[2 * q + 1] = mine2.y + __shfl_xor(send.y, 32);
    }
    const int e0 = 32 * j + 16 * gg;
    f32x4 xo[4]; float sq = 0.f;
    { float f0[8], f1[8]; unpack8(*(const u32x4*)(xbrow + e0), f0); unpack8(*(const u32x4*)(xbrow + e0 + 8), f1);
      xo[0] = (f32x4){f0[0], f0[1], f0[2], f0[3]}; xo[1] = (f32x4){f0[4], f0[5], f0[6], f0[7]}; xo[2] = (f32x4){f1[0], f1[1], f1[2], f1[3]}; xo[3] = (f32x4){f1[4], f1[5], f1[6], f1[7]}; }
#pragma unroll
    for (int q = 0; q < 4; ++q) { xo[q] += (f32x4){s2[4 * q], s2[4 * q + 1], s2[4 * q + 2], s2[4 * q + 3]};
        sq += (xo[q].x * xo[q].x + xo[q].y * xo[q].y) + (xo[q].z * xo[q].z + xo[q].w * xo[q].w); }
    if (l + 1 < DEPTH) {
        const float r1 = rsqrtf(wave_sum(sq) * (1.f / DM) + EPS);
        if (!DRY) {
            u32x4 o0, o1;
            o0.x = pk2(xo[0].x, xo[0].y); o0.y = pk2(xo[0].z, xo[0].w); o0.z = pk2(xo[1].x, xo[1].y); o0.w = pk2(xo[1].z, xo[1].w);
            o1.x = pk2(xo[2].x, xo[2].y); o1.y = pk2(xo[2].z, xo[2].w); o1.z = pk2(xo[3].x, xo[3].y); o1.w = pk2(xo[3].z, xo[3].w);
            u32x4* po = (u32x4*)(XN + (size_t)t * DM + e0);
            po[0] = o0; po[1] = o1;
            if (lane == 0) rstd_out[t] = r1;
        }
    } else {
#pragma unroll
        for (int q = 0; q < 4; ++q) if (!DRY || xo[q].x == 1.2345e-30f) *(f32x4*)(xrow + e0 + 4 * q) = xo[q];
    }
}

#define DPP_MOVI(v, CTRL) __builtin_amdgcn_update_dpp((v), (v), (CTRL), 0xf, 0xf, false)
__device__ __forceinline__ void gather_pass1_lean(int t, const bf16_t* XB, const float* g2w, const unsigned char* PU, const f32x2* SUQ, const float* SV, const float* scos, LAS unsigned* wl, int lane) {
    const int gg = lane >> 5, j = lane & 31;
    const int rho = (lane >> 1) & 15;
    const unsigned jofs = (unsigned)j * 16u, jofs3 = (unsigned)j * 12u; (void)jofs; (void)jofs3;
    const bf16_t* xbrow = XB + (size_t)t * DM;
    float sc4[4], sv4[4]; f32x2 sq4[4];
#pragma unroll
    for (int bb = 0; bb < 4; ++bb) { const int rb = 2 * (16 * bb + rho) + gg; const unsigned e = wl[rb]; sc4[bb] = scos[(size_t)t * 128 + rb]; sq4[bb] = SUQ[e]; sv4[bb] = SV[e]; }
    unsigned xh[4], xl[4];
    float xscale, rstd, c35;
    {
        float f[32]; float ss = 0.f;
#pragma unroll
        for (int q = 0; q < 4; ++q) { unpack8(*(const u32x4*)(xbrow + 32 * j + 8 * q), f + 8 * q);
#pragma unroll
            for (int e = 0; e < 8; ++e) ss += f[8 * q + e] * f[8 * q + e]; }
        ss = sum32(ss);
        rstd = rsqrtf(ss * (1.f / DM) + EPS);
        float am = 0.f;
#pragma unroll
        for (int q = 0; q < 8; ++q) { const f32x4 ga = *(const f32x4*)(g2w + 32 * j + 4 * q);
            f[4 * q] *= ga.x * rstd; f[4 * q + 1] *= ga.y * rstd; f[4 * q + 2] *= ga.z * rstd; f[4 * q + 3] *= ga.w * rstd;
            am = fmaxf(am, fmaxf(fmaxf(fabsf(f[4 * q]), fabsf(f[4 * q + 1])), fmaxf(fabsf(f[4 * q + 2]), fabsf(f[4 * q + 3])))); }
        am = fmaxf(am, DPP_MOV(am, 0xB1)); am = fmaxf(am, DPP_MOV(am, 0x4E)); am = fmaxf(am, DPP_MOV(am, 0x141)); am = fmaxf(am, DPP_MOV(am, 0x128));
        am = fmaxf(am, __builtin_bit_cast(float, __builtin_amdgcn_ds_swizzle(__builtin_bit_cast(int, am), 0x401F)));
        am = fmaxf(am, 1e-30f);
        xscale = am * (1.f / 127.f);
        const float iq = 127.f / am;
        int xsum = 0;
#pragma unroll
        for (int w = 0; w < 4; ++w) { unsigned h4 = 0u, l4 = 0u;
#pragma unroll
            for (int pp = 0; pp < 8; ++pp) { const int bq = (int)__builtin_rintf(f[8 * w + pp] * iq) + 128;
                xsum += bq - 128;
                h4 |= (unsigned)(((bq >> 4) - 8) & 0xf) << (4 * pp); l4 |= (unsigned)(((bq & 15) - 8) & 0xf) << (4 * pp); }
            xh[w] = h4; xl[w] = l4; }
        c35 = 3.5f * sum32((float)xsum);
    }
#if USE_I3U
    struct StU { u32x3 u; };
#else
    struct StU { u32x4 u; };
#endif
    StU A0, A1, A2, A3, A4, A5, A6, A7, A8, A9, A10, A11, A12, A13, A14, A15;
#if USE_I3U
#define P1_LOAD(S, i) do { const unsigned _e = wl[2 * (i) + gg]; S.u = *(const u32x3*)(PU + (size_t)(_e * 384u + jofs3)); } while (0)
#else
#define P1_LOAD(S, i) do { const unsigned _e = wl[2 * (i) + gg]; S.u = *(const u32x4*)(PU + (size_t)(_e * 512u + jofs)); } while (0)
#endif
#if USE_I3U
#define P1_COMPUTE(S, PD) do { int _ah = 0, _al = 0; \
        const unsigned _n0 = S.u.x & 0x77777777u, _n1 = S.u.y & 0x77777777u, _n2 = S.u.z & 0x77777777u; \
        unsigned _n3 = (S.u.x >> 3) & 0x11111111u; _n3 = ((S.u.y >> 2) & 0x22222222u) | _n3; _n3 = ((S.u.z >> 1) & 0x44444444u) | _n3; \
        _ah = __builtin_amdgcn_sdot8((int)_n0, (int)xh[0], _ah, false); _al = __builtin_amdgcn_sdot8((int)_n0, (int)xl[0], _al, false); \
        _ah = __builtin_amdgcn_sdot8((int)_n1, (int)xh[1], _ah, false); _al = __builtin_amdgcn_sdot8((int)_n1, (int)xl[1], _al, false); \
        _ah = __builtin_amdgcn_sdot8((int)_n2, (int)xh[2], _ah, false); _al = __builtin_amdgcn_sdot8((int)_n2, (int)xl[2], _al, false); \
        _ah = __builtin_amdgcn_sdot8((int)_n3, (int)xh[3], _ah, false); _al = __builtin_amdgcn_sdot8((int)_n3, (int)xl[3], _al, false); \
        PD = 16 * _ah + _al; } while (0)
#else
#define P1_COMPUTE(S, PD) do { int _ah = 0, _al = 0; \
        _ah = __builtin_amdgcn_sdot8((int)S.u.x, (int)xh[0], _ah, false); _al = __builtin_amdgcn_sdot8((int)S.u.x, (int)xl[0], _al, false); \
        _ah = __builtin_amdgcn_sdot8((int)S.u.y, (int)xh[1], _ah, false); _al = __builtin_amdgcn_sdot8((int)S.u.y, (int)xl[1], _al, false); \
        _ah = __builtin_amdgcn_sdot8((int)S.u.z, (int)xh[2], _ah, false); _al = __builtin_amdgcn_sdot8((int)S.u.z, (int)xl[2], _al, false); \
        _ah = __builtin_amdgcn_sdot8((int)S.u.w, (int)xh[3], _ah, false); _al = __builtin_amdgcn_sdot8((int)S.u.w, (int)xl[3], _al, false); \
        PD = 16 * _ah + _al; } while (0)
#endif
#define P1_STEP(S, k) do { P1_COMPUTE(S, P[(k)]); if (i0 + 16 < 64) P1_LOAD(S, i0 + (k) + 16); } while (0)
    P1_LOAD(A0, 0); P1_LOAD(A1, 1); P1_LOAD(A2, 2); P1_LOAD(A3, 3); P1_LOAD(A4, 4); P1_LOAD(A5, 5); P1_LOAD(A6, 6); P1_LOAD(A7, 7);
    P1_LOAD(A8, 8); P1_LOAD(A9, 9); P1_LOAD(A10, 10); P1_LOAD(A11, 11); P1_LOAD(A12, 12); P1_LOAD(A13, 13); P1_LOAD(A14, 14); P1_LOAD(A15, 15);
    const bool b4 = (lane & 16) != 0, b3 = (lane & 8) != 0, b2 = (lane & 4) != 0, b1 = (lane & 2) != 0;
#pragma unroll
    for (int b = 0; b < 4; ++b) {
        const int i0 = 16 * b;
        int P[16];
        P1_STEP(A0, 0); P1_STEP(A1, 1); P1_STEP(A2, 2); P1_STEP(A3, 3); P1_STEP(A4, 4); P1_STEP(A5, 5); P1_STEP(A6, 6); P1_STEP(A7, 7);
        P1_STEP(A8, 8); P1_STEP(A9, 9); P1_STEP(A10, 10); P1_STEP(A11, 11); P1_STEP(A12, 12); P1_STEP(A13, 13); P1_STEP(A14, 14); P1_STEP(A15, 15);
        int Q8[8], R4[4], S2[2], hi;
#pragma unroll
        for (int k = 0; k < 8; ++k) { const int mine = b4 ? P[8 + k] : P[k], send = b4 ? P[k] : P[8 + k]; Q8[k] = mine + __builtin_amdgcn_ds_swizzle(send, 0x401F); }
#pragma unroll
        for (int k = 0; k < 4; ++k) { const int mine = b3 ? Q8[4 + k] : Q8[k], send = b3 ? Q8[k] : Q8[4 + k]; R4[k] = mine + DPP_MOVI(send, 0x128); }
#pragma unroll
        for (int k = 0; k < 2; ++k) { const int mine = b2 ? R4[2 + k] : R4[k], send = b2 ? R4[k] : R4[2 + k]; S2[k] = mine + DPP_MOVI(send, 0x141); }
        { const int mine = b1 ? S2[1] : S2[0], send = b1 ? S2[0] : S2[1]; hi = mine + DPP_MOVI(send, 0x4E); }
        hi += DPP_MOVI(hi, 0xB1);
        const float h = ((float)hi - (USE_I3U ? c35 : 0.f)) * sq4[b].x + 32.f * sq4[b].y;
        const int r = 2 * (i0 + rho) + gg;
        const float sc = sc4[b];
        const float m0 = __shfl(sc, lane & 16);
        const float ex = __expf((sc - m0) * rstd);
        float z = ex;
        z += DPP_MOV(z, 0x4E); z += DPP_MOV(z, 0x141) ; z += DPP_MOV(z, 0x128);
        z += __shfl_xor(z, 32);
        const float a = (ex / z) * gelu_fast(h * xscale) * sv4[b];
#if P2_F16
        if ((lane & 1) == 0) { typedef _Float16 h16x2p __attribute__((ext_vector_type(2))); const _Float16 ah = (_Float16)a; wl[128 + r] = __builtin_bit_cast(unsigned, (h16x2p){ah, ah}); }
#else
        if ((lane & 1) == 0) wl[128 + r] = __float_as_uint(a);
#endif
    }
#undef P1_LOAD
#undef P1_COMPUTE
#undef P1_STEP
}

__device__ __forceinline__ void gather_pass2_lean(int l, int t, float* out, const bf16_t* XB, float* rstd_out, const unsigned char* PV, bf16_t* XN, LAS unsigned* wl, int lane) {
    const int gg = lane >> 5, j = lane & 31;
    const unsigned jofs = (unsigned)j * 16u;
    float* xrow = out + (size_t)t * DM; const bf16_t* xbrow = XB + (size_t)t * DM;
#if P2_F16
    typedef _Float16 h16x2 __attribute__((ext_vector_type(2)));
    h16x2 acch[16];
#pragma unroll
    for (int q = 0; q < 16; ++q) acch[q] = (h16x2){(_Float16)0.f, (_Float16)0.f};
#else
    f32x2 acc[16];
#pragma unroll
    for (int q = 0; q < 16; ++q) acc[q] = (f32x2){0.f, 0.f};
#endif
    struct StV { u32x4 v; float a; };
    StV B0, B1, B2, B3, B4, B5, B6, B7, B8, B9, B10, B11, B12, B13, B14, B15;
#define P2_LOAD(S, i) do { const unsigned _e = wl[2 * (i) + gg]; S.a = __uint_as_float(wl[128 + 2 * (i) + gg]); S.v = *(const u32x4*)(PV + (size_t)(_e * 512u + jofs)); } while (0)
#if P2_F16
#define P2_AXPY1(W, Q) do { acch[(Q)] = __builtin_amdgcn_cvt_scalef32_pk_f16_fp4((W), 1.0f, 0) * a2 + acch[(Q)]; acch[(Q) + 1] = __builtin_amdgcn_cvt_scalef32_pk_f16_fp4((W), 1.0f, 1) * a2 + acch[(Q) + 1]; \
        acch[(Q) + 2] = __builtin_amdgcn_cvt_scalef32_pk_f16_fp4((W), 1.0f, 2) * a2 + acch[(Q) + 2]; acch[(Q) + 3] = __builtin_amdgcn_cvt_scalef32_pk_f16_fp4((W), 1.0f, 3) * a2 + acch[(Q) + 3]; } while (0)
#define P2_A2(S) const h16x2 a2 = __builtin_bit_cast(h16x2, S.a)
#else
#define P2_AXPY1(W, Q) do { acc[(Q)] = __builtin_amdgcn_cvt_scalef32_pk_f32_fp4((W), 1.0f, 0) * a2 + acc[(Q)]; acc[(Q) + 1] = __builtin_amdgcn_cvt_scalef32_pk_f32_fp4((W), 1.0f, 1) * a2 + acc[(Q) + 1]; \
        acc[(Q) + 2] = __builtin_amdgcn_cvt_scalef32_pk_f32_fp4((W), 1.0f, 2) * a2 + acc[(Q) + 2]; acc[(Q) + 3] = __builtin_amdgcn_cvt_scalef32_pk_f32_fp4((W), 1.0f, 3) * a2 + acc[(Q) + 3]; } while (0)
#define P2_A2(S) const f32x2 a2 = (f32x2){S.a, S.a}
#endif
#define P2_STEP(S, k) do { { P2_A2(S); P2_AXPY1(S.v.x, 0); P2_AXPY1(S.v.y, 4); P2_AXPY1(S.v.z, 8); P2_AXPY1(S.v.w, 12); } \
        if (i0 + 16 < 64) P2_LOAD(S, i0 + (k) + 16); } while (0)
    P2_LOAD(B0, 0); P2_LOAD(B1, 1); P2_LOAD(B2, 2); P2_LOAD(B3, 3); P2_LOAD(B4, 4); P2_LOAD(B5, 5); P2_LOAD(B6, 6); P2_LOAD(B7, 7);
    P2_LOAD(B8, 8); P2_LOAD(B9, 9); P2_LOAD(B10, 10); P2_LOAD(B11, 11); P2_LOAD(B12, 12); P2_LOAD(B13, 13); P2_LOAD(B14, 14); P2_LOAD(B15, 15);
#pragma unroll
    for (int i0 = 0; i0 < 64; i0 += 16) {
        P2_STEP(B0, 0); P2_STEP(B1, 1); P2_STEP(B2, 2); P2_STEP(B3, 3); P2_STEP(B4, 4); P2_STEP(B5, 5); P2_STEP(B6, 6); P2_STEP(B7, 7);
        P2_STEP(B8, 8); P2_STEP(B9, 9); P2_STEP(B10, 10); P2_STEP(B11, 11); P2_STEP(B12, 12); P2_STEP(B13, 13); P2_STEP(B14, 14); P2_STEP(B15, 15);
    }
#undef P2_LOAD
#undef P2_AXPY1
#undef P2_A2
#undef P2_STEP
#if P2_F16
    f32x2 acc[16];
#pragma unroll
    for (int q = 0; q < 16; ++q) acc[q] = (f32x2){(float)acch[q].x, (float)acch[q].y};
#endif
    float s2[16];
#pragma unroll
    for (int q = 0; q < 8; ++q) {
        const f32x2 mine2 = gg ? acc[8 + q] : acc[q], send = gg ? acc[q] : acc[8 + q];
        s2[2 * q] = mine2.x + __shfl_xor(send.x, 32); s2[2 * q + 1] = mine2.y + __shfl_xor(send.y, 32);
    }
    const int e0 = 32 * j + 16 * gg;
    f32x4 xo[4]; float sq = 0.f;
    { float f0[8], f1[8]; unpack8(__builtin_nontemporal_load((const u32x4*)(xbrow + e0)), f0); unpack8(__builtin_nontemporal_load((const u32x4*)(xbrow + e0 + 8)), f1);
      xo[0] = (f32x4){f0[0], f0[1], f0[2], f0[3]}; xo[1] = (f32x4){f0[4], f0[5], f0[6], f0[7]}; xo[2] = (f32x4){f1[0], f1[1], f1[2], f1[3]}; xo[3] = (f32x4){f1[4], f1[5], f1[6], f1[7]}; }
#pragma unroll
    for (int q = 0; q < 4; ++q) { xo[q] += (f32x4){s2[4 * q], s2[4 * q + 1], s2[4 * q + 2], s2[4 * q + 3]};
        sq += (xo[q].x * xo[q].x + xo[q].y * xo[q].y) + (xo[q].z * xo[q].z + xo[q].w * xo[q].w); }
    if (l + 1 < DEPTH) {
        const float r1 = rsqrtf(wave_sum(sq) * (1.f / DM) + EPS);
        u32x4 o0, o1;
        o0.x = pk2(xo[0].x, xo[0].y); o0.y = pk2(xo[0].z, xo[0].w); o0.z = pk2(xo[1].x, xo[1].y); o0.w = pk2(xo[1].z, xo[1].w);
        o1.x = pk2(xo[2].x, xo[2].y); o1.y = pk2(xo[2].z, xo[2].w); o1.z = pk2(xo[3].x, xo[3].y); o1.w = pk2(xo[3].z, xo[3].w);
        u32x4* po = (u32x4*)(XN + (size_t)t * DM + e0);
        po[0] = o0; po[1] = o1;
        if (lane == 0) rstd_out[t] = r1;
    } else {
#pragma unroll
        for (int q = 0; q < 4; ++q) *(f32x4*)(xrow + e0 + 4 * q) = xo[q];
    }
}

#define BSORT_LOCAL(K) do { const bool _asc = (lane & ((K) >> 1)) == 0; const unsigned _mn = k0 < k1 ? k0 : k1, _mx = k0 < k1 ? k1 : k0; k0 = _asc ? _mn : _mx; k1 = _asc ? _mx : _mn; } while (0)
#define BSORT_CROSS(K, J) do { const unsigned _o0 = (unsigned)__shfl_xor((int)k0, (J) >> 1), _o1 = (unsigned)__shfl_xor((int)k1, (J) >> 1); \
        const bool _keepmin = ((lane & ((J) >> 1)) == 0) == ((lane & ((K) >> 1)) == 0); \
        k0 = _keepmin ? (k0 < _o0 ? k0 : _o0) : (k0 < _o0 ? _o0 : k0); k1 = _keepmin ? (k1 < _o1 ? k1 : _o1) : (k1 < _o1 ? _o1 : k1); } while (0)
__device__ __forceinline__ void gather_prep(int t, const bf16_t* XB, const int* idxs, const float* scos, LAS unsigned* wl, LAS float* rs_slot, int lane) {
    const bf16_t* xbrow = XB + (size_t)t * DM;
    float ss = 0.f;
    { float f[8]; unpack8(*(const u32x4*)(xbrow + 16 * lane), f);
#pragma unroll
      for (int e = 0; e < 8; ++e) ss += f[e] * f[e];
      unpack8(*(const u32x4*)(xbrow + 16 * lane + 8), f);
#pragma unroll
      for (int e = 0; e < 8; ++e) ss += f[e] * f[e]; }
    const float rstd = rsqrtf(wave_sum(ss) * (1.f / DM) + EPS);
    if (lane == 0) *rs_slot = rstd;
    const u32x2 iv = *(const u32x2*)(idxs + (size_t)t * 128 + 2 * lane);
    const f32x2 sv = *(const f32x2*)(scos + (size_t)t * 128 + 2 * lane);
    const float m0 = __shfl(sv.x, lane & ~7);
    const float e0 = __expf((sv.x - m0) * rstd), e1 = __expf((sv.y - m0) * rstd);
    float z = e0 + e1; DPP_ADD8(z);
    const float iz = 1.f / z;
    wl[128 + 2 * lane] = __float_as_uint(e0 * iz); wl[128 + 2 * lane + 1] = __float_as_uint(e1 * iz);
    unsigned k0 = (iv.x << 7) | (unsigned)(2 * lane), k1 = (iv.y << 7) | (unsigned)(2 * lane + 1);
    BSORT_LOCAL(2);
    BSORT_CROSS(4, 2); BSORT_LOCAL(4);
    BSORT_CROSS(8, 4); BSORT_CROSS(8, 2); BSORT_LOCAL(8);
    BSORT_CROSS(16, 8); BSORT_CROSS(16, 4); BSORT_CROSS(16, 2); BSORT_LOCAL(16);
    BSORT_CROSS(32, 16); BSORT_CROSS(32, 8); BSORT_CROSS(32, 4); BSORT_CROSS(32, 2); BSORT_LOCAL(32);
    BSORT_CROSS(64, 32); BSORT_CROSS(64, 16); BSORT_CROSS(64, 8); BSORT_CROSS(64, 4); BSORT_CROSS(64, 2); BSORT_LOCAL(64);
    BSORT_CROSS(128, 64); BSORT_CROSS(128, 32); BSORT_CROSS(128, 16); BSORT_CROSS(128, 8); BSORT_CROSS(128, 4); BSORT_CROSS(128, 2); BSORT_LOCAL(128);
    const unsigned gs0 = wl[128 + (k0 & 127u)], gs1 = wl[128 + (k1 & 127u)];
    asm volatile("s_waitcnt lgkmcnt(0)" ::: "memory");
    wl[2 * lane] = k0 >> 7; wl[2 * lane + 1] = k1 >> 7;
    wl[128 + 2 * lane] = gs0; wl[128 + 2 * lane + 1] = gs1;
}

__device__ __forceinline__ void gather_pass1_sorted(int tbase, const bf16_t* XB, const float* g2w, const unsigned char* PU, LAS unsigned* wl0, LAS float* rs, int lane, LAS unsigned char* lds_all) {
    const int gg = lane >> 5, j = lane & 31;
    f32x4 gv[8];
#pragma unroll
    for (int q = 0; q < 8; ++q) gv[q] = *(const f32x4*)(g2w + 32 * j + 4 * q);
    struct StU { u32x4 u; unsigned short su; };
    StU A0, A1, A2, A3, A4, A5, A6, A7;
#define BATCH_IDX(n) (wl0 + ((n) & 15) * 256 + 32 * ((n) >> 4))
#define P1_LOAD(S, lp, k) do { const int _e = (int)(lp)[2 * (k) + gg]; const unsigned char* _ur = PU + (size_t)_e * F4_ROW; S.u = *(const u32x4*)(_ur + j * 16); S.su = *(const unsigned short*)(_ur + 512 + 2 * j); } while (0)
#define P1_DOT1(W, Q) do { d2 = __builtin_amdgcn_cvt_scalef32_pk_f32_fp4((W), 1.0f, 0) * xv[(Q)] + d2; e2 = __builtin_amdgcn_cvt_scalef32_pk_f32_fp4((W), 1.0f, 1) * xv[(Q) + 1] + e2; \
        d2 = __builtin_amdgcn_cvt_scalef32_pk_f32_fp4((W), 1.0f, 2) * xv[(Q) + 2] + d2; e2 = __builtin_amdgcn_cvt_scalef32_pk_f32_fp4((W), 1.0f, 3) * xv[(Q) + 3] + e2; } while (0)
#define P1_COMPUTE(S, PD) do { f32x2 d2 = (f32x2){0.f, 0.f}, e2 = (f32x2){0.f, 0.f}; P1_DOT1(S.u.x, 0); P1_DOT1(S.u.y, 4); P1_DOT1(S.u.z, 8); P1_DOT1(S.u.w, 12); \
        PD = ((d2.x + d2.y) + (e2.x + e2.y)) * bf2f(S.su); } while (0)
#define P1_STEP_A(S, k) do { P1_COMPUTE(S, P[(k)]); P1_LOAD(S, cur, (k) + 8); } while (0)
#define P1_STEP_B(S, k) do { P1_COMPUTE(S, P[(k)]); if (n + 1 < 64) P1_LOAD(S, nxt, (k) - 8); } while (0)
    { LAS unsigned* cur = BATCH_IDX(0);
      P1_LOAD(A0, cur, 0); P1_LOAD(A1, cur, 1); P1_LOAD(A2, cur, 2); P1_LOAD(A3, cur, 3); P1_LOAD(A4, cur, 4); P1_LOAD(A5, cur, 5); P1_LOAD(A6, cur, 6); P1_LOAD(A7, cur, 7); }
    u32x4 xraw[4];
    { const bf16_t* xb = XB + (size_t)tbase * DM + 32 * j;
#pragma unroll
      for (int q = 0; q < 4; ++q) xraw[q] = *(const u32x4*)(xb + 8 * q); }
    const bool b4 = (lane & 16) != 0, b3 = (lane & 8) != 0, b2 = (lane & 4) != 0, b1 = (lane & 2) != 0;
    const int rho = (lane >> 1) & 15;
#pragma unroll 1
    for (int n = 0; n < 64; ++n) {
#if QUARTILE_BARRIER
        if (n > 0 && (n & 15) == 0) {
            FRESH_PARAMS; XcdBarrier xb_; xb_.bar = (unsigned*)(p.ws + WS_CTL) + 1024; xb_.x = xb_xcc_id(); xb_.st = (volatile LAS unsigned*)(lds_all + LDS_BYTES - 64); xcd_barrier(xb_);
        }
#endif
        LAS unsigned* cur = BATCH_IDX(n); LAS unsigned* nxt = BATCH_IDX(n + 1);
        const float rstd = rs[n & 15];
        f32x2 xv[16];
#pragma unroll
        for (int q = 0; q < 4; ++q) { float f[8]; unpack8(xraw[q], f); const f32x4 ga = gv[2 * q] * rstd, gb = gv[2 * q + 1] * rstd;
            xv[4 * q] = (f32x2){f[0] * ga.x, f[1] * ga.y}; xv[4 * q + 1] = (f32x2){f[2] * ga.z, f[3] * ga.w}; xv[4 * q + 2] = (f32x2){f[4] * gb.x, f[5] * gb.y}; xv[4 * q + 3] = (f32x2){f[6] * gb.z, f[7] * gb.w}; }
        { const bf16_t* xb = XB + (size_t)(tbase + ((n + 1) & 15)) * DM + 32 * j;
#pragma unroll
          for (int q = 0; q < 4; ++q) xraw[q] = *(const u32x4*)(xb + 8 * q); }
        float P[16];
        P1_STEP_A(A0, 0); P1_STEP_A(A1, 1); P1_STEP_A(A2, 2); P1_STEP_A(A3, 3); P1_STEP_A(A4, 4); P1_STEP_A(A5, 5); P1_STEP_A(A6, 6); P1_STEP_A(A7, 7);
        P1_STEP_B(A0, 8); P1_STEP_B(A1, 9); P1_STEP_B(A2, 10); P1_STEP_B(A3, 11); P1_STEP_B(A4, 12); P1_STEP_B(A5, 13); P1_STEP_B(A6, 14); P1_STEP_B(A7, 15);
        float Q8[8], R4[4], S2[2], h;
#pragma unroll
        for (int k = 0; k < 8; ++k) { const float mine = b4 ? P[8 + k] : P[k], send = b4 ? P[k] : P[8 + k]; Q8[k] = mine + __builtin_bit_cast(float, __builtin_amdgcn_ds_swizzle(__builtin_bit_cast(int, send), 0x401F)); }
#pragma unroll
        for (int k = 0; k < 4; ++k) { const float mine = b3 ? Q8[4 + k] : Q8[k], send = b3 ? Q8[k] : Q8[4 + k]; R4[k] = mine + DPP_MOV(send, 0x128); }
#pragma unroll
        for (int k = 0; k < 2; ++k) { const float mine = b2 ? R4[2 + k] : R4[k], send = b2 ? R4[k] : R4[2 + k]; S2[k] = mine + DPP_MOV(send, 0x141); }
        { const float mine = b1 ? S2[1] : S2[0], send = b1 ? S2[0] : S2[1]; h = mine + DPP_MOV(send, 0x4E); }
        h += DPP_MOV(h, 0xB1);
        LAS unsigned* ap = wl0 + (n & 15) * 256 + 128 + 32 * (n >> 4) + 2 * rho + gg;
        const float a = __uint_as_float(*ap) * gelu_fast(h);
        if ((lane & 1) == 0) *ap = __float_as_uint(a);
    }
#undef BATCH_IDX
#undef P1_LOAD
#undef P1_DOT1
#undef P1_COMPUTE
#undef P1_STEP_A
#undef P1_STEP_B
}

__device__ __forceinline__ void phase_peer(int wv0, int l, LAS unsigned char* lds) {
    FRESH_PARAMS; FRESH_IDS;
    const bf16_t* qp = (const bf16_t*)(p.ws + WS_Z);
    const bf16_t* SK = (const bf16_t*)(p.ws + WS_SK) + (size_t)l * 2 * 128 * 128;
    int* idxo = (int*)(p.ws + WS_IDX); float* sco = (float*)(p.ws + WS_GATE);
#if USE_FP4
    const unsigned char* PU = p.ws + WS_P8 + (size_t)(2 * l) * NEXP * F4_ROW; const unsigned char* PV = PU + (size_t)NEXP * F4_ROW;
    const float* SU4 = (const float*)(p.ws + WS_SCL) + (size_t)(2 * l) * NEXP; const float* SV4 = SU4 + NEXP;
#else
    const unsigned char* PU = p.ws + WS_P8 + (size_t)(2 * l) * NEXP * 1024; const unsigned char* PV = PU + (size_t)NEXP * 1024;
    const float* SU = (const float*)(p.ws + WS_SCL) + (size_t)(2 * l) * NEXP; const float* SV = SU + NEXP;
#endif
    const float* g2 = p.norm2_g + l * DM;
    bf16_t* XN = (bf16_t*)(p.ws + WS_XN);
    const int r = lane & 31, hh = lane >> 5;
    LAS float* mine = (LAS float*)(lds + RT_SK_BYTES + wave * RT_WAVE_BYTES + lane * RT_LANE_STRIDE);
#pragma unroll 1
    for (int tb = bid; tb < T / 128; tb += nblk) {
        __syncthreads();
        int tid2 = tid; asm volatile("" : "+v"(tid2));
        for (int i = tid2; i < 4096; i += NTHREADS) {
            const int row = i >> 4, ch = i & 15;
            *(LAS u32x4*)(lds + row * 256 + ((ch ^ (row & 15)) << 4)) = *(const u32x4*)(SK + (size_t)i * 8);
        }
        __syncthreads();
#pragma unroll 1
        for (int uu = wave; uu < 32; uu += NWAVES) route_unit(lds, mine, qp, idxo, sco, tb * 128 + (uu >> 3) * 32, uu & 7, r, hh);
#if PROBE_MASK & 16
#pragma unroll 1
        for (int uu = wave; uu < 32; uu += NWAVES) route_unit(lds, mine, qp, idxo, sco, tb * 128 + (uu >> 3) * 32, uu & 7, r, hh);
#endif
        asm volatile("s_waitcnt vmcnt(0)" ::: "memory");
        __syncthreads();
#if USE_FP4 == 4
        {
            int ln = lane, wv = wave; asm volatile("" : "+v"(ln)); asm volatile("" : "+s"(wv));
            LAS unsigned* wl0 = (LAS unsigned*)(lds + wv * 16384);
            LAS float* rs = (LAS float*)(lds + 131072 + wv * 256);
            const int tok0 = tb * 128 + wv * 16;
#pragma unroll 1
            for (int i = 0; i < 16; ++i) gather_prep(tok0 + i, (const bf16_t*)(p.ws + WS_XN2), idxo, sco, wl0 + i * 256, rs + i, ln);
            gather_pass1_sorted(tok0, (const bf16_t*)(p.ws + WS_XN2), g2, PU, wl0, rs, ln, lds);
#pragma unroll 1
            for (int i = 0; i < 16; ++i) gather_pass2<false>(l, tok0 + i, p.out, (const bf16_t*)(p.ws + WS_XN2), (float*)(p.ws + WS_RSTD), PV, SV4, XN, wl0 + i * 256, ln);
        }
#elif USE_FP4 == 3
        {
            int ln = lane, wv = wave; asm volatile("" : "+v"(ln)); asm volatile("" : "+s"(wv));
            LAS unsigned* wl0 = (LAS unsigned*)(lds + wv * 16384);
            const int tok0 = tb * 128 + wv * 16;
#if P1_PRESTAGE
            {
                const u32x4* ip = (const u32x4*)(idxo + (size_t)tok0 * 128);
#pragma unroll
                for (int k = 0; k < 8; ++k) { const int w4 = k * 64 + ln; const u32x4 v4 = __builtin_nontemporal_load(ip + w4); *(LAS u32x4*)(wl0 + (w4 >> 5) * 256 + (w4 & 31) * 4) = v4; }
            }
#endif
#pragma unroll 1
            for (int i = 0; i < 16; ++i) gather_pass1_lean(tok0 + i, (const bf16_t*)(p.ws + WS_XN2), g2, PU, (const f32x2*)(p.ws + WS_SUQ + (size_t)l * NEXP * 8), SV4, sco, wl0 + i * 256, ln);
#pragma unroll 1
            for (int i = 0; i < 16; ++i) gather_pass2_lean(l, tok0 + i, p.out, (const bf16_t*)(p.ws + WS_XN2), (float*)(p.ws + WS_RSTD), PV, XN, wl0 + i * 256, ln);
        }
#elif USE_FP4 == 2
        { LAS unsigned* wl = (LAS unsigned*)(lds + RT_SK_BYTES + wave * RT_WAVE_BYTES);
#if PROBE_MASK & 8
#pragma unroll 1
          for (int i = 0; i < 16; ++i) gather_token4b<true>(l, tb * 128 + wave * 16 + i, p.out, (const bf16_t*)(p.ws + WS_XN2), (float*)(p.ws + WS_RSTD), g2, PU, PV, idxo, sco, XN, wl, lane);
#endif
#pragma unroll 1
          for (int i = 0; i < 16; ++i) gather_token4b<false>(l, tb * 128 + wave * 16 + i, p.out, (const bf16_t*)(p.ws + WS_XN2), (float*)(p.ws + WS_RSTD), g2, PU, PV, idxo, sco, XN, wl, lane); }
#elif USE_FP4
#if PROBE_MASK & 8
#pragma unroll 1
        for (int i = 0; i < 16; ++i) gather_token4<true>(l, tb * 128 + wave * 16 + i, p.out, g2, PU, PV, idxo, sco, XN, lane);
#endif
#pragma unroll 1
        for (int i = 0; i < 16; ++i) gather_token4<false>(l, tb * 128 + wave * 16 + i, p.out, g2, PU, PV, idxo, sco, XN, lane);
#else
#if PROBE_MASK & 8
#pragma unroll 1
        for (int i = 0; i < 16; ++i) gather_token8<true>(l, tb * 128 + wave * 16 + i, p.out, g2, PU, PV, SU, SV, idxo, sco, XN, lane);
#endif
#pragma unroll 1
        for (int i = 0; i < 16; ++i) gather_token8<false>(l, tb * 128 + wave * 16 + i, p.out, g2, PU, PV, SU, SV, idxo, sco, XN, lane);
#endif
    }
}

__global__ void __launch_bounds__(NTHREADS, 2) fwd_kernel(Params p_unused) {
    extern __shared__ __attribute__((aligned(16))) unsigned char lds_raw[];
    LAS unsigned char* lds = (LAS unsigned char*)lds_raw;
    cg::grid_group grid = cg::this_grid();
    const int wv0 = __builtin_amdgcn_readfirstlane(threadIdx.x >> 6);
    volatile LAS unsigned* bar_st = (volatile LAS unsigned*)(lds + LDS_BYTES - 64);
    if (threadIdx.x < 16) bar_st[threadIdx.x] = 0u;
    __syncthreads();
    { FRESH_PARAMS; (void)xcd_barrier_post((unsigned*)(p.ws + WS_CTL) + 1024, bar_st); }
#if USE_XBAR
#define GRID_SYNC() do { FRESH_PARAMS; XcdBarrier xb_; xb_.bar = (unsigned*)(p.ws + WS_CTL) + 1024; xb_.x = xb_xcc_id(); xb_.st = (volatile LAS unsigned*)(lds + LDS_BYTES - 64); xcd_barrier(xb_); } while (0)
#else
#define GRID_SYNC() grid.sync()
#endif
    phase_prep(wv0, lds);
#if PROBE_MASK & 32
    __syncthreads(); phase_prep(wv0, lds);
#endif
#if USE_FP4
    phase_table_fp4(wv0);
#if PROBE_MASK & 64
    phase_table_fp4(wv0);
#endif
#elif USE_GATHER == 2
    phase_table_fp8(wv0);
#endif
#if USE_XBAR
    { FRESH_PARAMS; if (p.ws == nullptr) grid.sync(); }
    GRID_SYNC();
#else
    grid.sync();
#endif
#pragma unroll 1
    for (int l = 0; l < DEPTH; ++l) {
        { FRESH_PARAMS; FRESH_IDS; const bf16_t* XN = (const bf16_t*)(p.ws + WS_XN); bf16_t* Z = (bf16_t*)(p.ws + WS_Z); const bf16_t* WinT = (const bf16_t*)(p.ws + WS_WIN) + (size_t)l * NZ * DM;
#if USE_PG8 & 1
          pg8::Gemm g{XN, WinT, T, NZ, DM}; pg8::StaticOrderHT S; S.init(T, NZ, nblk, bid); pg8::EpiBf16RS E{Z, NZ, (const float*)(p.ws + WS_RSTD)};
          pg8::gemm_phase<pg8::EpiBf16RS, pg8::StaticOrderHT, true, true>(lds, g, S, E, tid);
#if PROBE_MASK & 128
          pg8::gemm_phase<pg8::EpiBf16RS, pg8::StaticOrder, true, true>(lds, g, S, E, tid);
#endif
#else
          EpiStoreBf16 E{Z, NZ}; gemm_simple(XN, WinT, T, NZ, DM, E, gw, ngw, lane);
#endif
        }
        GRID_SYNC();
#if !USE_ATTN
        phase_qknorm(wv0, l);
        GRID_SYNC();
#endif
#if USE_POOLFOLD
        phase_poolconv4(wv0, l);
#if PROBE_MASK & 4
        phase_poolconv4(wv0, l);
#endif
#else
        phase_poolconv(wv0, l, lds);
#if PROBE_MASK & 4
        __syncthreads(); phase_poolconv(wv0, l, lds);
#endif
#endif
#if USE_ATTN
        phase_attn(wv0, l, lds);
#if PROBE_MASK & 1
        __syncthreads(); phase_attn(wv0, l, lds);
#endif
#else
        phase_swa_naive(wv0, l);
        phase_diff_naive(wv0, l);
#endif
        GRID_SYNC();
        { FRESH_PARAMS; FRESH_IDS; const bf16_t* Y = (const bf16_t*)(p.ws + WS_Y); const bf16_t* WoutT = (const bf16_t*)(p.ws + WS_WOUT) + (size_t)l * DM * DM; const float* base = (l == 0) ? p.x : p.out;
#if USE_PG8 & 2
          pg8::Gemm g{Y, WoutT, T, DM, DM}; pg8::StaticOrder S; S.init(T, DM, nblk, bid);
          pg8::EpiResB E{nullptr, (const bf16_t*)(p.ws + WS_XN), (bf16_t*)(p.ws + WS_XN2), DM}; (void)base;
          pg8::gemm_phase<pg8::EpiResB, pg8::StaticOrder, true, true>(lds, g, S, E, tid);
#else
          EpiResidual E{base, p.out, DM}; gemm_simple(Y, WoutT, T, DM, DM, E, gw, ngw, lane);
#endif
        }
        GRID_SYNC();
#if !USE_PEER
        { FRESH_PARAMS; FRESH_IDS; bf16_t* XN2 = (bf16_t*)(p.ws + WS_XN2);
          for (int m = gw; m < T; m += ngw) rms_row_to_bf16(p.out + (size_t)m * DM, XN2 + (size_t)m * DM, lane); }
#if USE_GATHER == 1
        phase_table_convert(wv0, l);
#endif
        GRID_SYNC();
#endif
        { FRESH_PARAMS; FRESH_IDS; const bf16_t* XN2 = (const bf16_t*)(p.ws + WS_XN2); bf16_t* Z = (bf16_t*)(p.ws + WS_Z); const bf16_t* WqT = (const bf16_t*)(p.ws + WS_WQ) + (size_t)l * NQ * DM;
#if USE_PG8 & 4
          pg8::Gemm g{XN2, WqT, T, NQ, DM}; pg8::StaticOrder S; S.init(T, NQ, nblk, bid); pg8::EpiBf16<0> E{Z, NQ, nullptr, 0, 0, 1.f};
          pg8::gemm_phase<pg8::EpiBf16<0>, pg8::StaticOrder, true, true>(lds, g, S, E, tid);
#if PROBE_MASK & 128
          pg8::gemm_phase<pg8::EpiBf16<0>, pg8::StaticOrder, true, true>(lds, g, S, E, tid);
#endif
#else
          EpiStoreBf16 E{Z, NQ}; gemm_simple(XN2, WqT, T, NQ, DM, E, gw, ngw, lane);
#endif
        }
        GRID_SYNC();
#if USE_PEER
        phase_peer(wv0, l, lds);
#else
#if USE_ROUTE
        phase_route(wv0, l, lds);
#if PROBE_MASK & 2
        __syncthreads(); phase_route(wv0, l, lds);
#endif
#else
        phase_route_a_naive(wv0, l);
        GRID_SYNC();
        phase_route_b_naive(wv0, l);
#endif
        GRID_SYNC();
#if USE_GATHER == 2
        phase_gather8(wv0, l);
#elif USE_GATHER == 1
        phase_gather(wv0, l);
#else
        phase_gather_naive(wv0, l);
#endif
#endif
        GRID_SYNC();
    }
}

extern "C" void kernel_launch(void* const* d_in, const int* in_sizes, int n_in, void* d_out, int out_size, void* d_ws, size_t ws_size, hipStream_t stream) {
    static int grid_blocks = 0;
    if (grid_blocks == 0) {
        if (n_in != 21 || out_size != T * DM || ws_size < WS_END) { fprintf(stderr, "kernel_launch: unexpected shapes (n_in %d out %d ws %zu)\n", n_in, out_size, ws_size); grid_blocks = -1; return; }
        int dev = 0, cus = 0, per_cu = 0;
        hipGetDevice(&dev);
        hipDeviceGetAttribute(&cus, hipDeviceAttributeMultiprocessorCount, dev);
        if (hipFuncSetAttribute((const void*)fwd_kernel, hipFuncAttributeMaxDynamicSharedMemorySize, LDS_BYTES) != hipSuccess) { fprintf(stderr, "kernel_launch: hipFuncSetAttribute failed\n"); }
        if (hipOccupancyMaxActiveBlocksPerMultiprocessor(&per_cu, (const void*)fwd_kernel, NTHREADS, LDS_BYTES) != hipSuccess || per_cu < 1) { fprintf(stderr, "kernel_launch: occupancy query says %d\n", per_cu); per_cu = 1; }
        (void)hipGetLastError();
        if (per_cu > 1) per_cu = 1;
        grid_blocks = cus * per_cu;
    }
    if (grid_blocks < 0) return;
    Params p{};
    p.x = (const float*)d_in[0]; p.norm1_g = (const float*)d_in[1]; p.w_in = (const float*)d_in[2]; p.w_pool = (const float*)d_in[3];
    p.swa_q_norm = (const float*)d_in[4]; p.swa_k_norm = (const float*)d_in[5]; p.swa_sinks = (const float*)d_in[6]; p.conv_w = (const float*)d_in[7];
    p.diff_q_norm = (const float*)d_in[8]; p.diff_k_norm = (const float*)d_in[9]; p.lam_q1 = (const float*)d_in[10]; p.lam_k1 = (const float*)d_in[11];
    p.lam_q2 = (const float*)d_in[12]; p.lam_k2 = (const float*)d_in[13]; p.out_norm_g = (const float*)d_in[14]; p.w_out = (const float*)d_in[15];
    p.norm2_g = (const float*)d_in[16]; p.w_query = (const float*)d_in[17]; p.sub_keys = (const float*)d_in[18]; p.peer_u = (const float*)d_in[19];
    p.peer_v = (const float*)d_in[20];
    p.out = (float*)d_out; p.ws = (unsigned char*)d_ws;
    if (hipMemsetAsync((char*)d_ws + WS_CTL, 0, 65536, stream) != hipSuccess) { fprintf(stderr, "kernel_launch: memset failed\n"); return; }
    void* args[] = {&p};
    hipError_t e = hipLaunchCooperativeKernel((const void*)fwd_kernel, dim3(grid_blocks), dim3(NTHREADS), args, LDS_BYTES, stream);
    if (e != hipSuccess) fprintf(stderr, "kernel_launch: cooperative launch failed: %s (grid %d)\n", hipGetErrorString(e), grid_blocks);
}
```
